# Optimizing an MI355X kernel written in HIP

```python
import jax, jax.numpy as jnp
from jax import lax
import numpy as np

D_MODEL = 1024
BATCH = 16
SEQ = 2048
DEPTH = 1

CTX_LEN = 256
GRID_W = 64
MIX_WIDTH = D_MODEL
NA_HEAD_DIM = 64
NA_WIDTH = MIX_WIDTH // 2
NA_HEADS = NA_WIDTH // NA_HEAD_DIM
NA_WIN_ROWS = 8
NA_WIN_COLS = 16
RET_HEADS = 4
RET_WIDTH = MIX_WIDTH - NA_WIDTH
RET_V_DIM = RET_WIDTH // RET_HEADS
RET_QK_DIM = RET_WIDTH // RET_HEADS
RET_QK_WIDTH = RET_HEADS * RET_QK_DIM
RET_CHUNK = 128
IN_WIDTH = 4 * NA_WIDTH + 2 * RET_QK_WIDTH + 2 * RET_WIDTH
ROPE_BASE = 10000.0
EPS = 1e-6

kernel_name = "hybrid_na_retention_dit_block"


def _rmsnorm(x, g):
    xf = x.astype(jnp.float32)
    xf = xf * lax.rsqrt(jnp.mean(xf * xf, axis=-1, keepdims=True) + EPS)
    return (xf * g.astype(jnp.float32)).astype(x.dtype)


def _heads(t, n_heads):
    b, l, _ = t.shape
    return t.reshape(b, l, n_heads, -1).transpose(0, 2, 1, 3)


def _merge(t):
    b, h, l, d = t.shape
    return t.transpose(0, 2, 1, 3).reshape(b, l, h * d)


def _split_proj(p):
    sizes = [NA_WIDTH] * 4 + [RET_QK_WIDTH, RET_QK_WIDTH, RET_WIDTH, RET_WIDTH]
    offs = [int(o) for o in np.cumsum(sizes)[:-1]]
    return jnp.split(p, offs, axis=-1)


def _axial_rotary(x):
    L, dk = x.shape[2], x.shape[-1]
    half = dk // 2
    nf = half // 2
    t = jnp.arange(L)
    row = (t // GRID_W).astype(jnp.float32)
    col = (t % GRID_W).astype(jnp.float32)
    inv = ROPE_BASE ** (-jnp.arange(nf, dtype=jnp.float32) / nf)
    ang = jnp.concatenate([row[:, None] * inv, col[:, None] * inv], axis=-1)
    cos, sin = jnp.cos(ang), jnp.sin(ang)
    xf = x.astype(jnp.float32)
    x1, x2 = xf[..., :half], xf[..., half:]
    out = jnp.concatenate([x1 * cos - x2 * sin, x1 * sin + x2 * cos], axis=-1)
    return out.astype(x.dtype)


def _neighbourhood_attention(q, k, v, k_ctx, v_ctx, rpb):
    B, H, L, dh = q.shape
    rows = L // GRID_W
    kr = min(NA_WIN_ROWS, rows)
    kc = NA_WIN_COLS
    r = jnp.arange(rows)
    r0 = jnp.clip(r - kr // 2, 0, rows - kr)
    row_idx = r0[:, None] + jnp.arange(kr)[None, :]
    cq = jnp.arange(GRID_W)
    c0 = jnp.clip(cq - kc // 2, 0, GRID_W - kc)
    ck = jnp.arange(GRID_W)
    col_in = (ck[None, :] >= c0[:, None]) & (ck[None, :] < c0[:, None] + kc)
    dr_i = row_idx - r[:, None] + NA_WIN_ROWS - 1
    dc_i = jnp.clip(ck[None, :] - cq[:, None] + kc - 1, 0, 2 * kc - 2)
    bias = rpb[:, dr_i[:, None, :, None], dc_i[None, :, None, :]]
    bias = bias.reshape(H, rows, GRID_W, kr * GRID_W).astype(jnp.float32)
    mask = jnp.broadcast_to(col_in[:, None, :], (GRID_W, kr, GRID_W)).reshape(GRID_W, kr * GRID_W)

    kg = k.reshape(B, H, rows, GRID_W, dh)[:, :, row_idx].reshape(B, H, rows, kr * GRID_W, dh)
    vg = v.reshape(B, H, rows, GRID_W, dh)[:, :, row_idx].reshape(B, H, rows, kr * GRID_W, dh)
    qr = q.reshape(B, H, rows, GRID_W, dh)
    scale = dh ** -0.5
    s_loc = jnp.einsum('bhrqd,bhrkd->bhrqk', qr, kg, preferred_element_type=jnp.float32) * scale + bias[None]
    s_loc = jnp.where(mask, s_loc, -jnp.inf)
    s_ctx = jnp.einsum('bhrqd,bhcd->bhrqc', qr, k_ctx, preferred_element_type=jnp.float32) * scale
    p = jax.nn.softmax(jnp.concatenate([s_loc, s_ctx], axis=-1), axis=-1)
    p_loc = p[..., :kr * GRID_W].astype(v.dtype)
    p_ctx = p[..., kr * GRID_W:].astype(v.dtype)
    o = jnp.einsum('bhrqk,bhrkd->bhrqd', p_loc, vg) + jnp.einsum('bhrqc,bhcd->bhrqd', p_ctx, v_ctx)
    return o.reshape(B, H, L, dh)


def _dense_attention(q, k, v):
    s = jnp.einsum('bhqd,bhkd->bhqk', q, k, preferred_element_type=jnp.float32) * (q.shape[-1] ** -0.5)
    p = jax.nn.softmax(s, axis=-1).astype(v.dtype)
    return jnp.einsum('bhqk,bhkd->bhqd', p, v)


def _retention_chunkwise(q, k, v, log_gamma, state0):
    B, H, L, dk = q.shape
    dv = v.shape[-1]
    C = RET_CHUNK
    n = L // C
    qc = q.astype(jnp.float32).reshape(B, H, n, C, dk)
    kc = k.astype(jnp.float32).reshape(B, H, n, C, dk)
    vc = v.astype(jnp.float32).reshape(B, H, n, C, dv)
    lg = log_gamma.astype(jnp.float32)
    i = jnp.arange(C, dtype=jnp.float32)
    dist = i[:, None] - i[None, :]
    decay = jnp.where(dist >= 0, jnp.exp(lg[:, None, None] * jnp.maximum(dist, 0.0)), 0.0)
    s = jnp.einsum('bhnid,bhnjd->bhnij', qc, kc) * decay[None, :, None]
    inner = jnp.einsum('bhnij,bhnje->bhnie', s, vc)
    k_decay = jnp.exp(lg[:, None] * (C - 1 - i))
    k_w = kc * k_decay[None, :, None, :, None]
    chunk_states = jnp.einsum('bhnjd,bhnje->nbhde', k_w, vc)
    chunk_decay = jnp.exp(lg * C)[None, :, None, None]

    def step(S, T):
        return chunk_decay * S + T, S

    S_final, S_prev = lax.scan(step, state0, chunk_states)
    q_decay = jnp.exp(lg[:, None] * (i + 1.0))
    q_w = qc * q_decay[None, :, None, :, None]
    cross = jnp.einsum('bhnid,nbhde->bhnie', q_w, S_prev)
    return (inner + cross).reshape(B, H, L, dv), S_final


def _retention_final_state(k, v, log_gamma):
    L = k.shape[2]
    w = jnp.exp(log_gamma.astype(jnp.float32)[:, None] * (L - 1 - jnp.arange(L, dtype=jnp.float32)))
    return jnp.einsum('bhld,bhle->bhde', k.astype(jnp.float32) * w[None, :, :, None], v.astype(jnp.float32))


def _head_rmsnorm(o, g):
    o = o * lax.rsqrt(jnp.mean(o * o, axis=-1, keepdims=True) + EPS)
    return _merge(o) * g.astype(jnp.float32)


def _mixer(h_lat, h_ctx, w_in, na_rpb, lg_f, lg_b, ret_norm_g, w_out, with_ctx_out):
    dt = h_lat.dtype
    na_q, na_k, na_v, na_g, r_q, r_k, r_v, r_g = _split_proj(h_lat @ w_in)
    cna_q, cna_k, cna_v, cna_g, cr_q, cr_k, cr_v, cr_g = _split_proj(h_ctx @ w_in)

    k_na_ctx = _heads(cna_k, NA_HEADS)
    v_na_ctx = _heads(cna_v, NA_HEADS)
    o_na = _neighbourhood_attention(_heads(na_q, NA_HEADS), _heads(na_k, NA_HEADS),
                                    _heads(na_v, NA_HEADS), k_na_ctx, v_na_ctx, na_rpb)
    y_na = _merge(o_na) * jax.nn.silu(na_g)

    kscale = RET_QK_DIM ** -0.5
    q = _axial_rotary(_heads(r_q, RET_HEADS))
    k = _axial_rotary(_heads(r_k, RET_HEADS)) * kscale
    v = _heads(r_v, RET_HEADS)
    k_ctx = _heads(cr_k, RET_HEADS) * kscale
    v_ctx = _heads(cr_v, RET_HEADS)
    S_f = _retention_final_state(k_ctx, v_ctx, lg_f)
    S_b = _retention_final_state(jnp.flip(k_ctx, 2), jnp.flip(v_ctx, 2), lg_b)
    o_f, _ = _retention_chunkwise(q, k, v, lg_f, S_f)
    o_b, _ = _retention_chunkwise(jnp.flip(q, 2), jnp.flip(k, 2), jnp.flip(v, 2), lg_b, S_b)
    o_ret = o_f + jnp.flip(o_b, 2)
    y_ret = _head_rmsnorm(o_ret, ret_norm_g).astype(dt) * jax.nn.silu(r_g)

    y_lat = jnp.concatenate([y_na, y_ret], axis=-1) @ w_out
    if not with_ctx_out:
        return y_lat, None

    o_cna = _dense_attention(_heads(cna_q, NA_HEADS), k_na_ctx, v_na_ctx)
    yc_na = _merge(o_cna) * jax.nn.silu(cna_g)
    q_ctx = _heads(cr_q, RET_HEADS)
    zeros = jnp.zeros(S_f.shape, jnp.float32)
    oc_f, _ = _retention_chunkwise(q_ctx, k_ctx, v_ctx, lg_f, zeros)
    oc_b, _ = _retention_chunkwise(jnp.flip(q_ctx, 2), jnp.flip(k_ctx, 2), jnp.flip(v_ctx, 2), lg_b, zeros)
    yc_ret = _head_rmsnorm(oc_f + jnp.flip(oc_b, 2), ret_norm_g).astype(dt) * jax.nn.silu(cr_g)
    y_ctx = jnp.concatenate([yc_na, yc_ret], axis=-1) @ w_out
    return y_lat, y_ctx


def setup_inputs(seed: int = 0) -> dict:
    key = jax.random.key(seed)
    ks = jax.random.split(key, 16)
    f32 = jnp.float32
    D = D_MODEL
    x = jax.random.normal(ks[0], (BATCH, SEQ, D), f32)
    c = jax.random.normal(ks[1], (BATCH, D), f32)
    ctx = jax.random.normal(ks[2], (BATCH, CTX_LEN, D), f32)
    c_ctx = jax.random.normal(ks[3], (D,), f32)
    norm_g = 1.0 + 0.02 * jax.random.normal(ks[4], (DEPTH, D), f32)
    w_ada = 0.5 * D ** -0.5 * jax.random.normal(ks[5], (DEPTH, D, 3 * D), f32)
    b_ada = 0.01 * jax.random.normal(ks[6], (DEPTH, 3 * D), f32)
    w_in = D ** -0.5 * jax.random.normal(ks[7], (DEPTH, D, IN_WIDTH), f32)
    na_rpb = 0.1 * jax.random.normal(ks[8], (DEPTH, NA_HEADS, 2 * NA_WIN_ROWS - 1, 2 * NA_WIN_COLS - 1), f32)
    gam = 1.0 - 2.0 ** (-5.0 - np.arange(RET_HEADS, dtype=np.float32))
    base = jnp.asarray(np.log(-np.log(gam)).astype(np.float32))
    ret_decay_fwd = base[None] + 0.05 * jax.random.normal(ks[9], (DEPTH, RET_HEADS), f32)
    ret_decay_bwd = base[None] + 0.05 * jax.random.normal(ks[10], (DEPTH, RET_HEADS), f32)
    ret_norm_g = 1.0 + 0.02 * jax.random.normal(ks[11], (DEPTH, RET_WIDTH), f32)
    w_out = MIX_WIDTH ** -0.5 * jax.random.normal(ks[12], (DEPTH, MIX_WIDTH, D), f32)
    final_norm_g = 1.0 + 0.02 * jax.random.normal(ks[13], (D,), f32)
    return {"x": x, "c": c, "ctx": ctx, "c_ctx": c_ctx, "norm_g": norm_g, "w_ada": w_ada,
            "b_ada": b_ada, "w_in": w_in, "na_rpb": na_rpb, "ret_decay_fwd": ret_decay_fwd,
            "ret_decay_bwd": ret_decay_bwd, "ret_norm_g": ret_norm_g, "w_out": w_out,
            "final_norm_g": final_norm_g}


def reference(x, c, ctx, c_ctx, norm_g, w_ada, b_ada, w_in, na_rpb, ret_decay_fwd,
              ret_decay_bwd, ret_norm_g, w_out, final_norm_g):
    D = D_MODEL
    for i in range(DEPTH):
        update_ctx = i < DEPTH - 1
        mod = jax.nn.silu(c) @ w_ada[i] + b_ada[i]
        mod_c = jax.nn.silu(c_ctx) @ w_ada[i] + b_ada[i]
        shift, scale, gate = mod[:, None, :D], mod[:, None, D:2 * D], mod[:, None, 2 * D:]
        shift_c, scale_c, gate_c = mod_c[:D], mod_c[D:2 * D], mod_c[2 * D:]
        h_lat = _rmsnorm(x, norm_g[i]) * (1.0 + scale) + shift
        h_ctx = _rmsnorm(ctx, norm_g[i]) * (1.0 + scale_c) + shift_c
        lg_f = -jnp.exp(ret_decay_fwd[i].astype(jnp.float32))
        lg_b = -jnp.exp(ret_decay_bwd[i].astype(jnp.float32))
        y_lat, y_ctx = _mixer(h_lat, h_ctx, w_in[i], na_rpb[i], lg_f, lg_b, ret_norm_g[i],
                              w_out[i], update_ctx)
        x = x + gate * y_lat
        if update_ctx:
            ctx = ctx + gate_c * y_ctx
    return _rmsnorm(x, final_norm_g)
```

```cpp
#include <hip/hip_runtime.h>
#include <cstdio>
#include <cstdint>

#define DI __device__ __forceinline__
#define LAS __attribute__((address_space(3)))
typedef unsigned short bf16_t;
typedef short bf16x8 __attribute__((ext_vector_type(8)));
typedef float f32x4 __attribute__((ext_vector_type(4)));
typedef unsigned u32x4 __attribute__((ext_vector_type(4)));
typedef unsigned u32x2 __attribute__((ext_vector_type(2)));

constexpr int DM = 1024, NBATCH = 16, SEQ = 2048, CTXL = 256;
constexpr int MLAT = NBATCH * SEQ, MCTX = NBATCH * CTXL, MTOT = MLAT + MCTX;
constexpr int LDP = 2560 + 128;
constexpr int LDT = MTOT + 128;
constexpr int LDKC = 512 + 128;
constexpr int PC_NAQ = 0, PC_NAG = 512, PC_RQ = 1024, PC_RK = 1536, PC_RG = 2048;
constexpr int PT_NAV = 0, PT_RK = 512, PT_RV = 1024;
constexpr float LOG2E = 1.4426950408889634f;
constexpr float KSCALE = 0.08838834764831845f;
constexpr float EPSN = 1e-6f;
constexpr int NWT = 4608;

constexpr size_t MiB = 1u << 20;
constexpr size_t WS_WT = 2 * MiB, WS_WOT = 12 * MiB, WS_MODP = 24 * MiB  , WS_MOD = 15 * MiB;
constexpr size_t WS_CNT = 16384;
constexpr size_t WS_XBUF = 20 * MiB;
constexpr size_t WS_COS = 16 * MiB, WS_SIN = WS_COS + 512 * 1024, WS_COST = 17 * MiB, WS_SINT = WS_COST + 512 * 1024;
constexpr size_t WS_XN = 32 * MiB;
constexpr size_t WS_Y = 32 * MiB;
constexpr size_t WS_P = 104 * MiB;
constexpr size_t WS_KT = 272 * MiB;
constexpr size_t WS_PT = 310 * MiB;
constexpr size_t WS_VT = WS_PT;
constexpr size_t WS_RT = WS_PT + (size_t)512 * LDT * 2;
static_assert((size_t)MTOT * 1024 * 2 <= (size_t)1024 * LDT * 2, "RT fits the old PT rows");
constexpr size_t WS_SF = 419 * MiB, WS_SB = 451 * MiB;
constexpr size_t WS_END = 483 * MiB;
static_assert(WS_P + (size_t)MLAT * LDP * 2 <= WS_KT && WS_KT + (size_t)MTOT * 512 * 2 <= WS_PT && (size_t)MTOT * 512 * 2 <= (size_t)512 * LDT * 2 && WS_PT + (size_t)1536 * LDT * 2 <= WS_SF, "ws map");

constexpr int LDS_BYTES = 131072 + 256 + 5120 + 8 * 2304;

struct Params {
    const float *x, *c, *ctx, *c_ctx, *norm_g, *w_ada, *b_ada, *w_in, *na_rpb, *dec_f, *dec_b, *ret_norm_g, *w_out, *final_g;
    float* out; unsigned char* ws;
};

DI unsigned cvt_pk_bf16(float lo, float hi) { unsigned r; asm volatile("v_cvt_pk_bf16_f32 %0, %1, %2" : "=v"(r) : "v"(lo), "v"(hi)); return r; }
DI float bf2f(unsigned short v) { return __uint_as_float(((unsigned)v) << 16); }
DI float bflo(unsigned w) { return __uint_as_float(w << 16); }
DI float bfhi(unsigned w) { return __uint_as_float(w & 0xffff0000u); }
DI f32x4 mfma16(bf16x8 a, bf16x8 b, f32x4 c) { return __builtin_amdgcn_mfma_f32_16x16x32_bf16(a, b, c, 0, 0, 0); }
DI bf16x8 ldg8(const bf16_t* p) { return *(const bf16x8*)p; }
#define GAS __attribute__((address_space(1)))
DI bf16x8 ldg8u(const bf16_t* ub, unsigned off_bytes) {
    const GAS char* gp = (const GAS char*)ub; asm volatile("" : "+s"(gp));
    return *(const GAS bf16x8*)(gp + off_bytes); }
DI float ex2(float x) { return __builtin_amdgcn_exp2f(x); }
DI float wave_sum(float v) {
#pragma unroll
    for (int o = 1; o < 64; o <<= 1) v += __shfl_xor(v, o);
    return v;
}
DI float silu_f(float v) { return v * __builtin_amdgcn_rcpf(1.f + ex2(v * -LOG2E)); }
DI bf16x8 scale_frag(bf16x8 a, float s) {
    u32x4 w = __builtin_bit_cast(u32x4, a), o;
    o.x = cvt_pk_bf16(bflo(w.x) * s, bfhi(w.x) * s); o.y = cvt_pk_bf16(bflo(w.y) * s, bfhi(w.y) * s);
    o.z = cvt_pk_bf16(bflo(w.z) * s, bfhi(w.z) * s); o.w = cvt_pk_bf16(bflo(w.w) * s, bfhi(w.w) * s);
    return __builtin_bit_cast(bf16x8, o);
}

namespace pg8 {
constexpr int BM = 256, BK = 64, HALF = 128, HTB = HALF * BK * 2, STAGE_BYTES = 8 * HTB;
constexpr int GK = 1024;
__host__ __device__ __forceinline__ int lds_byte(int r, int c) { const int st = (r >> 4) * 2 + (c >> 5), rr = r & 15, cc = c & 31, ob = rr * 64 + cc * 2; return st * 1024 + (ob ^ (((ob >> 9) & 1) << 5)); }
__host__ __device__ __forceinline__ void stage_rc(int b, int& R, int& C) { const int st = b / 1024, sb = b % 1024, swz = sb ^ (((sb >> 9) & 1) << 5); R = (st >> 1) * 16 + swz / 64; C = (st & 1) * 32 + (swz % 64) / 2; }
__host__ __device__ __forceinline__ int perm32(int rho) { const int n = rho >> 4, i = rho & 15; return 8 * (i >> 2) + 4 * n + (i & 3); }

struct Unit { int pm, pn; };

template <class Epi, class Sched>
DI void gemm_phase(LAS unsigned char* lds, const Sched& S, const Epi& E) {
    const int tid = threadIdx.x, wid = __builtin_amdgcn_readfirstlane(tid >> 6), lane = tid & 63, wr = wid >> 2, wc = wid & 3, fr = lane & 15, fq = lane >> 4;
    constexpr int K = GK, nt = K / BK;
    unsigned voffA[2], voffB[2];
#pragma unroll
    for (int i = 0; i < 2; ++i) { int R, C; stage_rc(tid * 16 + i * 8192, R, C); const int Rb = Epi::PERM ? ((R & ~31) + perm32(R & 31)) : R;
        voffA[i] = (unsigned)(R * K + C) * 2u; voffB[i] = (unsigned)(Rb * K + C) * 2u; }
    const size_t kstep = (size_t)(BK * 2);
    const size_t hstep = (size_t)HALF * K * 2;
    const unsigned ldsw = (unsigned)wid * 1024u;
    const int aoff = lds_byte(wr * 64 + fr, fq * 8), boff = lds_byte(wc * 32 + fr, fq * 8);
#define PG8_SA(b, h) (((b) * 2 + (h)) * HTB)
#define PG8_SB(b, h) ((4 + (b) * 2 + (h)) * HTB)
#define PG8_STAGE(bufoff, gbase, voff) do { _Pragma("unroll") for (int _i = 0; _i < 2; ++_i) \
        __builtin_amdgcn_global_load_lds((const unsigned*)((const char*)(gbase) + (voff)[_i]), (LAS unsigned*)(lds + (bufoff) + ldsw + _i * 8192), 16, 0, 0); } while (0)
#define PG8_LDA(dst, b, h) do { _Pragma("unroll") for (int m = 0; m < 4; ++m) _Pragma("unroll") for (int k = 0; k < 2; ++k) dst[m][k] = *(const LAS bf16x8*)(lds + PG8_SA(b, h) + aoff + m * 2048 + k * 1024); } while (0)
#define PG8_LDB(dst, b, h) do { _Pragma("unroll") for (int n = 0; n < 2; ++n) _Pragma("unroll") for (int k = 0; k < 2; ++k) dst[n][k] = *(const LAS bf16x8*)(lds + PG8_SB(b, h) + boff + n * 2048 + k * 1024); } while (0)
#define PG8_MMA(ai, bj, At, Bt) do { __builtin_amdgcn_s_setprio(1); _Pragma("unroll") for (int m = 0; m < 4; ++m) _Pragma("unroll") for (int n = 0; n < 2; ++n) _Pragma("unroll") for (int k = 0; k < 2; ++k) \
        acc[ai][bj][m][n] = __builtin_amdgcn_mfma_f32_16x16x32_bf16(Bt[n][k], At[m][k], acc[ai][bj][m][n], 0, 0, 0); __builtin_amdgcn_s_setprio(0); } while (0)
#define PG8_WAIT_V(n) asm volatile("s_waitcnt vmcnt(" #n ")" ::: "memory")
#define PG8_WAIT_L(n) asm volatile("s_waitcnt lgkmcnt(" #n ")" ::: "memory")
#define PG8_BAR __builtin_amdgcn_s_barrier()
#define PG8_SCHED __builtin_amdgcn_sched_barrier(0)
    Unit cur, nxt; int ui = 0;
    if (!S.next(0, cur)) return;
    f32x4 acc[2][2][4][2];
#pragma unroll
    for (int a = 0; a < 2; ++a)
#pragma unroll
        for (int b = 0; b < 2; ++b)
#pragma unroll
            for (int m = 0; m < 4; ++m)
#pragma unroll
                for (int n = 0; n < 2; ++n) acc[a][b][m][n] = (f32x4){0.f, 0.f, 0.f, 0.f};
    bf16x8 At[4][2], B0[2][2], B1[2][2];
    const char* cA = S.aptr(cur); const char* cB = S.bptr(cur);
    PG8_STAGE(PG8_SB(0, 0), cB, voffB); PG8_STAGE(PG8_SB(0, 1), cB + hstep, voffB); PG8_STAGE(PG8_SA(0, 0), cA, voffA); PG8_STAGE(PG8_SA(0, 1), cA + hstep, voffA);
    if (wr == 1) PG8_BAR;
    PG8_WAIT_V(2); PG8_BAR;
    PG8_STAGE(PG8_SB(1, 0), cB + kstep, voffB); PG8_STAGE(PG8_SA(1, 0), cA + kstep, voffA); PG8_STAGE(PG8_SB(1, 1), cB + hstep + kstep, voffB);
    PG8_WAIT_V(6); PG8_BAR;
    for (;;) {
        const bool has_next = S.next(ui + 1, nxt);
        const char* nA = has_next ? S.aptr(nxt) : cA; const char* nB = has_next ? S.bptr(nxt) : cB;
        for (int t = 0; t < nt; t += 2) {
            const bool last = (t == nt - 2);
            const char* a1 = cA + (size_t)(t + 1) * kstep;
            const char* a2 = last ? nA : cA + (size_t)(t + 2) * kstep; const char* b2 = last ? nB : cB + (size_t)(t + 2) * kstep;
            const char* a3 = a2 + kstep; const char* b3 = b2 + kstep;
            PG8_LDB(B0, 0, 0); PG8_LDB(B1, 0, 1); PG8_SCHED; PG8_LDA(At, 0, 0); PG8_STAGE(PG8_SA(1, 1), a1 + hstep, voffA);
            PG8_WAIT_V(8); PG8_WAIT_L(0); PG8_BAR; PG8_MMA(0, 0, At, B0); PG8_MMA(0, 1, At, B1); PG8_BAR; PG8_SCHED;
            PG8_LDA(At, 0, 1); PG8_STAGE(PG8_SB(0, 0), b2, voffB); PG8_STAGE(PG8_SB(0, 1), b2 + hstep, voffB); PG8_STAGE(PG8_SA(0, 0), a2, voffA);
            PG8_WAIT_V(8); PG8_WAIT_L(0); PG8_BAR; PG8_MMA(1, 0, At, B0); PG8_MMA(1, 1, At, B1); PG8_BAR; PG8_SCHED;
            PG8_LDB(B0, 1, 0); PG8_LDB(B1, 1, 1); PG8_SCHED; PG8_LDA(At, 1, 0); PG8_STAGE(PG8_SA(0, 1), a2 + hstep, voffA);
            PG8_WAIT_V(8); PG8_WAIT_L(0); PG8_BAR; PG8_MMA(0, 0, At, B0); PG8_MMA(0, 1, At, B1); PG8_BAR; PG8_SCHED;
            PG8_LDA(At, 1, 1); PG8_STAGE(PG8_SB(1, 0), b3, voffB); PG8_STAGE(PG8_SB(1, 1), b3 + hstep, voffB); PG8_STAGE(PG8_SA(1, 0), a3, voffA);
            PG8_WAIT_V(8); PG8_WAIT_L(0); PG8_BAR; PG8_MMA(1, 0, At, B0); PG8_MMA(1, 1, At, B1); PG8_BAR; PG8_SCHED;
        }
        if (wr == 0) PG8_BAR;
        E(acc, cur, wr, wc, fr, fq);
        if (!has_next) break;
#pragma unroll
        for (int a = 0; a < 2; ++a)
#pragma unroll
            for (int b = 0; b < 2; ++b)
#pragma unroll
                for (int m = 0; m < 4; ++m)
#pragma unroll
                    for (int n = 0; n < 2; ++n) acc[a][b][m][n] = (f32x4){0.f, 0.f, 0.f, 0.f};
        cur = nxt; cA = nA; cB = nB; ++ui;
        if (wr == 1) PG8_BAR;
    }
    PG8_WAIT_V(0);
    PG8_BAR;
#undef PG8_SA
#undef PG8_SB
#undef PG8_STAGE
#undef PG8_LDA
#undef PG8_LDB
#undef PG8_MMA
#undef PG8_WAIT_V
#undef PG8_WAIT_L
#undef PG8_BAR
#undef PG8_SCHED
}
}

struct InSched {
    const char* XN; const char* WT; int c, G;
    DI bool next(int i, pg8::Unit& u) const {
        const long L = (long)i * G + c;
        if (L < 2048) {
            int wgid = (int)L; wgid = (wgid & 7) * 256 + (wgid >> 3);
            const int gid = wgid >> 7, rem = wgid & 127, vs = rem >> 3;
            u.pm = gid * 8 + (rem & 7); u.pn = vs < 14 ? vs : vs + 2; return true;
        }
        if (L < 2176) { const int l2 = (int)L - 2048; u.pm = 128 + (l2 & 15); const int j = l2 >> 4; u.pn = j < 2 ? 2 + j : 10 + j; return true; }
        return false;
    }
    DI const char* aptr(const pg8::Unit& u) const { return u.pn < 12 ? XN + (size_t)u.pm * (256 * 1024 * 2) : WT + (size_t)u.pn * (256 * 1024 * 2); }
    DI const char* bptr(const pg8::Unit& u) const { return u.pn < 12 ? WT + (size_t)u.pn * (256 * 1024 * 2) : XN + (size_t)u.pm * (256 * 1024 * 2); }
};
struct EpiIn {
    static constexpr bool PERM = true;
    bf16_t *P, *KT, *PT; const float *COS, *SIN, *COST, *SINT; LAS unsigned char* scr;
    DI void operator()(const f32x4 (&acc)[2][2][4][2], const pg8::Unit& u, int wr, int wc, int fr_, int fq_) const {
        int fr = fr_, fq = fq_; asm volatile("" : "+v"(fr), "+v"(fq));
        const int vn = u.pn, pm = u.pm;
        if (vn < 12) {
            const int rowb = pm * 256 + wr * 64 + fr;
            if (vn == 2 || vn == 3) {
                const int colk = (vn - 2) * 256 + wc * 32 + 8 * fq;
#pragma unroll
                for (int ai = 0; ai < 2; ++ai)
#pragma unroll
                    for (int m = 0; m < 4; ++m) {
                        const int tok = rowb + ai * 128 + m * 16;
#pragma unroll
                        for (int bj = 0; bj < 2; ++bj) {
                            const int col = colk + bj * 128, hh = col >> 6, ks = (col >> 5) & 1, gg = (col >> 3) & 3;
                            const f32x4 v0 = acc[ai][bj][m][0], v1 = acc[ai][bj][m][1];
                            u32x4 w; w.x = cvt_pk_bf16(v0[0], v0[1]); w.y = cvt_pk_bf16(v0[2], v0[3]); w.z = cvt_pk_bf16(v1[0], v1[1]); w.w = cvt_pk_bf16(v1[2], v1[3]);
                            *(u32x4*)((char*)KT + (size_t)((tok >> 3) * 8 + hh) * 1024 + ks * 512 + (gg * 8 + (tok & 7)) * 16) = w;
                        }
                    }
                return;
            }
            bf16_t* base = P; const int ldc = LDP;
            const int col0 = (vn < 2 ? vn : vn - 2) * 256 + wc * 32 + 8 * fq;
            const bool rot = (vn >= 6 && vn < 10);
            const int i0 = 16 * wc + 4 * fq;
#pragma unroll
            for (int ai = 0; ai < 2; ++ai)
#pragma unroll
                for (int m = 0; m < 4; ++m) {
                    const int row = rowb + ai * 128 + m * 16;
                    f32x4 c4 = {1.f, 1.f, 1.f, 1.f}, s4 = {0.f, 0.f, 0.f, 0.f};
                    if (rot) { const int t = row & 2047; c4 = *(const f32x4*)(COS + t * 64 + i0); s4 = *(const f32x4*)(SIN + t * 64 + i0); }
                    bf16_t* rowp = base + (size_t)row * ldc + col0;
#pragma unroll
                    for (int bj = 0; bj < 2; ++bj) {
                        const f32x4 v0 = acc[ai][bj][m][0], v1 = acc[ai][bj][m][1];
                        const f32x4 o0 = v0 * c4 - v1 * s4, o1 = v0 * s4 + v1 * c4;
                        u32x4 w; w.x = cvt_pk_bf16(o0[0], o0[1]); w.y = cvt_pk_bf16(o0[2], o0[3]); w.z = cvt_pk_bf16(o1[0], o1[1]); w.w = cvt_pk_bf16(o1[2], o1[3]);
                        {
                            LAS unsigned char* tbw = scr + 5120 + (wr * 4 + wc) * 2304;
                            const int ln = fr + 16 * fq;
                            *(LAS u32x4*)(tbw + fr * 80 + fq * 16) = w;
                            const u32x4 wt = *(const LAS u32x4*)(tbw + (ln >> 2) * 80 + (ln & 3) * 16);
                            *(u32x4*)(base + (size_t)(row - fr + (ln >> 2)) * ldc + (col0 - 8 * fq) + bj * 128 + (ln & 3) * 8) = wt;
                        }
                        if (vn == 8 || vn == 9) {
                            unsigned short* r0 = (unsigned short*)((char*)PT + (size_t)512 * LDT * 2 + ((size_t)(row >> 3) * 1024 + ((vn - 8) * 2 + bj) * 128 + 32 * wc + 4 * fq) * 16 + (row & 7) * 2);
                            r0[0] = (unsigned short)(w.x & 0xffffu); r0[8] = (unsigned short)(w.x >> 16); r0[16] = (unsigned short)(w.y & 0xffffu); r0[24] = (unsigned short)(w.y >> 16);
                            r0[128] = (unsigned short)(w.z & 0xffffu); r0[136] = (unsigned short)(w.z >> 16); r0[144] = (unsigned short)(w.w & 0xffffu); r0[152] = (unsigned short)(w.w >> 16);
                        }
                    }
                }
        } else {
            const int frow0 = (vn - 12) * 256 + wr * 64 + fr;
            const int tok0 = pm * 256 + wc * 32 + 8 * fq;
            const bool rot = (vn == 14 || vn == 15) && pm < 128;
            if (vn < 14) {
#pragma unroll
                for (int ai = 0; ai < 2; ++ai)
#pragma unroll
                    for (int bj = 0; bj < 2; ++bj)
#pragma unroll
                        for (int m = 0; m < 4; ++m) {
                            const int f = frow0 + ai * 128 + m * 16, tok = tok0 + bj * 128;
                            const f32x4 v0 = acc[ai][bj][m][0], v1 = acc[ai][bj][m][1];
                            u32x4 w; w.x = cvt_pk_bf16(v0[0], v0[1]); w.y = cvt_pk_bf16(v0[2], v0[3]); w.z = cvt_pk_bf16(v1[0], v1[1]); w.w = cvt_pk_bf16(v1[2], v1[3]);
                            *(u32x4*)((char*)PT + (size_t)((tok >> 3) * 8 + (f >> 6)) * 1024 + (f & 63) * 16) = w;
                        }
                return;
            }
#pragma unroll
            for (int ai = 0; ai < 2; ++ai)
#pragma unroll
                for (int bj = 0; bj < 2; ++bj)
#pragma unroll
                    for (int mp = 0; mp < 2; ++mp) {
                        const int tok = tok0 + bj * 128;
                        f32x4 ca = {1.f, 1.f, 1.f, 1.f}, cb = ca, sa = {0.f, 0.f, 0.f, 0.f}, sb = sa;
                        if (rot) { const int i = 32 * wr + 16 * mp + fr, t = tok & 2047;
                            ca = *(const f32x4*)(COST + i * 2048 + t); cb = *(const f32x4*)(COST + i * 2048 + t + 4);
                            sa = *(const f32x4*)(SINT + i * 2048 + t); sb = *(const f32x4*)(SINT + i * 2048 + t + 4); }
                        const f32x4 x1a = acc[ai][bj][2 * mp][0], x1b = acc[ai][bj][2 * mp][1], x2a = acc[ai][bj][2 * mp + 1][0], x2b = acc[ai][bj][2 * mp + 1][1];
                        const f32x4 o1a = x1a * ca - x2a * sa, o1b = x1b * cb - x2b * sb, o2a = x1a * sa + x2a * ca, o2b = x1b * sb + x2b * cb;
                        char* r1 = (char*)PT + (size_t)512 * LDT * 2 + ((size_t)(tok >> 3) * 1024 + (frow0 - 512 + ai * 128 + (2 * mp) * 16)) * 16;
                        char* r2 = r1 + 16 * 16;
                        u32x4 w; w.x = cvt_pk_bf16(o1a[0], o1a[1]); w.y = cvt_pk_bf16(o1a[2], o1a[3]); w.z = cvt_pk_bf16(o1b[0], o1b[1]); w.w = cvt_pk_bf16(o1b[2], o1b[3]);
                        *(u32x4*)r1 = w;
                        w.x = cvt_pk_bf16(o2a[0], o2a[1]); w.y = cvt_pk_bf16(o2a[2], o2a[3]); w.z = cvt_pk_bf16(o2b[0], o2b[1]); w.w = cvt_pk_bf16(o2b[2], o2b[3]);
                        *(u32x4*)r2 = w;
                    }
        }
    }
};
struct OutSched {
    const char* Y; const char* WOT; int c, G;
    DI bool next(int i, pg8::Unit& u) const {
        const long L = (long)i * G + c; if (L >= 512) return false;
        u.pm = (int)(L >> 2); u.pn = (int)(L & 3); return true;
    }
    DI const char* aptr(const pg8::Unit& u) const { return Y + (size_t)u.pm * (256 * 1024 * 2); }
    DI const char* bptr(const pg8::Unit& u) const { return WOT + (size_t)u.pn * (256 * 1024 * 2); }
};
struct EpiOutF {
    static constexpr bool PERM = false;
    const float* x; const float* MOD; const float* gfin; float* out; float* xbuf; unsigned* cnt; LAS unsigned char* scr;
    DI void operator()(f32x4 (&acc)[2][2][4][2], const pg8::Unit& u, int wr, int wc, int fr_, int fq_) const {
        int fr = fr_, fq = fq_, tid = threadIdx.x;
        asm volatile("" : "+v"(fr), "+v"(fq), "+v"(tid));
        const int b = u.pm >> 3;
        const int col0 = u.pn * 256 + wc * 32 + 4 * fq;
        LAS float* P4s = (LAS float*)scr;
        LAS float* S = (LAS float*)(scr + 4096);
        f32x4 gt[2][2];
#pragma unroll
        for (int bj = 0; bj < 2; ++bj)
#pragma unroll
            for (int n = 0; n < 2; ++n) gt[bj][n] = *(const f32x4*)(MOD + b * 3072 + 2048 + col0 + bj * 128 + n * 16);
        int lane = fr + 16 * fq; const int rr = lane >> 3, pz = lane & 7;
        LAS unsigned char* tb = scr + 5120 + (wr * 4 + wc) * 2304;
        f32x4 xv[3][2][2];
        const float* xg = x + (size_t)(u.pm * 256 + wr * 64 + rr) * DM + u.pn * 256 + wc * 32 + pz * 4;
#define EPF_LOADX(B, ai_, m_) do { _Pragma("unroll") for (int bj = 0; bj < 2; ++bj) _Pragma("unroll") for (int k = 0; k < 2; ++k) \
            xv[B][bj][k] = *(const f32x4*)(xg + (size_t)((ai_) * 128 + (m_) * 16 + 8 * k) * DM + bj * 128); } while (0)
        EPF_LOADX(0, 0, 0); EPF_LOADX(1, 0, 1);
#pragma unroll
        for (int im = 0; im < 8; ++im) {
            const int ai = im >> 2, m = im & 3;
            if (im + 2 < 8) EPF_LOADX((im + 2) % 3, (im + 2) >> 2, (im + 2) & 3);
            __builtin_amdgcn_sched_barrier(0);
            float q0 = 0.f, q1 = 0.f; f32x4 uu[2];
#pragma unroll
            for (int bj = 0; bj < 2; ++bj) {
#pragma unroll
                for (int n = 0; n < 2; ++n) *(LAS f32x4*)(tb + fr * 144 + (16 * n + 4 * fq) * 4) = gt[bj][n] * acc[ai][bj][m][n];
#pragma unroll
                for (int k = 0; k < 2; ++k) {
                    const f32x4 t = *(const LAS f32x4*)(tb + (rr + 8 * k) * 144 + pz * 16);
                    const f32x4 v = xv[im % 3][bj][k] + t;
                    const float d = (v[0] * v[0] + v[1] * v[1]) + (v[2] * v[2] + v[3] * v[3]);
                    if (k == 0) q0 += d; else q1 += d;
                    uu[k] = v;
                }
                acc[ai][bj][m][0] = uu[0]; acc[ai][bj][m][1] = uu[1];
            }
            q0 += __shfl_xor(q0, 1); q1 += __shfl_xor(q1, 1); q0 += __shfl_xor(q0, 2); q1 += __shfl_xor(q1, 2); q0 += __shfl_xor(q0, 4); q1 += __shfl_xor(q1, 4);
            if (pz == 0) { P4s[(ai * 128 + wr * 64 + m * 16 + rr) * 4 + wc] = q0; P4s[(ai * 128 + wr * 64 + m * 16 + rr + 8) * 4 + wc] = q1; }
            __builtin_amdgcn_sched_barrier(0);
        }
#undef EPF_LOADX
        asm volatile("s_waitcnt lgkmcnt(0)" ::: "memory"); __builtin_amdgcn_s_barrier(); asm volatile("" ::: "memory");
        float* slot = xbuf + ((size_t)u.pm * 256) * 4;
        unsigned* pc = cnt + 64 * u.pm;
        if (tid < 256) {
            const float t = (P4s[tid * 4 + 0] + P4s[tid * 4 + 1]) + (P4s[tid * 4 + 2] + P4s[tid * 4 + 3]);
            __hip_atomic_store(slot + tid * 4 + u.pn, t, __ATOMIC_RELAXED, __HIP_MEMORY_SCOPE_AGENT);
            asm volatile("s_waitcnt vmcnt(0)" ::: "memory");
            if ((tid & 63) == 0) __hip_atomic_fetch_add(pc, 1u, __ATOMIC_RELAXED, __HIP_MEMORY_SCOPE_AGENT);
        }
        if (tid < 64) {
            unsigned sp = 0;
            while ((unsigned)__builtin_amdgcn_readfirstlane(__hip_atomic_load(pc, __ATOMIC_RELAXED, __HIP_MEMORY_SCOPE_AGENT)) < 16u) {
                __builtin_amdgcn_s_sleep(2); if (++sp > (1u << 20)) break; }
            __builtin_amdgcn_fence(__ATOMIC_ACQUIRE, "agent");
        }
        asm volatile("s_waitcnt vmcnt(0) lgkmcnt(0)" ::: "memory"); __builtin_amdgcn_s_barrier(); asm volatile("" ::: "memory");
        if (tid < 256) {
            float tot = 0.f;
#pragma unroll
            for (int t = 0; t < 4; ++t) tot += __hip_atomic_load(slot + tid * 4 + t, __ATOMIC_RELAXED, __HIP_MEMORY_SCOPE_AGENT);
            S[tid] = rsqrtf(tot * (1.f / DM) + EPSN);
        }
        asm volatile("s_waitcnt lgkmcnt(0)" ::: "memory"); __builtin_amdgcn_s_barrier(); asm volatile("" ::: "memory");
        f32x4 gf[2];
#pragma unroll
        for (int bj = 0; bj < 2; ++bj) gf[bj] = *(const f32x4*)(gfin + u.pn * 256 + bj * 128 + wc * 32 + pz * 4);
#pragma unroll
        for (int ai = 0; ai < 2; ++ai)
#pragma unroll
            for (int m = 0; m < 4; ++m)
#pragma unroll
                for (int k = 0; k < 2; ++k) {
                    const int r = ai * 128 + wr * 64 + m * 16 + rr + 8 * k; const float rs = S[r];
                    float* orow = out + (size_t)(u.pm * 256 + r) * DM + u.pn * 256 + wc * 32 + pz * 4;
#pragma unroll
                    for (int bj = 0; bj < 2; ++bj) *(f32x4*)(orow + bj * 128) = acc[ai][bj][m][k] * rs * gf[bj];
                }
        asm volatile("s_waitcnt lgkmcnt(0)" ::: "memory"); __builtin_amdgcn_s_barrier(); asm volatile("" ::: "memory");
    }
};

DI void wt_src(int np, int& src, float& sc) {
    const int vn = np >> 8; sc = 1.f;
    if (vn < 2) { src = np; sc = 0.125f * LOG2E; }
    else if (vn < 4) { src = np; }
    else if (vn < 6) { src = 1536 + (np - 1024); }
    else if (vn < 10) { const int hl = (np - 1536) & 511, head = hl >> 7, p = hl & 127, half = (p >> 2) & 1, i = 4 * (p >> 3) + (p & 3);
        src = (vn < 8 ? 2048 : 2560) + head * 128 + 64 * half + i; if (vn >= 8) sc = KSCALE; }
    else if (vn < 12) { src = 3584 + (np - 2560); }
    else if (vn < 14) { src = 1024 + (np - 3072); }
    else if (vn < 16) { const int hl = np - 3584, head = hl >> 7, p = hl & 127, half = (p >> 4) & 1, i = 16 * (p >> 5) + (p & 15);
        src = 2560 + head * 128 + 64 * half + i; sc = KSCALE; }
    else { src = 3072 + (np - 4096); }
}
DI void p0_transpose_item(const float* W, int N, bool is_in, bf16_t* WT, LAS float* scr, int item, int lane) {
    const int nblk = is_in ? (NWT / 32) : 32, kb = item / nblk, nb = item % nblk, k0 = 64 * kb, n0 = 32 * nb;
    int src; float sc;
    if (is_in) wt_src(n0 + (lane & 31), src, sc); else { src = n0 + (lane & 31); sc = 1.f; }
#pragma unroll 8
    for (int i = 0; i < 32; ++i) { const int kk = 2 * i + (lane >> 5); scr[kk * 33 + (lane & 31)] = W[(size_t)(k0 + kk) * N + src] * sc; }
    asm volatile("s_waitcnt lgkmcnt(0)" ::: "memory");
    const int c = lane & 7;
#pragma unroll
    for (int j = 0; j < 4; ++j) { const int n = (lane >> 3) + 8 * j; const LAS float* s = scr + (8 * c) * 33 + n;
        u32x4 o; o.x = cvt_pk_bf16(s[0 * 33], s[1 * 33]); o.y = cvt_pk_bf16(s[2 * 33], s[3 * 33]); o.z = cvt_pk_bf16(s[4 * 33], s[5 * 33]); o.w = cvt_pk_bf16(s[6 * 33], s[7 * 33]);
        *(u32x4*)(WT + (size_t)(n0 + n) * 1024 + k0 + 8 * c) = o; }
    asm volatile("s_waitcnt lgkmcnt(0)" ::: "memory");
}
DI void p0_gemv_item(const Params& p, float* MODP, LAS float* scr, int item, int lane) {
    const int q = item / 48, cgp = item % 48, col = cgp * 64 + lane;
    float acc[17];
#pragma unroll
    for (int bb = 0; bb < 17; ++bb) acc[bb] = 0.f;
    for (int kc = 0; kc < 4; ++kc) {
        const int kbase = q * 64 + kc * 16;
#pragma unroll
        for (int u = 0; u < 5; ++u) { const int idx = lane + 64 * u;
            if (idx < 272) { const int kk = idx / 17, bb = idx - kk * 17; const float v = bb < 16 ? p.c[bb * 1024 + kbase + kk] : p.c_ctx[kbase + kk]; scr[idx] = silu_f(v); } }
        asm volatile("s_waitcnt lgkmcnt(0)" ::: "memory");
        float wv[16];
#pragma unroll
        for (int kk = 0; kk < 16; ++kk) wv[kk] = p.w_ada[(size_t)(kbase + kk) * 3072 + col];
#pragma unroll
        for (int kk = 0; kk < 16; ++kk) {
#pragma unroll
            for (int bb = 0; bb < 17; ++bb) acc[bb] += scr[kk * 17 + bb] * wv[kk]; }
        asm volatile("s_waitcnt lgkmcnt(0)" ::: "memory");
    }
#pragma unroll
    for (int bb = 0; bb < 17; ++bb) MODP[(q * 17 + bb) * 3072 + col] = acc[bb];
}
DI void phase_p0(const Params& p, LAS unsigned char* lds, int vb, int G) {
    const int tid = threadIdx.x, lane = tid & 63, wave = tid >> 6;
    LAS float* scr = (LAS float*)(lds + wave * 16384);
    const int gw = vb * 8 + wave, NGW = G * 8;
    bf16_t* WT = (bf16_t*)(p.ws + WS_WT); bf16_t* WOT = (bf16_t*)(p.ws + WS_WOT); float* MODP = (float*)(p.ws + WS_MODP);
    constexpr int I_GEMV = 768, I_IN = 16 * (NWT / 32), I_OUT = 16 * 32;
    for (int it = gw; it < I_GEMV + I_IN + I_OUT; it += NGW) {
        if (it < I_GEMV) p0_gemv_item(p, MODP, scr, it, lane);
        else if (it < I_GEMV + I_IN) p0_transpose_item(p.w_in, 4096, true, WT, scr, it - I_GEMV, lane);
        else p0_transpose_item(p.w_out, 1024, false, WOT, scr, it - I_GEMV - I_IN, lane);
    }
    float* COS = (float*)(p.ws + WS_COS); float* SIN = (float*)(p.ws + WS_SIN); float* COST = (float*)(p.ws + WS_COST); float* SINT = (float*)(p.ws + WS_SINT);
    for (int idx = vb * 512 + tid; idx < 2048 * 64; idx += G * 512) {
        const int t = idx >> 6, i = idx & 63, f = i & 31; const float pos = (float)((i < 32) ? (t >> 6) : (t & 63));
        const float inv = exp2f(-(float)f * (13.287712379549449f / 32.f));
        const float ang = pos * inv; const float cs = __cosf(ang), sn = __sinf(ang);
        COS[idx] = cs; SIN[idx] = sn; COST[i * 2048 + t] = cs; SINT[i * 2048 + t] = sn;
    }
}
DI void norm_rows(const Params& p, const float* src, bf16_t* dst, int nrows, int bmod, int lane) {
    const float* MODP = (const float*)(p.ws + WS_MODP);
    f32x4 mul[4], sh[4];
#pragma unroll
    for (int j = 0; j < 4; ++j) { const int col = 4 * lane + 256 * j;
        f32x4 s = *(const f32x4*)(p.b_ada + col), sc = *(const f32x4*)(p.b_ada + 1024 + col);
#pragma unroll 2
        for (int q = 0; q < 16; ++q) { s += *(const f32x4*)(MODP + (q * 17 + bmod) * 3072 + col); sc += *(const f32x4*)(MODP + (q * 17 + bmod) * 3072 + 1024 + col); }
        sh[j] = s; mul[j] = *(const f32x4*)(p.norm_g + col) * (sc + 1.0f); }
    for (int r = 0; r < nrows; r += 2) {
        const f32x4* xr = (const f32x4*)(src + (size_t)r * DM) + lane;
        f32x4 v[2][4]; float sq[2];
#pragma unroll
        for (int q = 0; q < 2; ++q)
#pragma unroll
            for (int j = 0; j < 4; ++j) v[q][j] = xr[q * 256 + 64 * j];
#pragma unroll
        for (int q = 0; q < 2; ++q) { float s = 0.f;
#pragma unroll
            for (int j = 0; j < 4; ++j) s += (v[q][j].x * v[q][j].x + v[q][j].y * v[q][j].y) + (v[q][j].z * v[q][j].z + v[q][j].w * v[q][j].w);
            sq[q] = s; }
#pragma unroll
        for (int o = 1; o < 64; o <<= 1) { sq[0] += __shfl_xor(sq[0], o); sq[1] += __shfl_xor(sq[1], o); }
#pragma unroll
        for (int q = 0; q < 2; ++q) { const float rstd = rsqrtf(sq[q] * (1.f / DM) + EPSN);
            u32x2* o8 = (u32x2*)(dst + (size_t)(r + q) * DM) + lane;
#pragma unroll
            for (int j = 0; j < 4; ++j) { const f32x4 h = v[q][j] * rstd * mul[j] + sh[j]; u32x2 w; w.x = cvt_pk_bf16(h.x, h.y); w.y = cvt_pk_bf16(h.z, h.w); o8[64 * j] = w; } }
    }
}
DI void phase_p0b(const Params& p, int vb, int G) {
    const int tid = threadIdx.x, lane = tid & 63, wave = tid >> 6;
    const int gw = vb * 8 + wave, NGW = G * 8;
    bf16_t* XN = (bf16_t*)(p.ws + WS_XN);
    for (int wv = gw; wv < 2048; wv += NGW) {
        const int b = wv >> 7, r0 = b * 2048 + (wv & 127) * 16;
        norm_rows(p, p.x + (size_t)r0 * DM, XN + (size_t)r0 * DM, 16, b, lane);
    }
    for (int wv = gw; wv < 2048; wv += NGW)
        norm_rows(p, p.ctx + (size_t)(wv * 2) * DM, XN + (size_t)(MLAT + wv * 2) * DM, 2, 16, lane);
    const float* MODP = (const float*)(p.ws + WS_MODP); float* MOD = (float*)(p.ws + WS_MOD);
    for (int idx = vb * 512 + tid; idx < 17 * 3072; idx += G * 512) {
        const int col = idx % 3072;
        float a = p.b_ada[col];
#pragma unroll
        for (int q = 0; q < 16; ++q) a += MODP[q * 17 * 3072 + idx];
        MOD[idx] = a;
    }
}

DI void ret_state_item(const Params& p, int item) {
    const int lane = threadIdx.x & 63, wave = __builtin_amdgcn_readfirstlane(threadIdx.x >> 6);
    const int dvq = item & 3, h = (item >> 2) & 3, b = item >> 4;
    const int dir = wave & 1, mt = wave >> 1, c = lane & 15, g = lane >> 4;
    const bf16_t* PT = (const bf16_t*)(p.ws + WS_PT);
    bf16_t* SO = (bf16_t*)(p.ws + (dir ? WS_SB : WS_SF)) + (size_t)((b * 4 + h) * 16) * 16384;
    const float lg2 = -__expf(dir ? p.dec_b[h] : p.dec_f[h]) * LOG2E;
    float w8[8];
#pragma unroll
    for (int j = 0; j < 8; ++j) w8[j] = ex2(lg2 * (float)(dir ? (8 * g + j) : (31 - 8 * g - j)));
    const float g32 = ex2(lg2 * 32.f);
    const unsigned loff = (unsigned)((g * 1024 + c) * 16);
    const char* RT = (const char*)(p.ws + WS_RT);
    const char* abase = RT + (size_t)(h * 128 + 32 * mt) * 16;
    const char* bbase = RT + (size_t)(512 + h * 128 + 32 * dvq) * 16;
    const int ctxb = MLAT + b * CTXL, latb = b * SEQ;
    f32x4 acc[2][2];
#pragma unroll
    for (int at = 0; at < 2; ++at)
#pragma unroll
        for (int nt = 0; nt < 2; ++nt) acc[at][nt] = (f32x4){0.f, 0.f, 0.f, 0.f};
    bf16x8 fa[2][2][4], fb[2][2][4];
#define RS_TOK(i) (dir ? ((i) < 2 ? ctxb + 128 * (1 - (i)) : latb + 128 * (17 - (i))) : ((i) < 2 ? ctxb + 128 * (i) : latb + 128 * ((i) - 2)))
#define RS_LOAD(B, i) do { const int tb_ = RS_TOK(i); _Pragma("unroll") for (int ks = 0; ks < 4; ++ks) { \
        const size_t to_ = (size_t)((tb_ >> 3) + 4 * ks) * 16384; \
        fa[B][0][ks] = ldg8u((const bf16_t*)(abase + to_), loff); fa[B][1][ks] = ldg8u((const bf16_t*)(abase + to_ + 256), loff); \
        fb[B][0][ks] = ldg8u((const bf16_t*)(bbase + to_), loff); fb[B][1][ks] = ldg8u((const bf16_t*)(bbase + to_ + 256), loff); } } while (0)
#define RS_STORE(i) do { const int n_ = dir ? 17 - (i) : (i) - 2; bf16_t* so_ = SO + (size_t)n_ * 16384; \
        _Pragma("unroll") for (int at = 0; at < 2; ++at) _Pragma("unroll") for (int nt = 0; nt < 2; ++nt) { \
            u32x2 w_; w_.x = cvt_pk_bf16(acc[at][nt][0], acc[at][nt][1]); w_.y = cvt_pk_bf16(acc[at][nt][2], acc[at][nt][3]); \
            *(u32x2*)(so_ + (32 * dvq + 16 * nt + c) * 128 + 32 * mt + 8 * g + 4 * at) = w_; } } while (0)
#define RS_COMPUTE(B) do { _Pragma("unroll") for (int kk = 0; kk < 4; ++kk) { const int ks = dir ? 3 - kk : kk; \
        _Pragma("unroll") for (int at = 0; at < 2; ++at) _Pragma("unroll") for (int nt = 0; nt < 2; ++nt) acc[at][nt] *= g32; \
        _Pragma("unroll") for (int at = 0; at < 2; ++at) { \
            const u32x4 w_ = __builtin_bit_cast(u32x4, fa[B][at][ks]); u32x4 o_; \
            o_.x = cvt_pk_bf16(bflo(w_.x) * w8[0], bfhi(w_.x) * w8[1]); o_.y = cvt_pk_bf16(bflo(w_.y) * w8[2], bfhi(w_.y) * w8[3]); \
            o_.z = cvt_pk_bf16(bflo(w_.z) * w8[4], bfhi(w_.z) * w8[5]); o_.w = cvt_pk_bf16(bflo(w_.w) * w8[6], bfhi(w_.w) * w8[7]); \
            const bf16x8 aw_ = __builtin_bit_cast(bf16x8, o_); \
            acc[at][0] = mfma16(aw_, fb[B][0][ks], acc[at][0]); acc[at][1] = mfma16(aw_, fb[B][1][ks], acc[at][1]); } } } while (0)
    RS_LOAD(0, 0); __builtin_amdgcn_sched_barrier(0);
    for (int i = 0; i < 18; i += 2) {
        if (i + 1 < 17) RS_LOAD(1, i + 1);
        __builtin_amdgcn_sched_barrier(0);
        if (i >= 2) RS_STORE(i);
        if (i < 17) RS_COMPUTE(0);
        if (i + 2 < 17) RS_LOAD(0, i + 2);
        __builtin_amdgcn_sched_barrier(0);
        if (i + 1 >= 2) RS_STORE(i + 1);
        if (i + 1 < 17) RS_COMPUTE(1);
    }
#undef RS_TOK
#undef RS_LOAD
#undef RS_STORE
#undef RS_COMPUTE
}

template <bool LOCAL>
DI void na_step1(const bf16x8 (&kf)[2][2], const bf16x8 (&vf)[4], const bf16x8 (&qf)[2], f32x4 (&O)[4], float& mrun, float& lrun,
                 const LAS float* bp, const f32x4 (&madd)[2]) {
    f32x4 s[2];
    if (LOCAL) {
#pragma unroll
        for (int tau = 0; tau < 2; ++tau) {
            float b0 = bp[4 * tau], b1 = bp[4 * tau + 1], b2 = bp[4 * tau + 2], b3 = bp[4 * tau + 3];
            asm volatile("" : "+v"(b0), "+v"(b1), "+v"(b2), "+v"(b3));
            s[tau] = (f32x4){b0, b1, b2, b3} + madd[tau];
        }
    } else { s[0] = (f32x4){0.f, 0.f, 0.f, 0.f}; s[1] = s[0]; }
#pragma unroll
    for (int tau = 0; tau < 2; ++tau) { s[tau] = mfma16(kf[tau][0], qf[0], s[tau]); s[tau] = mfma16(kf[tau][1], qf[1], s[tau]); }
    float mx = fmaxf(fmaxf(fmaxf(s[0][0], s[0][1]), fmaxf(s[0][2], s[0][3])), fmaxf(fmaxf(s[1][0], s[1][1]), fmaxf(s[1][2], s[1][3])));
    mx = fmaxf(mx, __shfl_xor(mx, 16)); mx = fmaxf(mx, __shfl_xor(mx, 32));
    const float mnew = fmaxf(mrun, mx), alpha = ex2(mrun - mnew);
    mrun = mnew;
    float ps = 0.f;
#pragma unroll
    for (int tau = 0; tau < 2; ++tau)
#pragma unroll
        for (int e = 0; e < 4; ++e) { s[tau][e] = ex2(s[tau][e] - mnew); ps += s[tau][e]; }
    lrun = lrun * alpha + ps;
    u32x4 pw; pw.x = cvt_pk_bf16(s[0][0], s[0][1]); pw.y = cvt_pk_bf16(s[0][2], s[0][3]); pw.z = cvt_pk_bf16(s[1][0], s[1][1]); pw.w = cvt_pk_bf16(s[1][2], s[1][3]);
    const bf16x8 pf = __builtin_bit_cast(bf16x8, pw);
#pragma unroll
    for (int dt = 0; dt < 4; ++dt) { O[dt] *= alpha; O[dt] = mfma16(vf[dt], pf, O[dt]); }
}
DI void na_step2(const bf16x8 (&kf)[2][2], const bf16x8 (&vf)[4], const bf16x8 (&kc)[2][2], const bf16x8 (&vc)[4], const bf16x8 (&qf)[2], f32x4 (&O)[4], float& mrun, float& lrun,
                 const LAS float* bp, const f32x4 (&madd)[2]) {
    f32x4 s[4];
#pragma unroll
    for (int tau = 0; tau < 2; ++tau) {
        float b0 = bp[4 * tau], b1 = bp[4 * tau + 1], b2 = bp[4 * tau + 2], b3 = bp[4 * tau + 3];
        asm volatile("" : "+v"(b0), "+v"(b1), "+v"(b2), "+v"(b3));
        s[tau] = (f32x4){b0, b1, b2, b3} + madd[tau];
        s[2 + tau] = (f32x4){0.f, 0.f, 0.f, 0.f};
    }
#pragma unroll
    for (int tau = 0; tau < 2; ++tau) { s[tau] = mfma16(kf[tau][0], qf[0], s[tau]); s[2 + tau] = mfma16(kc[tau][0], qf[0], s[2 + tau]); }
#pragma unroll
    for (int tau = 0; tau < 2; ++tau) { s[tau] = mfma16(kf[tau][1], qf[1], s[tau]); s[2 + tau] = mfma16(kc[tau][1], qf[1], s[2 + tau]); }
    float mx = fmaxf(fmaxf(fmaxf(s[0][0], s[0][1]), fmaxf(s[0][2], s[0][3])), fmaxf(fmaxf(s[1][0], s[1][1]), fmaxf(s[1][2], s[1][3])));
    mx = fmaxf(mx, fmaxf(fmaxf(fmaxf(s[2][0], s[2][1]), fmaxf(s[2][2], s[2][3])), fmaxf(fmaxf(s[3][0], s[3][1]), fmaxf(s[3][2], s[3][3]))));
    mx = fmaxf(mx, __shfl_xor(mx, 16)); mx = fmaxf(mx, __shfl_xor(mx, 32));
    const float mnew = fmaxf(mrun, mx), alpha = ex2(mrun - mnew);
    mrun = mnew;
    float ps = 0.f;
#pragma unroll
    for (int t = 0; t < 4; ++t)
#pragma unroll
        for (int e = 0; e < 4; ++e) { s[t][e] = ex2(s[t][e] - mnew); ps += s[t][e]; }
    lrun = lrun * alpha + ps;
    u32x4 pw; pw.x = cvt_pk_bf16(s[0][0], s[0][1]); pw.y = cvt_pk_bf16(s[0][2], s[0][3]); pw.z = cvt_pk_bf16(s[1][0], s[1][1]); pw.w = cvt_pk_bf16(s[1][2], s[1][3]);
    const bf16x8 pfl = __builtin_bit_cast(bf16x8, pw);
    pw.x = cvt_pk_bf16(s[2][0], s[2][1]); pw.y = cvt_pk_bf16(s[2][2], s[2][3]); pw.z = cvt_pk_bf16(s[3][0], s[3][1]); pw.w = cvt_pk_bf16(s[3][2], s[3][3]);
    const bf16x8 pfc = __builtin_bit_cast(bf16x8, pw);
#pragma unroll
    for (int dt = 0; dt < 4; ++dt) { O[dt] *= alpha; O[dt] = mfma16(vf[dt], pfl, O[dt]); O[dt] = mfma16(vc[dt], pfc, O[dt]); }
}
DI void na_item(const Params& p, LAS unsigned char* lds, int item) {
    const int tid = threadIdx.x, lane = tid & 63, wave = __builtin_amdgcn_readfirstlane(tid >> 6);
    const int half = item & 1, h = (item >> 1) & 7, b = item >> 4;
    const int j = wave & 3, rr = wave >> 2, c = lane & 15, g = lane >> 4;
    const bf16_t* P = (const bf16_t*)(p.ws + WS_P); const char* KT = (const char*)(p.ws + WS_KT); const char* VT = (const char*)(p.ws + WS_VT);
    bf16_t* Y = (bf16_t*)(p.ws + WS_Y);
    LAS float* rpb = (LAS float*)lds;
    LAS unsigned char* Kc = lds + 4096;
    LAS unsigned char* Vc = lds + 4096 + 32768;
    __syncthreads();
    for (int idx = tid; idx < 15 * 64; idx += 512) { const int dr = idx >> 6, xx = (idx & 63) - 16;
        rpb[idx] = (xx >= 0 && xx < 31) ? p.na_rpb[(h * 15 + dr) * 31 + xx] * LOG2E : 0.f; }
#pragma unroll
    for (int i = 0; i < 4; ++i) { const int idx = tid + 512 * i, blk = idx >> 6, q = idx & 63;
        const size_t tb = (size_t)(((MLAT + b * CTXL) >> 3) + blk) * 8 + h;
        { const int row = blk * 8 + (q & 7), pc = (q >> 5) * 4 + ((q >> 3) & 3);
          *(LAS bf16x8*)(Kc + row * 128 + ((pc ^ (((row >> 1) & 1) | (((row >> 3) & 3) << 1))) << 4)) = *(const bf16x8*)(KT + tb * 1024 + q * 16); }
        { const int row = q, pc = blk;
          *(LAS bf16x8*)(Vc + row * 512 + ((pc ^ (row & 15)) << 4)) = *(const bf16x8*)(VT + tb * 1024 + q * 16); } }
    __syncthreads();
    const int cw0 = (j == 0) ? 0 : (j == 1) ? 8 : (j == 2) ? 24 : 32;
    const int kap0 = 8 * (c >> 2) + (c & 3);
    const int cq = 16 * j + c; int c0 = cq - 8; c0 = c0 < 0 ? 0 : (c0 > 48 ? 48 : c0);
    const LAS float* rpbl = rpb + 16 + (cw0 + 8 * g - cq + 15);
    f32x4 madd[2];
#pragma unroll
    for (int tau = 0; tau < 2; ++tau)
#pragma unroll
        for (int e = 0; e < 4; ++e) { const int ck = cw0 + 8 * g + 4 * tau + e; madd[tau][e] = (ck >= c0 && ck < c0 + 16) ? 0.f : -INFINITY; }
    const unsigned klo = (unsigned)((c >> 2) * 8192 + (g * 8 + (c & 3)) * 16), vlo = (unsigned)(g * 8192 + c * 16);
    const unsigned kcb = (unsigned)(kap0 * 128), vcb = (unsigned)(c * 512);
    unsigned kx[2]; kx[0] = (unsigned)(((g) ^ (c >> 1)) << 4); kx[1] = (unsigned)(((4 + g) ^ (c >> 1)) << 4);
    for (int ui = 0; ui < 8; ++ui) {
        const int rp = 8 * half + ui, r = 2 * rp + rr;
        int r0 = r - 4; r0 = r0 < 0 ? 0 : (r0 > 24 ? 24 : r0);
        const size_t tok = (size_t)(b * SEQ + r * 64 + 16 * j + c);
        bf16x8 qf[2];
#pragma unroll
        for (int ks = 0; ks < 2; ++ks) qf[ks] = ldg8(P + tok * LDP + PC_NAQ + h * 64 + 32 * ks + 8 * g);
        f32x4 O[4]; float mrun = -1e30f, lrun = 0.f;
#pragma unroll
        for (int dt = 0; dt < 4; ++dt) O[dt] = (f32x4){0.f, 0.f, 0.f, 0.f};
        const size_t tb0 = (size_t)(((b * SEQ + r0 * 64 + cw0) >> 3) * 8 + h) * 1024;
        const char* kb0 = KT + tb0; const char* vb0 = VT + tb0;
        const LAS float* bp0 = rpbl + (r0 - r + 7) * 64;
        bf16x8 kf[2][2][2], vf[2][4], kc[2][2], vc[4];
#define NA_LOADL(B, st) do { _Pragma("unroll") for (int tau = 0; tau < 2; ++tau) _Pragma("unroll") for (int ks = 0; ks < 2; ++ks) \
            kf[B][tau][ks] = ldg8u((const bf16_t*)(kb0 + (size_t)(st) * 65536 + ks * 512 + tau * 64), klo); \
            _Pragma("unroll") for (int dt = 0; dt < 4; ++dt) vf[B][dt] = ldg8u((const bf16_t*)(vb0 + (size_t)(st) * 65536 + dt * 256), vlo); } while (0)
#define NA_LOADC(st) do { _Pragma("unroll") for (int tau = 0; tau < 2; ++tau) _Pragma("unroll") for (int ks = 0; ks < 2; ++ks) \
            kc[tau][ks] = *(const LAS bf16x8*)(Kc + kcb + kx[ks] + (32 * (st) + 4 * tau) * 128); \
            { unsigned va_ = vcb + (unsigned)((((4 * (st) + g) ^ c)) << 4); _Pragma("unroll") for (int dt = 0; dt < 4; ++dt) vc[dt] = *(const LAS bf16x8*)(Vc + va_ + (16 * dt) * 512); } } while (0)
        NA_LOADL(0, 0); __builtin_amdgcn_sched_barrier(0);
#pragma unroll 1
        for (int st = 0; st < 8; st += 2) {
            NA_LOADL(1, st + 1); __builtin_amdgcn_sched_barrier(0);
            NA_LOADC(st);
            na_step2(kf[0], vf[0], kc, vc, qf, O, mrun, lrun, bp0 + st * 64, madd);
            if (st + 2 < 8) NA_LOADL(0, st + 2);
            __builtin_amdgcn_sched_barrier(0);
            NA_LOADC(st + 1);
            na_step2(kf[1], vf[1], kc, vc, qf, O, mrun, lrun, bp0 + (st + 1) * 64, madd);
        }
#undef NA_LOADL
#undef NA_LOADC
        lrun += __shfl_xor(lrun, 16); lrun += __shfl_xor(lrun, 32);
        const float inv = __builtin_amdgcn_rcpf(lrun);
#pragma unroll
        for (int dt = 0; dt < 4; ++dt) {
            const f32x4 o = O[dt] * inv;
            const u32x2 gw = *(const u32x2*)(P + tok * LDP + PC_NAG + h * 64 + 16 * dt + 4 * g);
            u32x2 w; w.x = cvt_pk_bf16(o[0] * silu_f(bflo(gw.x)), o[1] * silu_f(bfhi(gw.x))); w.y = cvt_pk_bf16(o[2] * silu_f(bflo(gw.y)), o[3] * silu_f(bfhi(gw.y)));
            *(u32x2*)(Y + tok * DM + h * 64 + 16 * dt + 4 * g) = w;
        }
    }
}

DI void ret_out_phase(const Params& p, LAS unsigned char* lds, int vb, int G) {
    const int tid = threadIdx.x, lane = tid & 63, wave = __builtin_amdgcn_readfirstlane(tid >> 6), c = lane & 15, g = lane >> 4;
    const bf16_t* P = (const bf16_t*)(p.ws + WS_P); const bf16_t* PT = (const bf16_t*)(p.ws + WS_PT);
    const bf16_t* SFg = (const bf16_t*)(p.ws + WS_SF); const bf16_t* SBg = (const bf16_t*)(p.ws + WS_SB); const char* RTg = (const char*)(p.ws + WS_RT);
    bf16_t* Y = (bf16_t*)(p.ws + WS_Y);
    LAS unsigned char* Ks = lds; LAS unsigned char* Vs = lds + 32768; LAS unsigned char* SFs = lds + 65536; LAS unsigned char* SBs = lds + 98304;
    const int prow = tid >> 4, pc = tid & 15;
    const unsigned wK = (unsigned)(prow * 256 + ((pc ^ ((prow & 3) | (((prow >> 3) & 3) << 2))) << 4));
    const unsigned wV = (unsigned)(prow * 256 + ((pc ^ (prow & 15)) << 4));
    unsigned xo[4];
#pragma unroll
    for (int x = 0; x < 4; ++x) xo[x] = (unsigned)((((4 * x + g) ^ c)) << 4);
    const unsigned rK = (unsigned)((8 * (c >> 2) + (c & 3)) * 256), rV = (unsigned)(c * 256);
    bf16x8 st[8];
#define RO_LOAD_KV(uu) do { const int n_ = (uu) & 15, h_ = ((uu) >> 4) & 3, b_ = (uu) >> 6; \
        const bf16_t* kp_ = P + (size_t)(b_ * SEQ + 128 * n_ + prow) * LDP + PC_RK + h_ * 128 + pc * 8; \
        const char* vp_ = RTg + ((size_t)(((b_ * SEQ + 128 * n_) >> 3) + (tid >> 7)) * 1024 + 512 + h_ * 128 + (tid & 127)) * 16; \
        _Pragma("unroll") for (int i = 0; i < 4; ++i) { st[i] = ldg8(kp_ + (size_t)(32 * i) * LDP); st[4 + i] = *(const bf16x8*)(vp_ + (size_t)(4 * i) * 16384); } } while (0)
#define RO_LOAD_S(uu) do { const int n_ = (uu) & 15, h_ = ((uu) >> 4) & 3, b_ = (uu) >> 6; \
        const size_t so_ = (size_t)((b_ * 4 + h_) * 16 + n_) * 16384 + prow * 128 + pc * 8; \
        _Pragma("unroll") for (int i = 0; i < 4; ++i) { st[i] = ldg8(SFg + so_ + (32 * i) * 128); st[4 + i] = ldg8(SBg + so_ + (32 * i) * 128); } } while (0)
#define RO_STORE_KV() do { _Pragma("unroll") for (int i = 0; i < 4; ++i) { \
        *(LAS bf16x8*)(Ks + wK + i * 8192) = st[i]; \
        *(LAS bf16x8*)(Vs + (tid & 127) * 256 + (((((tid >> 7) + 4 * i)) ^ (tid & 15)) << 4)) = st[4 + i]; } } while (0)
#define RO_STORE(A0, W0, A1, W1) do { _Pragma("unroll") for (int i = 0; i < 4; ++i) { \
        *(LAS bf16x8*)((A0) + (W0) + i * 8192) = st[i]; *(LAS bf16x8*)((A1) + (W1) + i * 8192) = st[4 + i]; } } while (0)
    int u = vb;
    if (u < 1024) RO_LOAD_KV(u);
    int hcur = -1; float lgf2 = 0.f, lgb2 = 0.f; f32x4 dec[4][2];
    const int tl = 16 * wave + c;
    for (; u < 1024; u += G) {
        const int n = u & 15, h = (u >> 4) & 3, b = u >> 6;
        const size_t tok = (size_t)(b * SEQ + 128 * n + tl);
        if (h != hcur) { hcur = h; lgf2 = -__expf(p.dec_f[h]) * LOG2E; lgb2 = -__expf(p.dec_b[h]) * LOG2E;
#pragma unroll
            for (int sg = 0; sg < 4; ++sg)
#pragma unroll
                for (int tau = 0; tau < 2; ++tau)
#pragma unroll
                    for (int e = 0; e < 4; ++e) { const int dl_ = tl - (32 * sg + 8 * g + 4 * tau + e);
                        const float lg_ = dl_ > 0 ? lgf2 : lgb2; float d_ = ex2(lg_ * fabsf((float)dl_)); dec[sg][tau][e] = dl_ == 0 ? 2.0f : d_; } }
        RO_STORE_KV();
        RO_LOAD_S(u); __builtin_amdgcn_sched_barrier(0);
        bf16x8 qf[4];
#pragma unroll
        for (int ks = 0; ks < 4; ++ks) qf[ks] = ldg8(P + tok * LDP + PC_RQ + h * 128 + 32 * ks + 8 * g);
        u32x2 gwv[8];
#pragma unroll
        for (int dt = 0; dt < 8; ++dt) gwv[dt] = *(const u32x2*)(P + tok * LDP + PC_RG + h * 128 + 16 * dt + 4 * g);
        __syncthreads();
        f32x4 O[8];
#pragma unroll
        for (int dt = 0; dt < 8; ++dt) O[dt] = (f32x4){0.f, 0.f, 0.f, 0.f};
#pragma unroll
        for (int sg = 0; sg < 4; ++sg) {
            f32x4 s_[2];
#pragma unroll
            for (int tau = 0; tau < 2; ++tau) {
                s_[tau] = (f32x4){0.f, 0.f, 0.f, 0.f};
#pragma unroll
                for (int ks = 0; ks < 4; ++ks) { unsigned a_ = rK + xo[ks]; asm volatile("" : "+v"(a_)); s_[tau] = mfma16(*(const LAS bf16x8*)(Ks + a_ + (32 * sg + 4 * tau) * 256), qf[ks], s_[tau]); }
            }
#pragma unroll
            for (int tau = 0; tau < 2; ++tau) s_[tau] *= dec[sg][tau];
            u32x4 pw_; pw_.x = cvt_pk_bf16(s_[0][0], s_[0][1]); pw_.y = cvt_pk_bf16(s_[0][2], s_[0][3]); pw_.z = cvt_pk_bf16(s_[1][0], s_[1][1]); pw_.w = cvt_pk_bf16(s_[1][2], s_[1][3]);
            const bf16x8 pf = __builtin_bit_cast(bf16x8, pw_);
            unsigned av_ = 32768u + rV + xo[sg]; asm volatile("" : "+v"(av_));
#pragma unroll
            for (int dt = 0; dt < 8; ++dt) O[dt] = mfma16(*(const LAS bf16x8*)(lds + av_ + (16 * dt) * 256), pf, O[dt]);
            __builtin_amdgcn_sched_barrier(0);
        }
        RO_STORE(SFs, wV, SBs, wV);
        if (u + G < 1024) RO_LOAD_KV(u + G);
        __builtin_amdgcn_sched_barrier(0);
        __syncthreads();
        const float cF = ex2(lgf2 * (float)(tl + 1)), cB = ex2(lgb2 * (float)(128 - tl));
#pragma unroll
        for (int ks = 0; ks < 4; ++ks) {
            const bf16x8 qF_ = scale_frag(qf[ks], cF), qB_ = scale_frag(qf[ks], cB);
            unsigned af_ = 65536u + rV + xo[ks], ab_ = 98304u + rV + xo[ks]; asm volatile("" : "+v"(af_), "+v"(ab_));
#pragma unroll
            for (int dt = 0; dt < 8; ++dt) {
                O[dt] = mfma16(*(const LAS bf16x8*)(lds + af_ + (16 * dt) * 256), qF_, O[dt]);
                O[dt] = mfma16(*(const LAS bf16x8*)(lds + ab_ + (16 * dt) * 256), qB_, O[dt]);
            }
            __builtin_amdgcn_sched_barrier(0);
        }
        float ss = 0.f;
#pragma unroll
        for (int dt = 0; dt < 8; ++dt) ss += (O[dt][0] * O[dt][0] + O[dt][1] * O[dt][1]) + (O[dt][2] * O[dt][2] + O[dt][3] * O[dt][3]);
        ss += __shfl_xor(ss, 16); ss += __shfl_xor(ss, 32);
        const float rstd = rsqrtf(ss * (1.f / 128.f) + EPSN);
#pragma unroll
        for (int dt = 0; dt < 8; ++dt) {
            const int dv = 16 * dt + 4 * g;
            const f32x4 gn = *(const f32x4*)(p.ret_norm_g + h * 128 + dv);
            const u32x2 gw = gwv[dt];
            const f32x4 o = O[dt] * rstd * gn;
            u32x2 w; w.x = cvt_pk_bf16(o[0] * silu_f(bflo(gw.x)), o[1] * silu_f(bfhi(gw.x))); w.y = cvt_pk_bf16(o[2] * silu_f(bflo(gw.y)), o[3] * silu_f(bfhi(gw.y)));
            *(u32x2*)(Y + tok * DM + 512 + h * 128 + dv) = w;
        }
    }
#undef RO_LOAD_KV
#undef RO_LOAD_S
#undef RO_STORE
#undef RO_STORE_KV
}

DI void phase_p5(const Params& p, int vb, int G) {
    const int tid = threadIdx.x, lane = tid & 63, wave = tid >> 6;
    const int gw = vb * 8 + wave, NGW = G * 8;
    f32x4 gn[4];
#pragma unroll
    for (int j = 0; j < 4; ++j) gn[j] = *(const f32x4*)(p.final_g + 4 * lane + 256 * j);
    for (int grp = gw; grp < MLAT / 4; grp += NGW) {
        f32x4* xr = (f32x4*)(p.out + (size_t)grp * 4 * DM) + lane;
        f32x4 v[4][4]; float sq[4];
#pragma unroll
        for (int r = 0; r < 4; ++r)
#pragma unroll
            for (int j = 0; j < 4; ++j) v[r][j] = xr[r * 256 + 64 * j];
#pragma unroll
        for (int r = 0; r < 4; ++r) { float s = 0.f;
#pragma unroll
            for (int j = 0; j < 4; ++j) s += (v[r][j].x * v[r][j].x + v[r][j].y * v[r][j].y) + (v[r][j].z * v[r][j].z + v[r][j].w * v[r][j].w);
            sq[r] = s; }
#pragma unroll
        for (int o = 1; o < 64; o <<= 1)
#pragma unroll
            for (int r = 0; r < 4; ++r) sq[r] += __shfl_xor(sq[r], o);
#pragma unroll
        for (int r = 0; r < 4; ++r) { const float rstd = rsqrtf(sq[r] * (1.f / DM) + EPSN);
#pragma unroll
            for (int j = 0; j < 4; ++j) xr[r * 256 + 64 * j] = v[r][j] * rstd * gn[j]; }
    }
}

#define XB_TMO      128
#define XB_XCNT(j)  (256  + 64 * (j))
#define XB_XSUB(j)  (1280 + 64 * (j))
#define XB_XGEN(j)  (2304 + 64 * (j))
#define XB_TOP      3328
#define XB_TOPGEN   3392
#define XCD_BAR_WORDS 3456
#define XB_SPIN_CAP (1u << 18)
DI unsigned xb_ld(unsigned* p)              { return __hip_atomic_load(p, __ATOMIC_RELAXED, __HIP_MEMORY_SCOPE_AGENT); }
DI unsigned xb_add(unsigned* p, unsigned v) { return __hip_atomic_fetch_add(p, v, __ATOMIC_RELAXED, __HIP_MEMORY_SCOPE_AGENT); }
DI unsigned xb_xcc_id() { return (unsigned)__builtin_amdgcn_s_getreg((3 << 11) | 20) & 0xFu; }
#define XB_SPIN(cond, bar) do { unsigned _sp = 0; while (cond) { __builtin_amdgcn_s_sleep(1); \
    if ((++_sp & 255u) == 0u) { if (xb_ld(&(bar)[XB_TMO])) break; if (_sp > XB_SPIN_CAP) { atomicAdd(&(bar)[XB_TMO], 1u); break; } } } } while (0)
struct XcdBarrier { unsigned* bar; unsigned x; volatile LAS unsigned* st; };
DI XcdBarrier xcd_barrier_post(unsigned* bar, volatile LAS unsigned* st) {
    XcdBarrier b; b.bar = bar; b.x = xb_xcc_id(); b.st = st;
    if (threadIdx.x == 0) (void)xb_add(&bar[XB_XCNT(b.x)], 1u);
    return b;
}
DI void xcd_barrier_complete(unsigned* bar, unsigned x, unsigned& nloc, unsigned& nx) {
    const unsigned G = gridDim.x * gridDim.y * gridDim.z;
    unsigned sum, cnt, mine, sp = 0u;
    for (;;) {
        sum = 0u; cnt = 0u; mine = 0u;
#pragma unroll
        for (unsigned j = 0; j < 16; ++j) { const unsigned c = xb_ld(&bar[XB_XCNT(j)]); sum += c; cnt += (c > 0u) ? 1u : 0u; mine = (j == x) ? c : mine; }
        if (sum == G) break;
        __builtin_amdgcn_s_sleep(1);
        if ((++sp & 255u) == 0u) { if (xb_ld(&bar[XB_TMO])) break; if (sp > XB_SPIN_CAP) { atomicAdd(&bar[XB_TMO], 1u); break; } }
    }
    nloc = mine > 0u ? mine : 1u; nx = cnt > 0u ? cnt : 1u;
}
DI void xcd_barrier(const XcdBarrier& b) {
    asm volatile("s_waitcnt vmcnt(0)" ::: "memory");
    __syncthreads();
    if (threadIdx.x == 0) {
        unsigned* bar = b.bar;
        __builtin_amdgcn_s_waitcnt(0);
        unsigned nloc = b.st[0], nx = b.st[1];
        if (nloc == 0u) { xcd_barrier_complete(bar, b.x, nloc, nx); b.st[0] = nloc; b.st[1] = nx; }
        const unsigned old = xb_add(&bar[XB_XSUB(b.x)], 1u);
        const unsigned gen = old / nloc;
        if (old + 1u == (gen + 1u) * nloc) {
            __builtin_amdgcn_fence(__ATOMIC_RELEASE, "agent");
            asm volatile("s_waitcnt vmcnt(0)" ::: "memory");
            const unsigned og = xb_add(&bar[XB_TOP], 1u);
            const unsigned tg = og / nx;
            if (og + 1u == (tg + 1u) * nx) xb_add(&bar[XB_TOPGEN], 1u);
            else XB_SPIN(xb_ld(&bar[XB_TOPGEN]) == tg, bar);
            __builtin_amdgcn_fence(__ATOMIC_ACQUIRE, "agent");
            xb_add(&bar[XB_XGEN(b.x)], 1u);
            asm volatile("s_waitcnt vmcnt(0)" ::: "memory");
        } else {
            XB_SPIN(xb_ld(&bar[XB_XGEN(b.x)]) == gen, bar);
            __builtin_amdgcn_fence(__ATOMIC_ACQUIRE, "agent");
            asm volatile("s_waitcnt vmcnt(0)" ::: "memory");
        }
    }
    __syncthreads();
}
__global__ void __launch_bounds__(512, 2) mega_fwd(Params p) {
    extern __shared__ __attribute__((aligned(16))) unsigned char lds_raw[];
    LAS unsigned char* lds = (LAS unsigned char*)lds_raw;
    const int G = gridDim.x, bx = blockIdx.x;
    const int vb = (G % 8 == 0) ? (bx % 8) * (G / 8) + bx / 8 : bx;
    const int tid = threadIdx.x;
    volatile LAS unsigned* MISC = (volatile LAS unsigned*)(lds + 131072);
    if (tid < 16) MISC[tid] = 0u;
    __syncthreads();
    (void)xcd_barrier_post((unsigned*)p.ws, MISC);
#define GRID_BAR() do { XcdBarrier b_; b_.bar = (unsigned*)p.ws; b_.x = xb_xcc_id(); b_.st = (volatile LAS unsigned*)(lds + 131072); xcd_barrier(b_); } while (0)

#ifndef REPMASK
#define REPMASK 0
#endif
#define PH_P0()  phase_p0(p, lds, vb, G)
#define PH_P0B() phase_p0b(p, vb, G)
#define PH_P1()  do { InSched S{(const char*)(p.ws + WS_XN), (const char*)(p.ws + WS_WT), bx, G}; \
        EpiIn E{(bf16_t*)(p.ws + WS_P), (bf16_t*)(p.ws + WS_KT), (bf16_t*)(p.ws + WS_PT), (const float*)(p.ws + WS_COS), (const float*)(p.ws + WS_SIN), (const float*)(p.ws + WS_COST), (const float*)(p.ws + WS_SINT), lds + 131072 + 256}; \
        pg8::gemm_phase<EpiIn, InSched>(lds, S, E); } while (0)
#define PH_R1()  do { for (int it = vb; it < 256; it += G) ret_state_item(p, it); } while (0)
#define PH_NA()  do { for (int it = vb; it < 256; it += G) na_item(p, lds, it); } while (0)
#define PH_R2()  ret_out_phase(p, lds, vb, G)
#define PH_P4()  do { OutSched S{(const char*)(p.ws + WS_Y), (const char*)(p.ws + WS_WOT), vb, G}; \
        EpiOutF E{p.x, (const float*)(p.ws + WS_MOD), p.final_g, p.out, (float*)(p.ws + WS_XBUF), (unsigned*)(p.ws + WS_CNT), lds + 131072 + 256}; \
        pg8::gemm_phase<EpiOutF, OutSched>(lds, S, E); } while (0)
    PH_P0();
#if REPMASK & 1
    PH_P0();
#endif
    GRID_BAR();
    PH_P0B();
#if REPMASK & 2
    PH_P0B();
#endif
    GRID_BAR();
    PH_P1();
#if REPMASK & 4
    PH_P1();
#endif
    GRID_BAR();
    PH_R1();
#if REPMASK & 8
    PH_R1();
#endif
    PH_NA();
#if REPMASK & 16
    PH_NA();
#endif
    GRID_BAR();
    PH_R2();
#if REPMASK & 32
    PH_R2();
#endif
    GRID_BAR();
    PH_P4();
}

extern "C" void kernel_launch(void* const* d_in, const int* in_sizes, int n_in, void* d_out, int out_size, void* d_ws, size_t ws_size, hipStream_t stream) {
    static int grid = 0;
    if (grid == 0) {
        if (n_in != 14 || out_size != MLAT * DM || ws_size < WS_END) { fprintf(stderr, "kernel_launch: unexpected shapes (n_in %d, out %d, ws %zu)\n", n_in, out_size, ws_size); grid = -1; return; }
        int dev = 0, cus = 0, per_cu = 0;
        hipGetDevice(&dev);
        hipDeviceGetAttribute(&cus, hipDeviceAttributeMultiprocessorCount, dev);
        hipFuncSetAttribute((const void*)mega_fwd, hipFuncAttributeMaxDynamicSharedMemorySize, LDS_BYTES);
        hipOccupancyMaxActiveBlocksPerMultiprocessor(&per_cu, (const void*)mega_fwd, 512, LDS_BYTES);
        if (per_cu < 1 || cus < 1) { fprintf(stderr, "kernel_launch: occupancy query says %d blocks per CU (%d CUs)\n", per_cu, cus); grid = -1; return; }
        grid = cus;
    }
    if (grid < 0) return;
    Params p{};
    p.x = (const float*)d_in[0]; p.c = (const float*)d_in[1]; p.ctx = (const float*)d_in[2]; p.c_ctx = (const float*)d_in[3];
    p.norm_g = (const float*)d_in[4]; p.w_ada = (const float*)d_in[5]; p.b_ada = (const float*)d_in[6]; p.w_in = (const float*)d_in[7];
    p.na_rpb = (const float*)d_in[8]; p.dec_f = (const float*)d_in[9]; p.dec_b = (const float*)d_in[10]; p.ret_norm_g = (const float*)d_in[11];
    p.w_out = (const float*)d_in[12]; p.final_g = (const float*)d_in[13];
    p.out = (float*)d_out; p.ws = (unsigned char*)d_ws;
    if (hipMemsetAsync(d_ws, 0, 65536, stream) != hipSuccess) { fprintf(stderr, "kernel_launch: memset of the barrier words failed\n"); return; }
    hipLaunchKernelGGL(mega_fwd, dim3(grid), dim3(512), LDS_BYTES, stream, p);
    const hipError_t e = hipPeekAtLastError();
    if (e != hipSuccess) fprintf(stderr, "launch failed: %s (grid %d)\n", hipGetErrorString(e), grid);
}
```

```cpp
#include <hip/hip_runtime.h>
#include <cstdio>
#include <cstdint>

#define DI __device__ __forceinline__
#define LAS __attribute__((address_space(3)))
typedef unsigned short bf16_t;
typedef short bf16x8 __attribute__((ext_vector_type(8)));
typedef float f32x4 __attribute__((ext_vector_type(4)));
typedef unsigned u32x4 __attribute__((ext_vector_type(4)));
typedef unsigned u32x2 __attribute__((ext_vector_type(2)));

constexpr int DM = 1024, NBATCH = 16, SEQ = 2048, CTXL = 256;
constexpr int MLAT = NBATCH * SEQ, MCTX = NBATCH * CTXL, MTOT = MLAT + MCTX;
constexpr int LDP = 2560 + 128;
constexpr int LDT = MTOT + 128;
constexpr int LDKC = 512 + 128;
constexpr int PC_NAQ = 0, PC_NAG = 512, PC_RQ = 1024, PC_RK = 1536, PC_RG = 2048;
constexpr int PT_NAV = 0, PT_RK = 512, PT_RV = 1024;
constexpr float LOG2E = 1.4426950408889634f;
constexpr float KSCALE = 0.08838834764831845f;
constexpr float EPSN = 1e-6f;
constexpr int NWT = 4608;

constexpr size_t MiB = 1u << 20;
constexpr size_t WS_WT = 2 * MiB, WS_WOT = 12 * MiB, WS_MODP = 24 * MiB  , WS_MOD = 15 * MiB;
constexpr size_t WS_CNT = 16384;
constexpr size_t WS_XBUF = 20 * MiB;
constexpr size_t WS_COS = 16 * MiB, WS_SIN = WS_COS + 512 * 1024, WS_COST = 17 * MiB, WS_SINT = WS_COST + 512 * 1024;
constexpr size_t WS_XN = 32 * MiB;
constexpr size_t WS_Y = 32 * MiB;
constexpr size_t WS_P = 104 * MiB;
constexpr size_t WS_KT = 272 * MiB;
constexpr size_t WS_PT = 310 * MiB;
constexpr size_t WS_VT = WS_PT;
constexpr size_t WS_RT = WS_PT + (size_t)512 * LDT * 2;
static_assert((size_t)MTOT * 1024 * 2 <= (size_t)1024 * LDT * 2, "RT fits the old PT rows");
constexpr size_t WS_SF = 419 * MiB, WS_SB = 451 * MiB;
constexpr size_t WS_END = 483 * MiB;
static_assert(WS_P + (size_t)MLAT * LDP * 2 <= WS_KT && WS_KT + (size_t)MTOT * 512 * 2 <= WS_PT && (size_t)MTOT * 512 * 2 <= (size_t)512 * LDT * 2 && WS_PT + (size_t)1536 * LDT * 2 <= WS_SF, "ws map");

constexpr int LDS_BYTES = 131072 + 256 + 5120 + 8 * 2304;

struct Params {
    const float *x, *c, *ctx, *c_ctx, *norm_g, *w_ada, *b_ada, *w_in, *na_rpb, *dec_f, *dec_b, *ret_norm_g, *w_out, *final_g;
    float* out; unsigned char* ws;
};

DI unsigned cvt_pk_bf16(float lo, float hi) { unsigned r; asm volatile("v_cvt_pk_bf16_f32 %0, %1, %2" : "=v"(r) : "v"(lo), "v"(hi)); return r; }
DI float bf2f(unsigned short v) { return __uint_as_float(((unsigned)v) << 16); }
DI float bflo(unsigned w) { return __uint_as_float(w << 16); }
DI float bfhi(unsigned w) { return __uint_as_float(w & 0xffff0000u); }
DI f32x4 mfma16(bf16x8 a, bf16x8 b, f32x4 c) { return __builtin_amdgcn_mfma_f32_16x16x32_bf16(a, b, c, 0, 0, 0); }
DI bf16x8 ldg8(const bf16_t* p) { return *(const bf16x8*)p; }
#define GAS __attribute__((address_space(1)))
DI bf16x8 ldg8u(const bf16_t* ub, unsigned off_bytes) {
    const GAS char* gp = (const GAS char*)ub; asm volatile("" : "+s"(gp));
    return *(const GAS bf16x8*)(gp + off_bytes); }
DI float ex2(float x) { return __builtin_amdgcn_exp2f(x); }
DI float wave_sum(float v) {
#pragma unroll
    for (int o = 1; o < 64; o <<= 1) v += __shfl_xor(v, o);
    return v;
}
DI float silu_f(float v) { return v * __builtin_amdgcn_rcpf(1.f + ex2(v * -LOG2E)); }
DI bf16x8 scale_frag(bf16x8 a, float s) {
    u32x4 w = __builtin_bit_cast(u32x4, a), o;
    o.x = cvt_pk_bf16(bflo(w.x) * s, bfhi(w.x) * s); o.y = cvt_pk_bf16(bflo(w.y) * s, bfhi(w.y) * s);
    o.z = cvt_pk_bf16(bflo(w.z) * s, bfhi(w.z) * s); o.w = cvt_pk_bf16(bflo(w.w) * s, bfhi(w.w) * s);
    return __builtin_bit_cast(bf16x8, o);
}

namespace pg8 {
constexpr int BM = 256, BK = 64, HALF = 128, HTB = HALF * BK * 2, STAGE_BYTES = 8 * HTB;
constexpr int GK = 1024;
__host__ __device__ __forceinline__ int lds_byte(int r, int c) { const int st = (r >> 4) * 2 + (c >> 5), rr = r & 15, cc = c & 31, ob = rr * 64 + cc * 2; return st * 1024 + (ob ^ (((ob >> 9) & 1) << 5)); }
__host__ __device__ __forceinline__ void stage_rc(int b, int& R, int& C) { const int st = b / 1024, sb = b % 1024, swz = sb ^ (((sb >> 9) & 1) << 5); R = (st >> 1) * 16 + swz / 64; C = (st & 1) * 32 + (swz % 64) / 2; }
__host__ __device__ __forceinline__ int perm32(int rho) { const int n = rho >> 4, i = rho & 15; return 8 * (i >> 2) + 4 * n + (i & 3); }

struct Unit { int pm, pn; };

template <class Epi, class Sched>
DI void gemm_phase(LAS unsigned char* lds, const Sched& S, const Epi& E) {
    const int tid = threadIdx.x, wid = __builtin_amdgcn_readfirstlane(tid >> 6), lane = tid & 63, wr = wid >> 2, wc = wid & 3, fr = lane & 15, fq = lane >> 4;
    constexpr int K = GK, nt = K / BK;
    unsigned voffA[2], voffB[2];
#pragma unroll
    for (int i = 0; i < 2; ++i) { int R, C; stage_rc(tid * 16 + i * 8192, R, C); const int Rb = Epi::PERM ? ((R & ~31) + perm32(R & 31)) : R;
        voffA[i] = (unsigned)(R * K + C) * 2u; voffB[i] = (unsigned)(Rb * K + C) * 2u; }
    const size_t kstep = (size_t)(BK * 2);
    const size_t hstep = (size_t)HALF * K * 2;
    const unsigned ldsw = (unsigned)wid * 1024u;
    const int aoff = lds_byte(wr * 64 + fr, fq * 8), boff = lds_byte(wc * 32 + fr, fq * 8);
#define PG8_SA(b, h) (((b) * 2 + (h)) * HTB)
#define PG8_SB(b, h) ((4 + (b) * 2 + (h)) * HTB)
#define PG8_STAGE(bufoff, gbase, voff) do { _Pragma("unroll") for (int _i = 0; _i < 2; ++_i) \
        __builtin_amdgcn_global_load_lds((const unsigned*)((const char*)(gbase) + (voff)[_i]), (LAS unsigned*)(lds + (bufoff) + ldsw + _i * 8192), 16, 0, 0); } while (0)
#define PG8_LDA(dst, b, h) do { _Pragma("unroll") for (int m = 0; m < 4; ++m) _Pragma("unroll") for (int k = 0; k < 2; ++k) dst[m][k] = *(const LAS bf16x8*)(lds + PG8_SA(b, h) + aoff + m * 2048 + k * 1024); } while (0)
#define PG8_LDB(dst, b, h) do { _Pragma("unroll") for (int n = 0; n < 2; ++n) _Pragma("unroll") for (int k = 0; k < 2; ++k) dst[n][k] = *(const LAS bf16x8*)(lds + PG8_SB(b, h) + boff + n * 2048 + k * 1024); } while (0)
#define PG8_MMA(ai, bj, At, Bt) do { __builtin_amdgcn_s_setprio(1); _Pragma("unroll") for (int m = 0; m < 4; ++m) _Pragma("unroll") for (int n = 0; n < 2; ++n) _Pragma("unroll") for (int k = 0; k < 2; ++k) \
        acc[ai][bj][m][n] = __builtin_amdgcn_mfma_f32_16x16x32_bf16(Bt[n][k], At[m][k], acc[ai][bj][m][n], 0, 0, 0); __builtin_amdgcn_s_setprio(0); } while (0)
#define PG8_WAIT_V(n) asm volatile("s_waitcnt vmcnt(" #n ")" ::: "memory")
#define PG8_WAIT_L(n) asm volatile("s_waitcnt lgkmcnt(" #n ")" ::: "memory")
#define PG8_BAR __builtin_amdgcn_s_barrier()
#define PG8_SCHED __builtin_amdgcn_sched_barrier(0)
    Unit cur, nxt; int ui = 0;
    if (!S.next(0, cur)) return;
    f32x4 acc[2][2][4][2];
#pragma unroll
    for (int a = 0; a < 2; ++a)
#pragma unroll
        for (int b = 0; b < 2; ++b)
#pragma unroll
            for (int m = 0; m < 4; ++m)
#pragma unroll
                for (int n = 0; n < 2; ++n) acc[a][b][m][n] = (f32x4){0.f, 0.f, 0.f, 0.f};
    bf16x8 At[4][2], B0[2][2], B1[2][2];
    const char* cA = S.aptr(cur); const char* cB = S.bptr(cur);
    PG8_STAGE(PG8_SB(0, 0), cB, voffB); PG8_STAGE(PG8_SB(0, 1), cB + hstep, voffB); PG8_STAGE(PG8_SA(0, 0), cA, voffA); PG8_STAGE(PG8_SA(0, 1), cA + hstep, voffA);
    if (wr == 1) PG8_BAR;
    PG8_WAIT_V(2); PG8_BAR;
    PG8_STAGE(PG8_SB(1, 0), cB + kstep, voffB); PG8_STAGE(PG8_SA(1, 0), cA + kstep, voffA); PG8_STAGE(PG8_SB(1, 1), cB + hstep + kstep, voffB);
    PG8_WAIT_V(6); PG8_BAR;
    for (;;) {
        const bool has_next = S.next(ui + 1, nxt);
        const char* nA = has_next ? S.aptr(nxt) : cA; const char* nB = has_next ? S.bptr(nxt) : cB;
        for (int t = 0; t < nt; t += 2) {
            const bool last = (t == nt - 2);
            const char* a1 = cA + (size_t)(t + 1) * kstep;
            const char* a2 = last ? nA : cA + (size_t)(t + 2) * kstep; const char* b2 = last ? nB : cB + (size_t)(t + 2) * kstep;
            const char* a3 = a2 + kstep; const char* b3 = b2 + kstep;
            PG8_LDB(B0, 0, 0); PG8_LDB(B1, 0, 1); PG8_SCHED; PG8_LDA(At, 0, 0); PG8_STAGE(PG8_SA(1, 1), a1 + hstep, voffA);
            PG8_WAIT_V(8); PG8_WAIT_L(0); PG8_BAR; PG8_MMA(0, 0, At, B0); PG8_MMA(0, 1, At, B1); PG8_BAR; PG8_SCHED;
            PG8_LDA(At, 0, 1); PG8_STAGE(PG8_SB(0, 0), b2, voffB); PG8_STAGE(PG8_SB(0, 1), b2 + hstep, voffB); PG8_STAGE(PG8_SA(0, 0), a2, voffA);
            PG8_WAIT_V(8); PG8_WAIT_L(0); PG8_BAR; PG8_MMA(1, 0, At, B0); PG8_MMA(1, 1, At, B1); PG8_BAR; PG8_SCHED;
            PG8_LDB(B0, 1, 0); PG8_LDB(B1, 1, 1); PG8_SCHED; PG8_LDA(At, 1, 0); PG8_STAGE(PG8_SA(0, 1), a2 + hstep, voffA);
            PG8_WAIT_V(8); PG8_WAIT_L(0); PG8_BAR; PG8_MMA(0, 0, At, B0); PG8_MMA(0, 1, At, B1); PG8_BAR; PG8_SCHED;
            PG8_LDA(At, 1, 1); PG8_STAGE(PG8_SB(1, 0), b3, voffB); PG8_STAGE(PG8_SB(1, 1), b3 + hstep, voffB); PG8_STAGE(PG8_SA(1, 0), a3, voffA);
            PG8_WAIT_V(8); PG8_WAIT_L(0); PG8_BAR; PG8_MMA(1, 0, At, B0); PG8_MMA(1, 1, At, B1); PG8_BAR; PG8_SCHED;
        }
        if (wr == 0) PG8_BAR;
        E(acc, cur, wr, wc, fr, fq);
        if (!has_next) break;
#pragma unroll
        for (int a = 0; a < 2; ++a)
#pragma unroll
            for (int b = 0; b < 2; ++b)
#pragma unroll
                for (int m = 0; m < 4; ++m)
#pragma unroll
                    for (int n = 0; n < 2; ++n) acc[a][b][m][n] = (f32x4){0.f, 0.f, 0.f, 0.f};
        cur = nxt; cA = nA; cB = nB; ++ui;
        if (wr == 1) PG8_BAR;
    }
    PG8_WAIT_V(0);
    PG8_BAR;
#undef PG8_SA
#undef PG8_SB
#undef PG8_STAGE
#undef PG8_LDA
#undef PG8_LDB
#undef PG8_MMA
#undef PG8_WAIT_V
#undef PG8_WAIT_L
#undef PG8_BAR
#undef PG8_SCHED
}
}

struct InSched {
    const char* XN; const char* WT; int c, G;
    DI bool next(int i, pg8::Unit& u) const {
        const long L = (long)i * G + c;
        if (L < 2048) {
            int wgid = (int)L; wgid = (wgid & 7) * 256 + (wgid >> 3);
            const int gid = wgid >> 7, rem = wgid & 127, vs = rem >> 3;
            u.pm = gid * 8 + (rem & 7); u.pn = vs < 14 ? vs : vs + 2; return true;
        }
        if (L < 2176) { const int l2 = (int)L - 2048; u.pm = 128 + (l2 & 15); const int j = l2 >> 4; u.pn = j < 2 ? 2 + j : 10 + j; return true; }
        return false;
    }
    DI const char* aptr(const pg8::Unit& u) const { return u.pn < 12 ? XN + (size_t)u.pm * (256 * 1024 * 2) : WT + (size_t)u.pn * (256 * 1024 * 2); }
    DI const char* bptr(const pg8::Unit& u) const { return u.pn < 12 ? WT + (size_t)u.pn * (256 * 1024 * 2) : XN + (size_t)u.pm * (256 * 1024 * 2); }
};
struct EpiIn {
    static constexpr bool PERM = true;
    bf16_t *P, *KT, *PT; const float *COS, *SIN, *COST, *SINT; LAS unsigned char* scr;
    DI void operator()(const f32x4 (&acc)[2][2][4][2], const pg8::Unit& u, int wr, int wc, int fr_, int fq_) const {
        int fr = fr_, fq = fq_; asm volatile("" : "+v"(fr), "+v"(fq));
        const int vn = u.pn, pm = u.pm;
        if (vn < 12) {
            const int rowb = pm * 256 + wr * 64 + fr;
            if (vn == 2 || vn == 3) {
                const int colk = (vn - 2) * 256 + wc * 32 + 8 * fq;
#pragma unroll
                for (int ai = 0; ai < 2; ++ai)
#pragma unroll
                    for (int m = 0; m < 4; ++m) {
                        const int tok = rowb + ai * 128 + m * 16;
#pragma unroll
                        for (int bj = 0; bj < 2; ++bj) {
                            const int col = colk + bj * 128, hh = col >> 6, ks = (col >> 5) & 1, gg = (col >> 3) & 3;
                            const f32x4 v0 = acc[ai][bj][m][0], v1 = acc[ai][bj][m][1];
                            u32x4 w; w.x = cvt_pk_bf16(v0[0], v0[1]); w.y = cvt_pk_bf16(v0[2], v0[3]); w.z = cvt_pk_bf16(v1[0], v1[1]); w.w = cvt_pk_bf16(v1[2], v1[3]);
                            *(u32x4*)((char*)KT + (size_t)((tok >> 3) * 8 + hh) * 1024 + ks * 512 + (gg * 8 + (tok & 7)) * 16) = w;
                        }
                    }
                return;
            }
            bf16_t* base = P; const int ldc = LDP;
            const int col0 = (vn < 2 ? vn : vn - 2) * 256 + wc * 32 + 8 * fq;
            const bool rot = (vn >= 6 && vn < 10);
            const int i0 = 16 * wc + 4 * fq;
#pragma unroll
            for (int ai = 0; ai < 2; ++ai)
#pragma unroll
                for (int m = 0; m < 4; ++m) {
                    const int row = rowb + ai * 128 + m * 16;
                    f32x4 c4 = {1.f, 1.f, 1.f, 1.f}, s4 = {0.f, 0.f, 0.f, 0.f};
                    if (rot) { const int t = row & 2047; c4 = *(const f32x4*)(COS + t * 64 + i0); s4 = *(const f32x4*)(SIN + t * 64 + i0); }
                    bf16_t* rowp = base + (size_t)row * ldc + col0;
#pragma unroll
                    for (int bj = 0; bj < 2; ++bj) {
                        const f32x4 v0 = acc[ai][bj][m][0], v1 = acc[ai][bj][m][1];
                        const f32x4 o0 = v0 * c4 - v1 * s4, o1 = v0 * s4 + v1 * c4;
                        u32x4 w; w.x = cvt_pk_bf16(o0[0], o0[1]); w.y = cvt_pk_bf16(o0[2], o0[3]); w.z = cvt_pk_bf16(o1[0], o1[1]); w.w = cvt_pk_bf16(o1[2], o1[3]);
                        {
                            LAS unsigned char* tbw = scr + 5120 + (wr * 4 + wc) * 2304;
                            const int ln = fr + 16 * fq;
                            *(LAS u32x4*)(tbw + fr * 80 + fq * 16) = w;
                            const u32x4 wt = *(const LAS u32x4*)(tbw + (ln >> 2) * 80 + (ln & 3) * 16);
                            *(u32x4*)(base + (size_t)(row - fr + (ln >> 2)) * ldc + (col0 - 8 * fq) + bj * 128 + (ln & 3) * 8) = wt;
                        }
                        if (vn == 8 || vn == 9) {
                            unsigned short* r0 = (unsigned short*)((char*)PT + (size_t)512 * LDT * 2 + ((size_t)(row >> 3) * 1024 + ((vn - 8) * 2 + bj) * 128 + 32 * wc + 4 * fq) * 16 + (row & 7) * 2);
                            r0[0] = (unsigned short)(w.x & 0xffffu); r0[8] = (unsigned short)(w.x >> 16); r0[16] = (unsigned short)(w.y & 0xffffu); r0[24] = (unsigned short)(w.y >> 16);
                            r0[128] = (unsigned short)(w.z & 0xffffu); r0[136] = (unsigned short)(w.z >> 16); r0[144] = (unsigned short)(w.w & 0xffffu); r0[152] = (unsigned short)(w.w >> 16);
                        }
                    }
                }
        } else {
            const int frow0 = (vn - 12) * 256 + wr * 64 + fr;
            const int tok0 = pm * 256 + wc * 32 + 8 * fq;
            const bool rot = (vn == 14 || vn == 15) && pm < 128;
            if (vn < 14) {
#pragma unroll
                for (int ai = 0; ai < 2; ++ai)
#pragma unroll
                    for (int bj = 0; bj < 2; ++bj)
#pragma unroll
                        for (int m = 0; m < 4; ++m) {
                            const int f = frow0 + ai * 128 + m * 16, tok = tok0 + bj * 128;
                            const f32x4 v0 = acc[ai][bj][m][0], v1 = acc[ai][bj][m][1];
                            u32x4 w; w.x = cvt_pk_bf16(v0[0], v0[1]); w.y = cvt_pk_bf16(v0[2], v0[3]); w.z = cvt_pk_bf16(v1[0], v1[1]); w.w = cvt_pk_bf16(v1[2], v1[3]);
                            *(u32x4*)((char*)PT + (size_t)((tok >> 3) * 8 + (f >> 6)) * 1024 + (f & 63) * 16) = w;
                        }
                return;
            }
#pragma unroll
            for (int ai = 0; ai < 2; ++ai)
#pragma unroll
                for (int bj = 0; bj < 2; ++bj)
#pragma unroll
                    for (int mp = 0; mp < 2; ++mp) {
                        const int tok = tok0 + bj * 128;
                        f32x4 ca = {1.f, 1.f, 1.f, 1.f}, cb = ca, sa = {0.f, 0.f, 0.f, 0.f}, sb = sa;
                        if (rot) { const int i = 32 * wr + 16 * mp + fr, t = tok & 2047;
                            ca = *(const f32x4*)(COST + i * 2048 + t); cb = *(const f32x4*)(COST + i * 2048 + t + 4);
                            sa = *(const f32x4*)(SINT + i * 2048 + t); sb = *(const f32x4*)(SINT + i * 2048 + t + 4); }
                        const f32x4 x1a = acc[ai][bj][2 * mp][0], x1b = acc[ai][bj][2 * mp][1], x2a = acc[ai][bj][2 * mp + 1][0], x2b = acc[ai][bj][2 * mp + 1][1];
                        const f32x4 o1a = x1a * ca - x2a * sa, o1b = x1b * cb - x2b * sb, o2a = x1a * sa + x2a * ca, o2b = x1b * sb + x2b * cb;
                        char* r1 = (char*)PT + (size_t)512 * LDT * 2 + ((size_t)(tok >> 3) * 1024 + (frow0 - 512 + ai * 128 + (2 * mp) * 16)) * 16;
                        char* r2 = r1 + 16 * 16;
                        u32x4 w; w.x = cvt_pk_bf16(o1a[0], o1a[1]); w.y = cvt_pk_bf16(o1a[2], o1a[3]); w.z = cvt_pk_bf16(o1b[0], o1b[1]); w.w = cvt_pk_bf16(o1b[2], o1b[3]);
                        *(u32x4*)r1 = w;
                        w.x = cvt_pk_bf16(o2a[0], o2a[1]); w.y = cvt_pk_bf16(o2a[2], o2a[3]); w.z = cvt_pk_bf16(o2b[0], o2b[1]); w.w = cvt_pk_bf16(o2b[2], o2b[3]);
                        *(u32x4*)r2 = w;
                    }
        }
    }
};
struct OutSched {
    const char* Y; const char* WOT; int c, G;
    DI bool next(int i, pg8::Unit& u) const {
        const long L = (long)i * G + c; if (L >= 512) return false;
        u.pm = (int)(L >> 2); u.pn = (int)(L & 3); return true;
    }
    DI const char* aptr(const pg8::Unit& u) const { return Y + (size_t)u.pm * (256 * 1024 * 2); }
    DI const char* bptr(const pg8::Unit& u) const { return WOT + (size_t)u.pn * (256 * 1024 * 2); }
};
struct EpiOutF {
    static constexpr bool PERM = false;
    const float* x; const float* MOD; const float* gfin; float* out; float* xbuf; unsigned* cnt; LAS unsigned char* scr;
    DI void operator()(f32x4 (&acc)[2][2][4][2], const pg8::Unit& u, int wr, int wc, int fr_, int fq_) const {
        int fr = fr_, fq = fq_, tid = threadIdx.x;
        asm volatile("" : "+v"(fr), "+v"(fq), "+v"(tid));
        const int b = u.pm >> 3;
        const int col0 = u.pn * 256 + wc * 32 + 4 * fq;
        LAS float* P4s = (LAS float*)scr;
        LAS float* S = (LAS float*)(scr + 4096);
        f32x4 gt[2][2];
#pragma unroll
        for (int bj = 0; bj < 2; ++bj)
#pragma unroll
            for (int n = 0; n < 2; ++n) gt[bj][n] = *(const f32x4*)(MOD + b * 3072 + 2048 + col0 + bj * 128 + n * 16);
        int lane = fr + 16 * fq; const int rr = lane >> 3, pz = lane & 7;
        LAS unsigned char* tb = scr + 5120 + (wr * 4 + wc) * 2304;
        f32x4 xv[3][2][2];
        const float* xg = x + (size_t)(u.pm * 256 + wr * 64 + rr) * DM + u.pn * 256 + wc * 32 + pz * 4;
#define EPF_LOADX(B, ai_, m_) do { _Pragma("unroll") for (int bj = 0; bj < 2; ++bj) _Pragma("unroll") for (int k = 0; k < 2; ++k) \
            xv[B][bj][k] = *(const f32x4*)(xg + (size_t)((ai_) * 128 + (m_) * 16 + 8 * k) * DM + bj * 128); } while (0)
        EPF_LOADX(0, 0, 0); EPF_LOADX(1, 0, 1);
#pragma unroll
        for (int im = 0; im < 8; ++im) {
            const int ai = im >> 2, m = im & 3;
            if (im + 2 < 8) EPF_LOADX((im + 2) % 3, (im + 2) >> 2, (im + 2) & 3);
            __builtin_amdgcn_sched_barrier(0);
            float q0 = 0.f, q1 = 0.f; f32x4 uu[2];
#pragma unroll
            for (int bj = 0; bj < 2; ++bj) {
#pragma unroll
                for (int n = 0; n < 2; ++n) *(LAS f32x4*)(tb + fr * 144 + (16 * n + 4 * fq) * 4) = gt[bj][n] * acc[ai][bj][m][n];
#pragma unroll
                for (int k = 0; k < 2; ++k) {
                    const f32x4 t = *(const LAS f32x4*)(tb + (rr + 8 * k) * 144 + pz * 16);
                    const f32x4 v = xv[im % 3][bj][k] + t;
                    const float d = (v[0] * v[0] + v[1] * v[1]) + (v[2] * v[2] + v[3] * v[3]);
                    if (k == 0) q0 += d; else q1 += d;
                    uu[k] = v;
                }
                acc[ai][bj][m][0] = uu[0]; acc[ai][bj][m][1] = uu[1];
            }
            q0 += __shfl_xor(q0, 1); q1 += __shfl_xor(q1, 1); q0 += __shfl_xor(q0, 2); q1 += __shfl_xor(q1, 2); q0 += __shfl_xor(q0, 4); q1 += __shfl_xor(q1, 4);
            if (pz == 0) { P4s[(ai * 128 + wr * 64 + m * 16 + rr) * 4 + wc] = q0; P4s[(ai * 128 + wr * 64 + m * 16 + rr + 8) * 4 + wc] = q1; }
            __builtin_amdgcn_sched_barrier(0);
        }
#undef EPF_LOADX
        asm volatile("s_waitcnt lgkmcnt(0)" ::: "memory"); __builtin_amdgcn_s_barrier(); asm volatile("" ::: "memory");
        float* slot = xbuf + ((size_t)u.pm * 256) * 4;
        unsigned* pc = cnt + 64 * u.pm;
        if (tid < 256) {
            const float t = (P4s[tid * 4 + 0] + P4s[tid * 4 + 1]) + (P4s[tid * 4 + 2] + P4s[tid * 4 + 3]);
            __hip_atomic_store(slot + tid * 4 + u.pn, t, __ATOMIC_RELAXED, __HIP_MEMORY_SCOPE_AGENT);
            asm volatile("s_waitcnt vmcnt(0)" ::: "memory");
            if ((tid & 63) == 0) __hip_atomic_fetch_add(pc, 1u, __ATOMIC_RELAXED, __HIP_MEMORY_SCOPE_AGENT);
        }
        if (tid < 64) {
            unsigned sp = 0;
            while ((unsigned)__builtin_amdgcn_readfirstlane(__hip_atomic_load(pc, __ATOMIC_RELAXED, __HIP_MEMORY_SCOPE_AGENT)) < 16u) {
                __builtin_amdgcn_s_sleep(2); if (++sp > (1u << 20)) break; }
            __builtin_amdgcn_fence(__ATOMIC_ACQUIRE, "agent");
        }
        asm volatile("s_waitcnt vmcnt(0) lgkmcnt(0)" ::: "memory"); __builtin_amdgcn_s_barrier(); asm volatile("" ::: "memory");
        if (tid < 256) {
            float tot = 0.f;
#pragma unroll
            for (int t = 0; t < 4; ++t) tot += __hip_atomic_load(slot + tid * 4 + t, __ATOMIC_RELAXED, __HIP_MEMORY_SCOPE_AGENT);
            S[tid] = rsqrtf(tot * (1.f / DM) + EPSN);
        }
        asm volatile("s_waitcnt lgkmcnt(0)" ::: "memory"); __builtin_amdgcn_s_barrier(); asm volatile("" ::: "memory");
        f32x4 gf[2];
#pragma unroll
        for (int bj = 0; bj < 2; ++bj) gf[bj] = *(const f32x4*)(gfin + u.pn * 256 + bj * 128 + wc * 32 + pz * 4);
#pragma unroll
        for (int ai = 0; ai < 2; ++ai)
#pragma unroll
            for (int m = 0; m < 4; ++m)
#pragma unroll
                for (int k = 0; k < 2; ++k) {
                    const int r = ai * 128 + wr * 64 + m * 16 + rr + 8 * k; const float rs = S[r];
                    float* orow = out + (size_t)(u.pm * 256 + r) * DM + u.pn * 256 + wc * 32 + pz * 4;
#pragma unroll
                    for (int bj = 0; bj < 2; ++bj) *(f32x4*)(orow + bj * 128) = acc[ai][bj][m][k] * rs * gf[bj];
                }
        asm volatile("s_waitcnt lgkmcnt(0)" ::: "memory"); __builtin_amdgcn_s_barrier(); asm volatile("" ::: "memory");
    }
};

DI void wt_src(int np, int& src, float& sc) {
    const int vn = np >> 8; sc = 1.f;
    if (vn < 2) { src = np; sc = 0.125f * LOG2E; }
    else if (vn < 4) { src = np; }
    else if (vn < 6) { src = 1536 + (np - 1024); }
    else if (vn < 10) { const int hl = (np - 1536) & 511, head = hl >> 7, p = hl & 127, half = (p >> 2) & 1, i = 4 * (p >> 3) + (p & 3);
        src = (vn < 8 ? 2048 : 2560) + head * 128 + 64 * half + i; if (vn >= 8) sc = KSCALE; }
    else if (vn < 12) { src = 3584 + (np - 2560); }
    else if (vn < 14) { src = 1024 + (np - 3072); }
    else if (vn < 16) { const int hl = np - 3584, head = hl >> 7, p = hl & 127, half = (p >> 4) & 1, i = 16 * (p >> 5) + (p & 15);
        src = 2560 + head * 128 + 64 * half + i; sc = KSCALE; }
    else { src = 3072 + (np - 4096); }
}
DI void p0_transpose_item(const float* W, int N, bool is_in, bf16_t* WT, LAS float* scr, int item, int lane) {
    const int nblk = is_in ? (NWT / 32) : 32, kb = item / nblk, nb = item % nblk, k0 = 64 * kb, n0 = 32 * nb;
    int src; float sc;
    if (is_in) wt_src(n0 + (lane & 31), src, sc); else { src = n0 + (lane & 31); sc = 1.f; }
#pragma unroll 8
    for (int i = 0; i < 32; ++i) { const int kk = 2 * i + (lane >> 5); scr[kk * 33 + (lane & 31)] = W[(size_t)(k0 + kk) * N + src] * sc; }
    asm volatile("s_waitcnt lgkmcnt(0)" ::: "memory");
    const int c = lane & 7;
#pragma unroll
    for (int j = 0; j < 4; ++j) { const int n = (lane >> 3) + 8 * j; const LAS float* s = scr + (8 * c) * 33 + n;
        u32x4 o; o.x = cvt_pk_bf16(s[0 * 33], s[1 * 33]); o.y = cvt_pk_bf16(s[2 * 33], s[3 * 33]); o.z = cvt_pk_bf16(s[4 * 33], s[5 * 33]); o.w = cvt_pk_bf16(s[6 * 33], s[7 * 33]);
        *(u32x4*)(WT + (size_t)(n0 + n) * 1024 + k0 + 8 * c) = o; }
    asm volatile("s_waitcnt lgkmcnt(0)" ::: "memory");
}
DI void p0_gemv_item(const Params& p, float* MODP, LAS float* scr, int item, int lane) {
    const int q = item / 48, cgp = item % 48, col = cgp * 64 + lane;
    float acc[17];
#pragma unroll
    for (int bb = 0; bb < 17; ++bb) acc[bb] = 0.f;
    for (int kc = 0; kc < 4; ++kc) {
        const int kbase = q * 64 + kc * 16;
#pragma unroll
        for (int u = 0; u < 5; ++u) { const int idx = lane + 64 * u;
            if (idx < 272) { const int kk = idx / 17, bb = idx - kk * 17; const float v = bb < 16 ? p.c[bb * 1024 + kbase + kk] : p.c_ctx[kbase + kk]; scr[idx] = silu_f(v); } }
        asm volatile("s_waitcnt lgkmcnt(0)" ::: "memory");
        float wv[16];
#pragma unroll
        for (int kk = 0; kk < 16; ++kk) wv[kk] = p.w_ada[(size_t)(kbase + kk) * 3072 + col];
#pragma unroll
        for (int kk = 0; kk < 16; ++kk) {
#pragma unroll
            for (int bb = 0; bb < 17; ++bb) acc[bb] += scr[kk * 17 + bb] * wv[kk]; }
        asm volatile("s_waitcnt lgkmcnt(0)" ::: "memory");
    }
#pragma unroll
    for (int bb = 0; bb < 17; ++bb) MODP[(q * 17 + bb) * 3072 + col] = acc[bb];
}
DI void phase_p0(const Params& p, LAS unsigned char* lds, int vb, int G) {
    const int tid = threadIdx.x, lane = tid & 63, wave = tid >> 6;
    LAS float* scr = (LAS float*)(lds + wave * 16384);
    const int gw = vb * 8 + wave, NGW = G * 8;
    bf16_t* WT = (bf16_t*)(p.ws + WS_WT); bf16_t* WOT = (bf16_t*)(p.ws + WS_WOT); float* MODP = (float*)(p.ws + WS_MODP);
    constexpr int I_GEMV = 768, I_IN = 16 * (NWT / 32), I_OUT = 16 * 32;
    for (int it = gw; it < I_GEMV + I_IN + I_OUT; it += NGW) {
        if (it < I_GEMV) p0_gemv_item(p, MODP, scr, it, lane);
        else if (it < I_GEMV + I_IN) p0_transpose_item(p.w_in, 4096, true, WT, scr, it - I_GEMV, lane);
        else p0_transpose_item(p.w_out, 1024, false, WOT, scr, it - I_GEMV - I_IN, lane);
    }
    float* COS = (float*)(p.ws + WS_COS); float* SIN = (float*)(p.ws + WS_SIN); float* COST = (float*)(p.ws + WS_COST); float* SINT = (float*)(p.ws + WS_SINT);
    for (int idx = vb * 512 + tid; idx < 2048 * 64; idx += G * 512) {
        const int t = idx >> 6, i = idx & 63, f = i & 31; const float pos = (float)((i < 32) ? (t >> 6) : (t & 63));
        const float inv = exp2f(-(float)f * (13.287712379549449f / 32.f));
        const float ang = pos * inv; const float cs = __cosf(ang), sn = __sinf(ang);
        COS[idx] = cs; SIN[idx] = sn; COST[i * 2048 + t] = cs; SINT[i * 2048 + t] = sn;
    }
}
DI void norm_rows(const Params& p, const float* src, bf16_t* dst, int nrows, int bmod, int lane) {
    const float* MODP = (const float*)(p.ws + WS_MODP);
    f32x4 mul[4], sh[4];
#pragma unroll
    for (int j = 0; j < 4; ++j) { const int col = 4 * lane + 256 * j;
        f32x4 s = *(const f32x4*)(p.b_ada + col), sc = *(const f32x4*)(p.b_ada + 1024 + col);
#pragma unroll 2
        for (int q = 0; q < 16; ++q) { s += *(const f32x4*)(MODP + (q * 17 + bmod) * 3072 + col); sc += *(const f32x4*)(MODP + (q * 17 + bmod) * 3072 + 1024 + col); }
        sh[j] = s; mul[j] = *(const f32x4*)(p.norm_g + col) * (sc + 1.0f); }
    for (int r = 0; r < nrows; r += 2) {
        const f32x4* xr = (const f32x4*)(src + (size_t)r * DM) + lane;
        f32x4 v[2][4]; float sq[2];
#pragma unroll
        for (int q = 0; q < 2; ++q)
#pragma unroll
            for (int j = 0; j < 4; ++j) v[q][j] = xr[q * 256 + 64 * j];
#pragma unroll
        for (int q = 0; q < 2; ++q) { float s = 0.f;
#pragma unroll
            for (int j = 0; j < 4; ++j) s += (v[q][j].x * v[q][j].x + v[q][j].y * v[q][j].y) + (v[q][j].z * v[q][j].z + v[q][j].w * v[q][j].w);
            sq[q] = s; }
#pragma unroll
        for (int o = 1; o < 64; o <<= 1) { sq[0] += __shfl_xor(sq[0], o); sq[1] += __shfl_xor(sq[1], o); }
#pragma unroll
        for (int q = 0; q < 2; ++q) { const float rstd = rsqrtf(sq[q] * (1.f / DM) + EPSN);
            u32x2* o8 = (u32x2*)(dst + (size_t)(r + q) * DM) + lane;
#pragma unroll
            for (int j = 0; j < 4; ++j) { const f32x4 h = v[q][j] * rstd * mul[j] + sh[j]; u32x2 w; w.x = cvt_pk_bf16(h.x, h.y); w.y = cvt_pk_bf16(h.z, h.w); o8[64 * j] = w; } }
    }
}
DI void phase_p0b(const Params& p, int vb, int G) {
    const int tid = threadIdx.x, lane = tid & 63, wave = tid >> 6;
    const int gw = vb * 8 + wave, NGW = G * 8;
    bf16_t* XN = (bf16_t*)(p.ws + WS_XN);
    for (int wv = gw; wv < 2048; wv += NGW) {
        const int b = wv >> 7, r0 = b * 2048 + (wv & 127) * 16;
        norm_rows(p, p.x + (size_t)r0 * DM, XN + (size_t)r0 * DM, 16, b, lane);
    }
    for (int wv = gw; wv < 2048; wv += NGW)
        norm_rows(p, p.ctx + (size_t)(wv * 2) * DM, XN + (size_t)(MLAT + wv * 2) * DM, 2, 16, lane);
    const float* MODP = (const float*)(p.ws + WS_MODP); float* MOD = (float*)(p.ws + WS_MOD);
    for (int idx = vb * 512 + tid; idx < 17 * 3072; idx += G * 512) {
        const int col = idx % 3072;
        float a = p.b_ada[col];
#pragma unroll
        for (int q = 0; q < 16; ++q) a += MODP[q * 17 * 3072 + idx];
        MOD[idx] = a;
    }
}

DI void ret_state_item(const Params& p, int item) {
    const int lane = threadIdx.x & 63, wave = __builtin_amdgcn_readfirstlane(threadIdx.x >> 6);
    const int dvq = item & 3, h = (item >> 2) & 3, b = item >> 4;
    const int dir = wave & 1, mt = wave >> 1, c = lane & 15, g = lane >> 4;
    const bf16_t* PT = (const bf16_t*)(p.ws + WS_PT);
    bf16_t* SO = (bf16_t*)(p.ws + (dir ? WS_SB : WS_SF)) + (size_t)((b * 4 + h) * 16) * 16384;
    const float lg2 = -__expf(dir ? p.dec_b[h] : p.dec_f[h]) * LOG2E;
    float w8[8];
#pragma unroll
    for (int j = 0; j < 8; ++j) w8[j] = ex2(lg2 * (float)(dir ? (8 * g + j) : (31 - 8 * g - j)));
    const float g32 = ex2(lg2 * 32.f);
    const unsigned loff = (unsigned)((g * 1024 + c) * 16);
    const char* RT = (const char*)(p.ws + WS_RT);
    const char* abase = RT + (size_t)(h * 128 + 32 * mt) * 16;
    const char* bbase = RT + (size_t)(512 + h * 128 + 32 * dvq) * 16;
    const int ctxb = MLAT + b * CTXL, latb = b * SEQ;
    f32x4 acc[2][2];
#pragma unroll
    for (int at = 0; at < 2; ++at)
#pragma unroll
        for (int nt = 0; nt < 2; ++nt) acc[at][nt] = (f32x4){0.f, 0.f, 0.f, 0.f};
    bf16x8 fa[2][2][4], fb[2][2][4];
#define RS_TOK(i) (dir ? ((i) < 2 ? ctxb + 128 * (1 - (i)) : latb + 128 * (17 - (i))) : ((i) < 2 ? ctxb + 128 * (i) : latb + 128 * ((i) - 2)))
#define RS_LOAD(B, i) do { const int tb_ = RS_TOK(i); _Pragma("unroll") for (int ks = 0; ks < 4; ++ks) { \
        const size_t to_ = (size_t)((tb_ >> 3) + 4 * ks) * 16384; \
        fa[B][0][ks] = ldg8u((const bf16_t*)(abase + to_), loff); fa[B][1][ks] = ldg8u((const bf16_t*)(abase + to_ + 256), loff); \
        fb[B][0][ks] = ldg8u((const bf16_t*)(bbase + to_), loff); fb[B][1][ks] = ldg8u((const bf16_t*)(bbase + to_ + 256), loff); } } while (0)
#define RS_STORE(i) do { const int n_ = dir ? 17 - (i) : (i) - 2; bf16_t* so_ = SO + (size_t)n_ * 16384; \
        _Pragma("unroll") for (int at = 0; at < 2; ++at) _Pragma("unroll") for (int nt = 0; nt < 2; ++nt) { \
            u32x2 w_; w_.x = cvt_pk_bf16(acc[at][nt][0], acc[at][nt][1]); w_.y = cvt_pk_bf16(acc[at][nt][2], acc[at][nt][3]); \
            *(u32x2*)(so_ + (32 * dvq + 16 * nt + c) * 128 + 32 * mt + 8 * g + 4 * at) = w_; } } while (0)
#define RS_COMPUTE(B) do { _Pragma("unroll") for (int kk = 0; kk < 4; ++kk) { const int ks = dir ? 3 - kk : kk; \
        _Pragma("unroll") for (int at = 0; at < 2; ++at) _Pragma("unroll") for (int nt = 0; nt < 2; ++nt) acc[at][nt] *= g32; \
        _Pragma("unroll") for (int at = 0; at < 2; ++at) { \
            const u32x4 w_ = __builtin_bit_cast(u32x4, fa[B][at][ks]); u32x4 o_; \
            o_.x = cvt_pk_bf16(bflo(w_.x) * w8[0], bfhi(w_.x) * w8[1]); o_.y = cvt_pk_bf16(bflo(w_.y) * w8[2], bfhi(w_.y) * w8[3]); \
            o_.z = cvt_pk_bf16(bflo(w_.z) * w8[4], bfhi(w_.z) * w8[5]); o_.w = cvt_pk_bf16(bflo(w_.w) * w8[6], bfhi(w_.w) * w8[7]); \
            const bf16x8 aw_ = __builtin_bit_cast(bf16x8, o_); \
            acc[at][0] = mfma16(aw_, fb[B][0][ks], acc[at][0]); acc[at][1] = mfma16(aw_, fb[B][1][ks], acc[at][1]); } } } while (0)
    RS_LOAD(0, 0); __builtin_amdgcn_sched_barrier(0);
    for (int i = 0; i < 18; i += 2) {
        if (i + 1 < 17) RS_LOAD(1, i + 1);
        __builtin_amdgcn_sched_barrier(0);
        if (i >= 2) RS_STORE(i);
        if (i < 17) RS_COMPUTE(0);
        if (i + 2 < 17) RS_LOAD(0, i + 2);
        __builtin_amdgcn_sched_barrier(0);
        if (i + 1 >= 2) RS_STORE(i + 1);
        if (i + 1 < 17) RS_COMPUTE(1);
    }
#undef RS_TOK
#undef RS_LOAD
#undef RS_STORE
#undef RS_COMPUTE
}

template <bool LOCAL>
DI void na_step1(const bf16x8 (&kf)[2][2], const bf16x8 (&vf)[4], const bf16x8 (&qf)[2], f32x4 (&O)[4], float& mrun, float& lrun,
                 const LAS float* bp, const f32x4 (&madd)[2]) {
    f32x4 s[2];
    if (LOCAL) {
#pragma unroll
        for (int tau = 0; tau < 2; ++tau) {
            float b0 = bp[4 * tau], b1 = bp[4 * tau + 1], b2 = bp[4 * tau + 2], b3 = bp[4 * tau + 3];
            asm volatile("" : "+v"(b0), "+v"(b1), "+v"(b2), "+v"(b3));
            s[tau] = (f32x4){b0, b1, b2, b3} + madd[tau];
        }
    } else { s[0] = (f32x4){0.f, 0.f, 0.f, 0.f}; s[1] = s[0]; }
#pragma unroll
    for (int tau = 0; tau < 2; ++tau) { s[tau] = mfma16(kf[tau][0], qf[0], s[tau]); s[tau] = mfma16(kf[tau][1], qf[1], s[tau]); }
    float mx = fmaxf(fmaxf(fmaxf(s[0][0], s[0][1]), fmaxf(s[0][2], s[0][3])), fmaxf(fmaxf(s[1][0], s[1][1]), fmaxf(s[1][2], s[1][3])));
    mx = fmaxf(mx, __shfl_xor(mx, 16)); mx = fmaxf(mx, __shfl_xor(mx, 32));
    const float mnew = fmaxf(mrun, mx), alpha = ex2(mrun - mnew);
    mrun = mnew;
    float ps = 0.f;
#pragma unroll
    for (int tau = 0; tau < 2; ++tau)
#pragma unroll
        for (int e = 0; e < 4; ++e) { s[tau][e] = ex2(s[tau][e] - mnew); ps += s[tau][e]; }
    lrun = lrun * alpha + ps;
    u32x4 pw; pw.x = cvt_pk_bf16(s[0][0], s[0][1]); pw.y = cvt_pk_bf16(s[0][2], s[0][3]); pw.z = cvt_pk_bf16(s[1][0], s[1][1]); pw.w = cvt_pk_bf16(s[1][2], s[1][3]);
    const bf16x8 pf = __builtin_bit_cast(bf16x8, pw);
#pragma unroll
    for (int dt = 0; dt < 4; ++dt) { O[dt] *= alpha; O[dt] = mfma16(vf[dt], pf, O[dt]); }
}
DI void na_step2(const bf16x8 (&kf)[2][2], const bf16x8 (&vf)[4], const bf16x8 (&kc)[2][2], const bf16x8 (&vc)[4], const bf16x8 (&qf)[2], f32x4 (&O)[4], float& mrun, float& lrun,
                 const LAS float* bp, const f32x4 (&madd)[2]) {
    f32x4 s[4];
#pragma unroll
    for (int tau = 0; tau < 2; ++tau) {
        float b0 = bp[4 * tau], b1 = bp[4 * tau + 1], b2 = bp[4 * tau + 2], b3 = bp[4 * tau + 3];
        asm volatile("" : "+v"(b0), "+v"(b1), "+v"(b2), "+v"(b3));
        s[tau] = (f32x4){b0, b1, b2, b3} + madd[tau];
        s[2 + tau] = (f32x4){0.f, 0.f, 0.f, 0.f};
    }
    __builtin_amdgcn_s_setprio(1);
#pragma unroll
    for (int tau = 0; tau < 2; ++tau) { s[tau] = mfma16(kf[tau][0], qf[0], s[tau]); s[2 + tau] = mfma16(kc[tau][0], qf[0], s[2 + tau]); }
#pragma unroll
    for (int tau = 0; tau < 2; ++tau) { s[tau] = mfma16(kf[tau][1], qf[1], s[tau]); s[2 + tau] = mfma16(kc[tau][1], qf[1], s[2 + tau]); }
    __builtin_amdgcn_s_setprio(0);
    float mx = fmaxf(fmaxf(fmaxf(s[0][0], s[0][1]), fmaxf(s[0][2], s[0][3])), fmaxf(fmaxf(s[1][0], s[1][1]), fmaxf(s[1][2], s[1][3])));
    mx = fmaxf(mx, fmaxf(fmaxf(fmaxf(s[2][0], s[2][1]), fmaxf(s[2][2], s[2][3])), fmaxf(fmaxf(s[3][0], s[3][1]), fmaxf(s[3][2], s[3][3]))));
    mx = fmaxf(mx, __shfl_xor(mx, 16)); mx = fmaxf(mx, __shfl_xor(mx, 32));
    const float mnew = fmaxf(mrun, mx), alpha = ex2(mrun - mnew);
    mrun = mnew;
    float ps = 0.f;
#pragma unroll
    for (int t = 0; t < 4; ++t)
#pragma unroll
        for (int e = 0; e < 4; ++e) { s[t][e] = ex2(s[t][e] - mnew); ps += s[t][e]; }
    lrun = lrun * alpha + ps;
    u32x4 pw; pw.x = cvt_pk_bf16(s[0][0], s[0][1]); pw.y = cvt_pk_bf16(s[0][2], s[0][3]); pw.z = cvt_pk_bf16(s[1][0], s[1][1]); pw.w = cvt_pk_bf16(s[1][2], s[1][3]);
    const bf16x8 pfl = __builtin_bit_cast(bf16x8, pw);
    pw.x = cvt_pk_bf16(s[2][0], s[2][1]); pw.y = cvt_pk_bf16(s[2][2], s[2][3]); pw.z = cvt_pk_bf16(s[3][0], s[3][1]); pw.w = cvt_pk_bf16(s[3][2], s[3][3]);
    const bf16x8 pfc = __builtin_bit_cast(bf16x8, pw);
#pragma unroll
    for (int dt = 0; dt < 4; ++dt) O[dt] *= alpha;
    __builtin_amdgcn_s_setprio(1);
#pragma unroll
    for (int dt = 0; dt < 4; ++dt) { O[dt] = mfma16(vf[dt], pfl, O[dt]); O[dt] = mfma16(vc[dt], pfc, O[dt]); }
    __builtin_amdgcn_s_setprio(0);
}
DI void na_item(const Params& p, LAS unsigned char* lds, int item) {
    const int tid = threadIdx.x, lane = tid & 63, wave = __builtin_amdgcn_readfirstlane(tid >> 6);
    const int half = item & 1, h = (item >> 1) & 7, b = item >> 4;
    const int j = wave & 3, rr = wave >> 2, c = lane & 15, g = lane >> 4;
    const bf16_t* P = (const bf16_t*)(p.ws + WS_P); const char* KT = (const char*)(p.ws + WS_KT); const char* VT = (const char*)(p.ws + WS_VT);
    bf16_t* Y = (bf16_t*)(p.ws + WS_Y);
    LAS float* rpb = (LAS float*)lds;
    LAS unsigned char* Kc = lds + 4096;
    LAS unsigned char* Vc = lds + 4096 + 32768;
    __syncthreads();
    for (int idx = tid; idx < 15 * 64; idx += 512) { const int dr = idx >> 6, xx = (idx & 63) - 16;
        rpb[idx] = (xx >= 0 && xx < 31) ? p.na_rpb[(h * 15 + dr) * 31 + xx] * LOG2E : 0.f; }
#pragma unroll
    for (int i = 0; i < 4; ++i) { const int idx = tid + 512 * i, blk = idx >> 6, q = idx & 63;
        const size_t tb = (size_t)(((MLAT + b * CTXL) >> 3) + blk) * 8 + h;
        { const int row = blk * 8 + (q & 7), pc = (q >> 5) * 4 + ((q >> 3) & 3);
          *(LAS bf16x8*)(Kc + row * 128 + ((pc ^ (((row >> 1) & 1) | (((row >> 3) & 3) << 1))) << 4)) = *(const bf16x8*)(KT + tb * 1024 + q * 16); }
        { const int row = q, pc = blk;
          *(LAS bf16x8*)(Vc + row * 512 + ((pc ^ (row & 15)) << 4)) = *(const bf16x8*)(VT + tb * 1024 + q * 16); } }
    __syncthreads();
    const int cw0 = (j == 0) ? 0 : (j == 1) ? 8 : (j == 2) ? 24 : 32;
    const int kap0 = 8 * (c >> 2) + (c & 3);
    const int cq = 16 * j + c; int c0 = cq - 8; c0 = c0 < 0 ? 0 : (c0 > 48 ? 48 : c0);
    const LAS float* rpbl = rpb + 16 + (cw0 + 8 * g - cq + 15);
    f32x4 madd[2];
#pragma unroll
    for (int tau = 0; tau < 2; ++tau)
#pragma unroll
        for (int e = 0; e < 4; ++e) { const int ck = cw0 + 8 * g + 4 * tau + e; madd[tau][e] = (ck >= c0 && ck < c0 + 16) ? 0.f : -INFINITY; }
    const unsigned klo = (unsigned)((c >> 2) * 8192 + (g * 8 + (c & 3)) * 16), vlo = (unsigned)(g * 8192 + c * 16);
    const unsigned kcb = (unsigned)(kap0 * 128), vcb = (unsigned)(c * 512);
    unsigned kx[2]; kx[0] = (unsigned)(((g) ^ (c >> 1)) << 4); kx[1] = (unsigned)(((4 + g) ^ (c >> 1)) << 4);
    for (int ui = 0; ui < 8; ++ui) {
        const int rp = 8 * half + ui, r = 2 * rp + rr;
        int r0 = r - 4; r0 = r0 < 0 ? 0 : (r0 > 24 ? 24 : r0);
        const size_t tok = (size_t)(b * SEQ + r * 64 + 16 * j + c);
        bf16x8 qf[2];
#pragma unroll
        for (int ks = 0; ks < 2; ++ks) qf[ks] = ldg8(P + tok * LDP + PC_NAQ + h * 64 + 32 * ks + 8 * g);
        f32x4 O[4]; float mrun = -1e30f, lrun = 0.f;
#pragma unroll
        for (int dt = 0; dt < 4; ++dt) O[dt] = (f32x4){0.f, 0.f, 0.f, 0.f};
        const size_t tb0 = (size_t)(((b * SEQ + r0 * 64 + cw0) >> 3) * 8 + h) * 1024;
        const char* kb0 = KT + tb0; const char* vb0 = VT + tb0;
        const LAS float* bp0 = rpbl + (r0 - r + 7) * 64;
        bf16x8 kf[2][2][2], vf[2][4], kc[2][2], vc[4];
#define NA_LOADL(B, st) do { _Pragma("unroll") for (int tau = 0; tau < 2; ++tau) _Pragma("unroll") for (int ks = 0; ks < 2; ++ks) \
            kf[B][tau][ks] = ldg8u((const bf16_t*)(kb0 + (size_t)(st) * 65536 + ks * 512 + tau * 64), klo); \
            _Pragma("unroll") for (int dt = 0; dt < 4; ++dt) vf[B][dt] = ldg8u((const bf16_t*)(vb0 + (size_t)(st) * 65536 + dt * 256), vlo); } while (0)
#define NA_LOADC(st) do { _Pragma("unroll") for (int tau = 0; tau < 2; ++tau) _Pragma("unroll") for (int ks = 0; ks < 2; ++ks) \
            kc[tau][ks] = *(const LAS bf16x8*)(Kc + kcb + kx[ks] + (32 * (st) + 4 * tau) * 128); \
            { unsigned va_ = vcb + (unsigned)((((4 * (st) + g) ^ c)) << 4); _Pragma("unroll") for (int dt = 0; dt < 4; ++dt) vc[dt] = *(const LAS bf16x8*)(Vc + va_ + (16 * dt) * 512); } } while (0)
        NA_LOADL(0, 0); __builtin_amdgcn_sched_barrier(0);
#pragma unroll 1
        for (int st = 0; st < 8; st += 2) {
            NA_LOADL(1, st + 1); __builtin_amdgcn_sched_barrier(0);
            NA_LOADC(st);
            na_step2(kf[0], vf[0], kc, vc, qf, O, mrun, lrun, bp0 + st * 64, madd);
            if (st + 2 < 8) NA_LOADL(0, st + 2);
            __builtin_amdgcn_sched_barrier(0);
            NA_LOADC(st + 1);
            na_step2(kf[1], vf[1], kc, vc, qf, O, mrun, lrun, bp0 + (st + 1) * 64, madd);
        }
#undef NA_LOADL
#undef NA_LOADC
        lrun += __shfl_xor(lrun, 16); lrun += __shfl_xor(lrun, 32);
        const float inv = __builtin_amdgcn_rcpf(lrun);
#pragma unroll
        for (int dt = 0; dt < 4; ++dt) {
            const f32x4 o = O[dt] * inv;
            const u32x2 gw = *(const u32x2*)(P + tok * LDP + PC_NAG + h * 64 + 16 * dt + 4 * g);
            u32x2 w; w.x = cvt_pk_bf16(o[0] * silu_f(bflo(gw.x)), o[1] * silu_f(bfhi(gw.x))); w.y = cvt_pk_bf16(o[2] * silu_f(bflo(gw.y)), o[3] * silu_f(bfhi(gw.y)));
            *(u32x2*)(Y + tok * DM + h * 64 + 16 * dt + 4 * g) = w;
        }
    }
}

DI void ret_out_phase(const Params& p, LAS unsigned char* lds, int vb, int G) {
    const int tid = threadIdx.x, lane = tid & 63, wave = __builtin_amdgcn_readfirstlane(tid >> 6), c = lane & 15, g = lane >> 4;
    const bf16_t* P = (const bf16_t*)(p.ws + WS_P); const bf16_t* PT = (const bf16_t*)(p.ws + WS_PT);
    const bf16_t* SFg = (const bf16_t*)(p.ws + WS_SF); const bf16_t* SBg = (const bf16_t*)(p.ws + WS_SB); const char* RTg = (const char*)(p.ws + WS_RT);
    bf16_t* Y = (bf16_t*)(p.ws + WS_Y);
    LAS unsigned char* Ks = lds; LAS unsigned char* Vs = lds + 32768; LAS unsigned char* SFs = lds + 65536; LAS unsigned char* SBs = lds + 98304;
    const int prow = tid >> 4, pc = tid & 15;
    const unsigned wK = (unsigned)(prow * 256 + ((pc ^ ((prow & 3) | (((prow >> 3) & 3) << 2))) << 4));
    const unsigned wV = (unsigned)(prow * 256 + ((pc ^ (prow & 15)) << 4));
    unsigned xo[4];
#pragma unroll
    for (int x = 0; x < 4; ++x) xo[x] = (unsigned)((((4 * x + g) ^ c)) << 4);
    const unsigned rK = (unsigned)((8 * (c >> 2) + (c & 3)) * 256), rV = (unsigned)(c * 256);
    bf16x8 st[8];
#define RO_LOAD_KV(uu) do { const int n_ = (uu) & 15, h_ = ((uu) >> 4) & 3, b_ = (uu) >> 6; \
        const bf16_t* kp_ = P + (size_t)(b_ * SEQ + 128 * n_ + prow) * LDP + PC_RK + h_ * 128 + pc * 8; \
        const char* vp_ = RTg + ((size_t)(((b_ * SEQ + 128 * n_) >> 3) + (tid >> 7)) * 1024 + 512 + h_ * 128 + (tid & 127)) * 16; \
        _Pragma("unroll") for (int i = 0; i < 4; ++i) { st[i] = ldg8(kp_ + (size_t)(32 * i) * LDP); st[4 + i] = *(const bf16x8*)(vp_ + (size_t)(4 * i) * 16384); } } while (0)
#define RO_LOAD_S(uu) do { const int n_ = (uu) & 15, h_ = ((uu) >> 4) & 3, b_ = (uu) >> 6; \
        const size_t so_ = (size_t)((b_ * 4 + h_) * 16 + n_) * 16384 + prow * 128 + pc * 8; \
        _Pragma("unroll") for (int i = 0; i < 4; ++i) { st[i] = ldg8(SFg + so_ + (32 * i) * 128); st[4 + i] = ldg8(SBg + so_ + (32 * i) * 128); } } while (0)
#define RO_STORE_KV() do { _Pragma("unroll") for (int i = 0; i < 4; ++i) { \
        *(LAS bf16x8*)(Ks + wK + i * 8192) = st[i]; \
        *(LAS bf16x8*)(Vs + (tid & 127) * 256 + (((((tid >> 7) + 4 * i)) ^ (tid & 15)) << 4)) = st[4 + i]; } } while (0)
#define RO_STORE(A0, W0, A1, W1) do { _Pragma("unroll") for (int i = 0; i < 4; ++i) { \
        *(LAS bf16x8*)((A0) + (W0) + i * 8192) = st[i]; *(LAS bf16x8*)((A1) + (W1) + i * 8192) = st[4 + i]; } } while (0)
    int u = vb;
    if (u < 1024) RO_LOAD_KV(u);
    for (; u < 1024; u += G) {
        const int n = u & 15, h = (u >> 4) & 3, b = u >> 6;
        const int tl = 16 * wave + c;
        const size_t tok = (size_t)(b * SEQ + 128 * n + tl);
        const float lgf2 = -__expf(p.dec_f[h]) * LOG2E, lgb2 = -__expf(p.dec_b[h]) * LOG2E;
        RO_STORE_KV();
        RO_LOAD_S(u); __builtin_amdgcn_sched_barrier(0);
        bf16x8 qf[4];
#pragma unroll
        for (int ks = 0; ks < 4; ++ks) qf[ks] = ldg8(P + tok * LDP + PC_RQ + h * 128 + 32 * ks + 8 * g);
        u32x2 gwv[8];
#pragma unroll
        for (int dt = 0; dt < 8; ++dt) gwv[dt] = *(const u32x2*)(P + tok * LDP + PC_RG + h * 128 + 16 * dt + 4 * g);
        __syncthreads();
        f32x4 O[8];
#pragma unroll
        for (int dt = 0; dt < 8; ++dt) O[dt] = (f32x4){0.f, 0.f, 0.f, 0.f};
#pragma unroll
        for (int sg = 0; sg < 4; ++sg) {
            int tlv = tl - 8 * g; asm volatile("" : "+v"(tlv));
            f32x4 s_[2];
#pragma unroll
            for (int tau = 0; tau < 2; ++tau) {
                s_[tau] = (f32x4){0.f, 0.f, 0.f, 0.f};
#pragma unroll
                for (int ks = 0; ks < 4; ++ks) { unsigned a_ = rK + xo[ks]; asm volatile("" : "+v"(a_)); s_[tau] = mfma16(*(const LAS bf16x8*)(Ks + a_ + (32 * sg + 4 * tau) * 256), qf[ks], s_[tau]); }
            }
#pragma unroll
            for (int tau = 0; tau < 2; ++tau)
#pragma unroll
                for (int e = 0; e < 4; ++e) {
                    const int dl_ = tlv - (32 * sg + 4 * tau + e);
                    const float lg_ = dl_ > 0 ? lgf2 : lgb2; float d_ = ex2(lg_ * fabsf((float)dl_)); d_ = dl_ == 0 ? 2.0f : d_; s_[tau][e] *= d_; }
            u32x4 pw_; pw_.x = cvt_pk_bf16(s_[0][0], s_[0][1]); pw_.y = cvt_pk_bf16(s_[0][2], s_[0][3]); pw_.z = cvt_pk_bf16(s_[1][0], s_[1][1]); pw_.w = cvt_pk_bf16(s_[1][2], s_[1][3]);
            const bf16x8 pf = __builtin_bit_cast(bf16x8, pw_);
            unsigned av_ = 32768u + rV + xo[sg]; asm volatile("" : "+v"(av_));
#pragma unroll
            for (int dt = 0; dt < 8; ++dt) O[dt] = mfma16(*(const LAS bf16x8*)(lds + av_ + (16 * dt) * 256), pf, O[dt]);
            __builtin_amdgcn_sched_barrier(0);
        }
        RO_STORE(SFs, wV, SBs, wV);
        if (u + G < 1024) RO_LOAD_KV(u + G);
        __builtin_amdgcn_sched_barrier(0);
        __syncthreads();
        const float cF = ex2(lgf2 * (float)(tl + 1)), cB = ex2(lgb2 * (float)(128 - tl));
#pragma unroll
        for (int ks = 0; ks < 4; ++ks) {
            const bf16x8 qF_ = scale_frag(qf[ks], cF), qB_ = scale_frag(qf[ks], cB);
            unsigned af_ = 65536u + rV + xo[ks], ab_ = 98304u + rV + xo[ks]; asm volatile("" : "+v"(af_), "+v"(ab_));
#pragma unroll
            for (int dt = 0; dt < 8; ++dt) {
                O[dt] = mfma16(*(const LAS bf16x8*)(lds + af_ + (16 * dt) * 256), qF_, O[dt]);
                O[dt] = mfma16(*(const LAS bf16x8*)(lds + ab_ + (16 * dt) * 256), qB_, O[dt]);
            }
            __builtin_amdgcn_sched_barrier(0);
        }
        float ss = 0.f;
#pragma unroll
        for (int dt = 0; dt < 8; ++dt) ss += (O[dt][0] * O[dt][0] + O[dt][1] * O[dt][1]) + (O[dt][2] * O[dt][2] + O[dt][3] * O[dt][3]);
        ss += __shfl_xor(ss, 16); ss += __shfl_xor(ss, 32);
        const float rstd = rsqrtf(ss * (1.f / 128.f) + EPSN);
#pragma unroll
        for (int dt = 0; dt < 8; ++dt) {
            const int dv = 16 * dt + 4 * g;
            const f32x4 gn = *(const f32x4*)(p.ret_norm_g + h * 128 + dv);
            const u32x2 gw = gwv[dt];
            const f32x4 o = O[dt] * rstd * gn;
            u32x2 w; w.x = cvt_pk_bf16(o[0] * silu_f(bflo(gw.x)), o[1] * silu_f(bfhi(gw.x))); w.y = cvt_pk_bf16(o[2] * silu_f(bflo(gw.y)), o[3] * silu_f(bfhi(gw.y)));
            *(u32x2*)(Y + tok * DM + 512 + h * 128 + dv) = w;
        }
    }
#undef RO_LOAD_KV
#undef RO_LOAD_S
#undef RO_STORE
#undef RO_STORE_KV
}

DI void phase_p5(const Params& p, int vb, int G) {
    const int tid = threadIdx.x, lane = tid & 63, wave = tid >> 6;
    const int gw = vb * 8 + wave, NGW = G * 8;
    f32x4 gn[4];
#pragma unroll
    for (int j = 0; j < 4; ++j) gn[j] = *(const f32x4*)(p.final_g + 4 * lane + 256 * j);
    for (int grp = gw; grp < MLAT / 4; grp += NGW) {
        f32x4* xr = (f32x4*)(p.out + (size_t)grp * 4 * DM) + lane;
        f32x4 v[4][4]; float sq[4];
#pragma unroll
        for (int r = 0; r < 4; ++r)
#pragma unroll
            for (int j = 0; j < 4; ++j) v[r][j] = xr[r * 256 + 64 * j];
#pragma unroll
        for (int r = 0; r < 4; ++r) { float s = 0.f;
#pragma unroll
            for (int j = 0; j < 4; ++j) s += (v[r][j].x * v[r][j].x + v[r][j].y * v[r][j].y) + (v[r][j].z * v[r][j].z + v[r][j].w * v[r][j].w);
            sq[r] = s; }
#pragma unroll
        for (int o = 1; o < 64; o <<= 1)
#pragma unroll
            for (int r = 0; r < 4; ++r) sq[r] += __shfl_xor(sq[r], o);
#pragma unroll
        for (int r = 0; r < 4; ++r) { const float rstd = rsqrtf(sq[r] * (1.f / DM) + EPSN);
#pragma unroll
            for (int j = 0; j < 4; ++j) xr[r * 256 + 64 * j] = v[r][j] * rstd * gn[j]; }
    }
}

#define XB_TMO      128
#define XB_XCNT(j)  (256  + 64 * (j))
#define XB_XSUB(j)  (1280 + 64 * (j))
#define XB_XGEN(j)  (2304 + 64 * (j))
#define XB_TOP      3328
#define XB_TOPGEN   3392
#define XCD_BAR_WORDS 3456
#define XB_SPIN_CAP (1u << 18)
DI unsigned xb_ld(unsigned* p)              { return __hip_atomic_load(p, __ATOMIC_RELAXED, __HIP_MEMORY_SCOPE_AGENT); }
DI unsigned xb_add(unsigned* p, unsigned v) { return __hip_atomic_fetch_add(p, v, __ATOMIC_RELAXED, __HIP_MEMORY_SCOPE_AGENT); }
DI unsigned xb_xcc_id() { return (unsigned)__builtin_amdgcn_s_getreg((3 << 11) | 20) & 0xFu; }
#define XB_SPIN(cond, bar) do { unsigned _sp = 0; while (cond) { __builtin_amdgcn_s_sleep(1); \
    if ((++_sp & 255u) == 0u) { if (xb_ld(&(bar)[XB_TMO])) break; if (_sp > XB_SPIN_CAP) { atomicAdd(&(bar)[XB_TMO], 1u); break; } } } } while (0)
struct XcdBarrier { unsigned* bar; unsigned x; volatile LAS unsigned* st; };
DI XcdBarrier xcd_barrier_post(unsigned* bar, volatile LAS unsigned* st) {
    XcdBarrier b; b.bar = bar; b.x = xb_xcc_id(); b.st = st;
    if (threadIdx.x == 0) (void)xb_add(&bar[XB_XCNT(b.x)], 1u);
    return b;
}
DI void xcd_barrier_complete(unsigned* bar, unsigned x, unsigned& nloc, unsigned& nx) {
    const unsigned G = gridDim.x * gridDim.y * gridDim.z;
    unsigned sum, cnt, mine, sp = 0u;
    for (;;) {
        sum = 0u; cnt = 0u; mine = 0u;
#pragma unroll
        for (unsigned j = 0; j < 16; ++j) { const unsigned c = xb_ld(&bar[XB_XCNT(j)]); sum += c; cnt += (c > 0u) ? 1u : 0u; mine = (j == x) ? c : mine; }
        if (sum == G) break;
        __builtin_amdgcn_s_sleep(1);
        if ((++sp & 255u) == 0u) { if (xb_ld(&bar[XB_TMO])) break; if (sp > XB_SPIN_CAP) { atomicAdd(&bar[XB_TMO], 1u); break; } }
    }
    nloc = mine > 0u ? mine : 1u; nx = cnt > 0u ? cnt : 1u;
}
DI void xcd_barrier(const XcdBarrier& b) {
    asm volatile("s_waitcnt vmcnt(0)" ::: "memory");
    __syncthreads();
    if (threadIdx.x == 0) {
        unsigned* bar = b.bar;
        __builtin_amdgcn_s_waitcnt(0);
        unsigned nloc = b.st[0], nx = b.st[1];
        if (nloc == 0u) { xcd_barrier_complete(bar, b.x, nloc, nx); b.st[0] = nloc; b.st[1] = nx; }
        const unsigned old = xb_add(&bar[XB_XSUB(b.x)], 1u);
        const unsigned gen = old / nloc;
        if (old + 1u == (gen + 1u) * nloc) {
            __builtin_amdgcn_fence(__ATOMIC_RELEASE, "agent");
            asm volatile("s_waitcnt vmcnt(0)" ::: "memory");
            const unsigned og = xb_add(&bar[XB_TOP], 1u);
            const unsigned tg = og / nx;
            if (og + 1u == (tg + 1u) * nx) xb_add(&bar[XB_TOPGEN], 1u);
            else XB_SPIN(xb_ld(&bar[XB_TOPGEN]) == tg, bar);
            __builtin_amdgcn_fence(__ATOMIC_ACQUIRE, "agent");
            xb_add(&bar[XB_XGEN(b.x)], 1u);
            asm volatile("s_waitcnt vmcnt(0)" ::: "memory");
        } else {
            XB_SPIN(xb_ld(&bar[XB_XGEN(b.x)]) == gen, bar);
            __builtin_amdgcn_fence(__ATOMIC_ACQUIRE, "agent");
            asm volatile("s_waitcnt vmcnt(0)" ::: "memory");
        }
    }
    __syncthreads();
}
__global__ void __launch_bounds__(512, 2) mega_fwd(Params p) {
    extern __shared__ __attribute__((aligned(16))) unsigned char lds_raw[];
    LAS unsigned char* lds = (LAS unsigned char*)lds_raw;
    const int G = gridDim.x, bx = blockIdx.x;
    const int vb = (G % 8 == 0) ? (bx % 8) * (G / 8) + bx / 8 : bx;
    const int tid = threadIdx.x;
    volatile LAS unsigned* MISC = (volatile LAS unsigned*)(lds + 131072);
    if (tid < 16) MISC[tid] = 0u;
    __syncthreads();
    (void)xcd_barrier_post((unsigned*)p.ws, MISC);
#define GRID_BAR() do { XcdBarrier b_; b_.bar = (unsigned*)p.ws; b_.x = xb_xcc_id(); b_.st = (volatile LAS unsigned*)(lds + 131072); xcd_barrier(b_); } while (0)

#ifndef REPMASK
#define REPMASK 0
#endif
#define PH_P0()  phase_p0(p, lds, vb, G)
#define PH_P0B() phase_p0b(p, vb, G)
#define PH_P1()  do { InSched S{(const char*)(p.ws + WS_XN), (const char*)(p.ws + WS_WT), bx, G}; \
        EpiIn E{(bf16_t*)(p.ws + WS_P), (bf16_t*)(p.ws + WS_KT), (bf16_t*)(p.ws + WS_PT), (const float*)(p.ws + WS_COS), (const float*)(p.ws + WS_SIN), (const float*)(p.ws + WS_COST), (const float*)(p.ws + WS_SINT), lds + 131072 + 256}; \
        pg8::gemm_phase<EpiIn, InSched>(lds, S, E); } while (0)
#define PH_R1()  do { for (int it = vb; it < 256; it += G) ret_state_item(p, it); } while (0)
#define PH_NA()  do { for (int it = vb; it < 256; it += G) na_item(p, lds, it); } while (0)
#define PH_R2()  ret_out_phase(p, lds, vb, G)
#define PH_P4()  do { OutSched S{(const char*)(p.ws + WS_Y), (const char*)(p.ws + WS_WOT), vb, G}; \
        EpiOutF E{p.x, (const float*)(p.ws + WS_MOD), p.final_g, p.out, (float*)(p.ws + WS_XBUF), (unsigned*)(p.ws + WS_CNT), lds + 131072 + 256}; \
        pg8::gemm_phase<EpiOutF, OutSched>(lds, S, E); } while (0)
    PH_P0();
#if REPMASK & 1
    PH_P0();
#endif
    GRID_BAR();
    PH_P0B();
#if REPMASK & 2
    PH_P0B();
#endif
    GRID_BAR();
    PH_P1();
#if REPMASK & 4
    PH_P1();
#endif
    GRID_BAR();
    PH_R1();
#if REPMASK & 8
    PH_R1();
#endif
    PH_NA();
#if REPMASK & 16
    PH_NA();
#endif
    GRID_BAR();
    PH_R2();
#if REPMASK & 32
    PH_R2();
#endif
    GRID_BAR();
    PH_P4();
}

extern "C" void kernel_launch(void* const* d_in, const int* in_sizes, int n_in, void* d_out, int out_size, void* d_ws, size_t ws_size, hipStream_t stream) {
    static int grid = 0;
    if (grid == 0) {
        if (n_in != 14 || out_size != MLAT * DM || ws_size < WS_END) { fprintf(stderr, "kernel_launch: unexpected shapes (n_in %d, out %d, ws %zu)\n", n_in, out_size, ws_size); grid = -1; return; }
        int dev = 0, cus = 0, per_cu = 0;
        hipGetDevice(&dev);
        hipDeviceGetAttribute(&cus, hipDeviceAttributeMultiprocessorCount, dev);
        hipFuncSetAttribute((const void*)mega_fwd, hipFuncAttributeMaxDynamicSharedMemorySize, LDS_BYTES);
        hipOccupancyMaxActiveBlocksPerMultiprocessor(&per_cu, (const void*)mega_fwd, 512, LDS_BYTES);
        if (per_cu < 1 || cus < 1) { fprintf(stderr, "kernel_launch: occupancy query says %d blocks per CU (%d CUs)\n", per_cu, cus); grid = -1; return; }
        grid = cus;
    }
    if (grid < 0) return;
    Params p{};
    p.x = (const float*)d_in[0]; p.c = (const float*)d_in[1]; p.ctx = (const float*)d_in[2]; p.c_ctx = (const float*)d_in[3];
    p.norm_g = (const float*)d_in[4]; p.w_ada = (const float*)d_in[5]; p.b_ada = (const float*)d_in[6]; p.w_in = (const float*)d_in[7];
    p.na_rpb = (const float*)d_in[8]; p.dec_f = (const float*)d_in[9]; p.dec_b = (const float*)d_in[10]; p.ret_norm_g = (const float*)d_in[11];
    p.w_out = (const float*)d_in[12]; p.final_g = (const float*)d_in[13];
    p.out = (float*)d_out; p.ws = (unsigned char*)d_ws;
    if (hipMemsetAsync(d_ws, 0, 65536, stream) != hipSuccess) { fprintf(stderr, "kernel_launch: memset of the barrier words failed\n"); return; }
    hipLaunchKernelGGL(mega_fwd, dim3(grid), dim3(512), LDS_BYTES, stream, p);
    const hipError_t e = hipPeekAtLastError();
    if (e != hipSuccess) fprintf(stderr, "launch failed: %s (grid %d)\n", hipGetErrorString(e), grid);
}
```

```cpp
#include <hip/hip_runtime.h>
#include <cstdio>
#include <cstdint>

#define DI __device__ __forceinline__
#define LAS __attribute__((address_space(3)))
typedef unsigned short bf16_t;
typedef short bf16x8 __attribute__((ext_vector_type(8)));
typedef float f32x4 __attribute__((ext_vector_type(4)));
typedef unsigned u32x4 __attribute__((ext_vector_type(4)));
typedef unsigned u32x2 __attribute__((ext_vector_type(2)));

constexpr int DM = 1024, NBATCH = 16, SEQ = 2048, CTXL = 256;
constexpr int MLAT = NBATCH * SEQ, MCTX = NBATCH * CTXL, MTOT = MLAT + MCTX;
constexpr int LDP = 2560 + 128;
constexpr int LDT = MTOT + 128;
constexpr int LDKC = 512 + 128;
constexpr int PC_NAQ = 0, PC_NAG = 512, PC_RQ = 1024, PC_RK = 1536, PC_RG = 2048;
constexpr int PT_NAV = 0, PT_RK = 512, PT_RV = 1024;
constexpr float LOG2E = 1.4426950408889634f;
constexpr float KSCALE = 0.08838834764831845f;
constexpr float EPSN = 1e-6f;
constexpr int NWT = 4608;

constexpr size_t MiB = 1u << 20;
constexpr size_t WS_WT = 2 * MiB, WS_WOT = 12 * MiB, WS_MODP = 24 * MiB  , WS_MOD = 15 * MiB;
constexpr size_t WS_CNT = 16384;
constexpr size_t WS_XBUF = 20 * MiB;
constexpr size_t WS_COS = 16 * MiB, WS_SIN = WS_COS + 512 * 1024, WS_COST = 17 * MiB, WS_SINT = WS_COST + 512 * 1024;
constexpr size_t WS_XN = 32 * MiB;
constexpr size_t WS_Y = 32 * MiB;
constexpr size_t WS_P = 104 * MiB;
constexpr size_t WS_KT = 272 * MiB;
constexpr size_t WS_PT = 310 * MiB;
constexpr size_t WS_VT = WS_PT;
constexpr size_t WS_RT = WS_PT + (size_t)512 * LDT * 2;
static_assert((size_t)MTOT * 1024 * 2 <= (size_t)1024 * LDT * 2, "RT fits the old PT rows");
constexpr size_t WS_SF = 419 * MiB, WS_SB = 451 * MiB;
constexpr size_t WS_END = 483 * MiB;
static_assert(WS_P + (size_t)MLAT * LDP * 2 <= WS_KT && WS_KT + (size_t)MTOT * 512 * 2 <= WS_PT && (size_t)MTOT * 512 * 2 <= (size_t)512 * LDT * 2 && WS_PT + (size_t)1536 * LDT * 2 <= WS_SF, "ws map");

constexpr int LDS_BYTES = 131072 + 256 + 5120 + 8 * 2304;

struct Params {
    const float *x, *c, *ctx, *c_ctx, *norm_g, *w_ada, *b_ada, *w_in, *na_rpb, *dec_f, *dec_b, *ret_norm_g, *w_out, *final_g;
    float* out; unsigned char* ws;
};

DI unsigned cvt_pk_bf16(float lo, float hi) { unsigned r; asm volatile("v_cvt_pk_bf16_f32 %0, %1, %2" : "=v"(r) : "v"(lo), "v"(hi)); return r; }
DI float bf2f(unsigned short v) { return __uint_as_float(((unsigned)v) << 16); }
DI float bflo(unsigned w) { return __uint_as_float(w << 16); }
DI float bfhi(unsigned w) { return __uint_as_float(w & 0xffff0000u); }
DI f32x4 mfma16(bf16x8 a, bf16x8 b, f32x4 c) { return __builtin_amdgcn_mfma_f32_16x16x32_bf16(a, b, c, 0, 0, 0); }
DI bf16x8 ldg8(const bf16_t* p) { return *(const bf16x8*)p; }
#define GAS __attribute__((address_space(1)))
DI bf16x8 ldg8u(const bf16_t* ub, unsigned off_bytes) {
    const GAS char* gp = (const GAS char*)ub; asm volatile("" : "+s"(gp));
    return *(const GAS bf16x8*)(gp + off_bytes); }
DI float ex2(float x) { return __builtin_amdgcn_exp2f(x); }
DI float wave_sum(float v) {
#pragma unroll
    for (int o = 1; o < 64; o <<= 1) v += __shfl_xor(v, o);
    return v;
}
DI float silu_f(float v) { return v * __builtin_amdgcn_rcpf(1.f + ex2(v * -LOG2E)); }
DI bf16x8 scale_frag(bf16x8 a, float s) {
    u32x4 w = __builtin_bit_cast(u32x4, a), o;
    o.x = cvt_pk_bf16(bflo(w.x) * s, bfhi(w.x) * s); o.y = cvt_pk_bf16(bflo(w.y) * s, bfhi(w.y) * s);
    o.z = cvt_pk_bf16(bflo(w.z) * s, bfhi(w.z) * s); o.w = cvt_pk_bf16(bflo(w.w) * s, bfhi(w.w) * s);
    return __builtin_bit_cast(bf16x8, o);
}

namespace pg8 {
constexpr int BM = 256, BK = 64, HALF = 128, HTB = HALF * BK * 2, STAGE_BYTES = 8 * HTB;
constexpr int GK = 1024;
__host__ __device__ __forceinline__ int lds_byte(int r, int c) { const int st = (r >> 4) * 2 + (c >> 5), rr = r & 15, cc = c & 31, ob = rr * 64 + cc * 2; return st * 1024 + (ob ^ (((ob >> 9) & 1) << 5)); }
__host__ __device__ __forceinline__ void stage_rc(int b, int& R, int& C) { const int st = b / 1024, sb = b % 1024, swz = sb ^ (((sb >> 9) & 1) << 5); R = (st >> 1) * 16 + swz / 64; C = (st & 1) * 32 + (swz % 64) / 2; }
__host__ __device__ __forceinline__ int perm32(int rho) { const int n = rho >> 4, i = rho & 15; return 8 * (i >> 2) + 4 * n + (i & 3); }

struct Unit { int pm, pn; };

template <class Epi, class Sched>
DI void gemm_phase(LAS unsigned char* lds, const Sched& S, const Epi& E) {
    const int tid = threadIdx.x, wid = __builtin_amdgcn_readfirstlane(tid >> 6), lane = tid & 63, wr = wid >> 2, wc = wid & 3, fr = lane & 15, fq = lane >> 4;
    constexpr int K = GK, nt = K / BK;
    unsigned voffA[2], voffB[2];
#pragma unroll
    for (int i = 0; i < 2; ++i) { int R, C; stage_rc(tid * 16 + i * 8192, R, C); const int Rb = Epi::PERM ? ((R & ~31) + perm32(R & 31)) : R;
        voffA[i] = (unsigned)(R * K + C) * 2u; voffB[i] = (unsigned)(Rb * K + C) * 2u; }
    const size_t kstep = (size_t)(BK * 2);
    const size_t hstep = (size_t)HALF * K * 2;
    const unsigned ldsw = (unsigned)wid * 1024u;
    const int aoff = lds_byte(wr * 64 + fr, fq * 8), boff = lds_byte(wc * 32 + fr, fq * 8);
#define PG8_SA(b, h) (((b) * 2 + (h)) * HTB)
#define PG8_SB(b, h) ((4 + (b) * 2 + (h)) * HTB)
#define PG8_STAGE(bufoff, gbase, voff) do { _Pragma("unroll") for (int _i = 0; _i < 2; ++_i) \
        __builtin_amdgcn_global_load_lds((const unsigned*)((const char*)(gbase) + (voff)[_i]), (LAS unsigned*)(lds + (bufoff) + ldsw + _i * 8192), 16, 0, 0); } while (0)
#define PG8_LDA(dst, b, h) do { _Pragma("unroll") for (int m = 0; m < 4; ++m) _Pragma("unroll") for (int k = 0; k < 2; ++k) dst[m][k] = *(const LAS bf16x8*)(lds + PG8_SA(b, h) + aoff + m * 2048 + k * 1024); } while (0)
#define PG8_LDB(dst, b, h) do { _Pragma("unroll") for (int n = 0; n < 2; ++n) _Pragma("unroll") for (int k = 0; k < 2; ++k) dst[n][k] = *(const LAS bf16x8*)(lds + PG8_SB(b, h) + boff + n * 2048 + k * 1024); } while (0)
#define PG8_MMA(ai, bj, At, Bt) do { __builtin_amdgcn_s_setprio(1); _Pragma("unroll") for (int m = 0; m < 4; ++m) _Pragma("unroll") for (int n = 0; n < 2; ++n) _Pragma("unroll") for (int k = 0; k < 2; ++k) \
        acc[ai][bj][m][n] = __builtin_amdgcn_mfma_f32_16x16x32_bf16(Bt[n][k], At[m][k], acc[ai][bj][m][n], 0, 0, 0); __builtin_amdgcn_s_setprio(0); } while (0)
#define PG8_WAIT_V(n) asm volatile("s_waitcnt vmcnt(" #n ")" ::: "memory")
#define PG8_WAIT_L(n) asm volatile("s_waitcnt lgkmcnt(" #n ")" ::: "memory")
#define PG8_BAR __builtin_amdgcn_s_barrier()
#define PG8_SCHED __builtin_amdgcn_sched_barrier(0)
    Unit cur, nxt; int ui = 0;
    if (!S.next(0, cur)) return;
    f32x4 acc[2][2][4][2];
#pragma unroll
    for (int a = 0; a < 2; ++a)
#pragma unroll
        for (int b = 0; b < 2; ++b)
#pragma unroll
            for (int m = 0; m < 4; ++m)
#pragma unroll
                for (int n = 0; n < 2; ++n) acc[a][b][m][n] = (f32x4){0.f, 0.f, 0.f, 0.f};
    bf16x8 At[4][2], B0[2][2], B1[2][2];
    const char* cA = S.aptr(cur); const char* cB = S.bptr(cur);
    PG8_STAGE(PG8_SB(0, 0), cB, voffB); PG8_STAGE(PG8_SB(0, 1), cB + hstep, voffB); PG8_STAGE(PG8_SA(0, 0), cA, voffA); PG8_STAGE(PG8_SA(0, 1), cA + hstep, voffA);
    if (wr == 1) PG8_BAR;
    PG8_WAIT_V(2); PG8_BAR;
    PG8_STAGE(PG8_SB(1, 0), cB + kstep, voffB); PG8_STAGE(PG8_SA(1, 0), cA + kstep, voffA); PG8_STAGE(PG8_SB(1, 1), cB + hstep + kstep, voffB);
    PG8_WAIT_V(6); PG8_BAR;
    for (;;) {
        const bool has_next = S.next(ui + 1, nxt);
        const char* nA = has_next ? S.aptr(nxt) : cA; const char* nB = has_next ? S.bptr(nxt) : cB;
        for (int t = 0; t < nt; t += 2) {
            const bool last = (t == nt - 2);
            const char* a1 = cA + (size_t)(t + 1) * kstep;
            const char* a2 = last ? nA : cA + (size_t)(t + 2) * kstep; const char* b2 = last ? nB : cB + (size_t)(t + 2) * kstep;
            const char* a3 = a2 + kstep; const char* b3 = b2 + kstep;
            PG8_LDB(B0, 0, 0); PG8_LDB(B1, 0, 1); PG8_SCHED; PG8_LDA(At, 0, 0); PG8_STAGE(PG8_SA(1, 1), a1 + hstep, voffA);
            PG8_WAIT_V(8); PG8_WAIT_L(0); PG8_BAR; PG8_MMA(0, 0, At, B0); PG8_MMA(0, 1, At, B1); PG8_BAR; PG8_SCHED;
            PG8_LDA(At, 0, 1); PG8_STAGE(PG8_SB(0, 0), b2, voffB); PG8_STAGE(PG8_SB(0, 1), b2 + hstep, voffB); PG8_STAGE(PG8_SA(0, 0), a2, voffA);
            PG8_WAIT_V(8); PG8_WAIT_L(0); PG8_BAR; PG8_MMA(1, 0, At, B0); PG8_MMA(1, 1, At, B1); PG8_BAR; PG8_SCHED;
            PG8_LDB(B0, 1, 0); PG8_LDB(B1, 1, 1); PG8_SCHED; PG8_LDA(At, 1, 0); PG8_STAGE(PG8_SA(0, 1), a2 + hstep, voffA);
            PG8_WAIT_V(8); PG8_WAIT_L(0); PG8_BAR; PG8_MMA(0, 0, At, B0); PG8_MMA(0, 1, At, B1); PG8_BAR; PG8_SCHED;
            PG8_LDA(At, 1, 1); PG8_STAGE(PG8_SB(1, 0), b3, voffB); PG8_STAGE(PG8_SB(1, 1), b3 + hstep, voffB); PG8_STAGE(PG8_SA(1, 0), a3, voffA);
            PG8_WAIT_V(8); PG8_WAIT_L(0); PG8_BAR; PG8_MMA(1, 0, At, B0); PG8_MMA(1, 1, At, B1); PG8_BAR; PG8_SCHED;
        }
        if (wr == 0) PG8_BAR;
        E(acc, cur, wr, wc, fr, fq);
        if (!has_next) break;
#pragma unroll
        for (int a = 0; a < 2; ++a)
#pragma unroll
            for (int b = 0; b < 2; ++b)
#pragma unroll
                for (int m = 0; m < 4; ++m)
#pragma unroll
                    for (int n = 0; n < 2; ++n) acc[a][b][m][n] = (f32x4){0.f, 0.f, 0.f, 0.f};
        cur = nxt; cA = nA; cB = nB; ++ui;
        if (wr == 1) PG8_BAR;
    }
    PG8_WAIT_V(0);
    PG8_BAR;
#undef PG8_SA
#undef PG8_SB
#undef PG8_STAGE
#undef PG8_LDA
#undef PG8_LDB
#undef PG8_MMA
#undef PG8_WAIT_V
#undef PG8_WAIT_L
#undef PG8_BAR
#undef PG8_SCHED
}
}

struct InSched {
    const char* XN; const char* WT; int c, G;
    DI bool next(int i, pg8::Unit& u) const {
        const long L = (long)i * G + c;
        if (L < 2048) {
            int wgid = (int)L; wgid = (wgid & 7) * 256 + (wgid >> 3);
            const int gid = wgid >> 7, rem = wgid & 127, vs = rem >> 3;
            u.pm = gid * 8 + (rem & 7); u.pn = vs < 14 ? vs : vs + 2; return true;
        }
        if (L < 2176) { const int l2 = (int)L - 2048; u.pm = 128 + (l2 & 15); const int j = l2 >> 4; u.pn = j < 2 ? 2 + j : 10 + j; return true; }
        return false;
    }
    DI const char* aptr(const pg8::Unit& u) const { return u.pn < 12 ? XN + (size_t)u.pm * (256 * 1024 * 2) : WT + (size_t)u.pn * (256 * 1024 * 2); }
    DI const char* bptr(const pg8::Unit& u) const { return u.pn < 12 ? WT + (size_t)u.pn * (256 * 1024 * 2) : XN + (size_t)u.pm * (256 * 1024 * 2); }
};
struct EpiIn {
    static constexpr bool PERM = true;
    bf16_t *P, *KT, *PT; const float *COS, *SIN, *COST, *SINT; LAS unsigned char* scr;
    DI void operator()(const f32x4 (&acc)[2][2][4][2], const pg8::Unit& u, int wr, int wc, int fr_, int fq_) const {
        int fr = fr_, fq = fq_; asm volatile("" : "+v"(fr), "+v"(fq));
        const int vn = u.pn, pm = u.pm;
        if (vn < 12) {
            const int rowb = pm * 256 + wr * 64 + fr;
            if (vn == 2 || vn == 3) {
                const int colk = (vn - 2) * 256 + wc * 32 + 8 * fq;
#pragma unroll
                for (int ai = 0; ai < 2; ++ai)
#pragma unroll
                    for (int m = 0; m < 4; ++m) {
                        const int tok = rowb + ai * 128 + m * 16;
#pragma unroll
                        for (int bj = 0; bj < 2; ++bj) {
                            const int col = colk + bj * 128, hh = col >> 6, ks = (col >> 5) & 1, gg = (col >> 3) & 3;
                            const f32x4 v0 = acc[ai][bj][m][0], v1 = acc[ai][bj][m][1];
                            u32x4 w; w.x = cvt_pk_bf16(v0[0], v0[1]); w.y = cvt_pk_bf16(v0[2], v0[3]); w.z = cvt_pk_bf16(v1[0], v1[1]); w.w = cvt_pk_bf16(v1[2], v1[3]);
                            *(u32x4*)((char*)KT + (size_t)((tok >> 3) * 8 + hh) * 1024 + ks * 512 + (gg * 8 + (tok & 7)) * 16) = w;
                        }
                    }
                return;
            }
            bf16_t* base = P; const int ldc = LDP;
            const int col0 = (vn < 2 ? vn : vn - 2) * 256 + wc * 32 + 8 * fq;
            const bool rot = (vn >= 6 && vn < 10);
            const int i0 = 16 * wc + 4 * fq;
#pragma unroll
            for (int ai = 0; ai < 2; ++ai)
#pragma unroll
                for (int m = 0; m < 4; ++m) {
                    const int row = rowb + ai * 128 + m * 16;
                    f32x4 c4 = {1.f, 1.f, 1.f, 1.f}, s4 = {0.f, 0.f, 0.f, 0.f};
                    if (rot) { const int t = row & 2047; c4 = *(const f32x4*)(COS + t * 64 + i0); s4 = *(const f32x4*)(SIN + t * 64 + i0); }
                    bf16_t* rowp = base + (size_t)row * ldc + col0;
#pragma unroll
                    for (int bj = 0; bj < 2; ++bj) {
                        const f32x4 v0 = acc[ai][bj][m][0], v1 = acc[ai][bj][m][1];
                        const f32x4 o0 = v0 * c4 - v1 * s4, o1 = v0 * s4 + v1 * c4;
                        u32x4 w; w.x = cvt_pk_bf16(o0[0], o0[1]); w.y = cvt_pk_bf16(o0[2], o0[3]); w.z = cvt_pk_bf16(o1[0], o1[1]); w.w = cvt_pk_bf16(o1[2], o1[3]);
                        {
                            LAS unsigned char* tbw = scr + 5120 + (wr * 4 + wc) * 2304;
                            const int ln = fr + 16 * fq;
                            *(LAS u32x4*)(tbw + fr * 80 + fq * 16) = w;
                            const u32x4 wt = *(const LAS u32x4*)(tbw + (ln >> 2) * 80 + (ln & 3) * 16);
                            *(u32x4*)(base + (size_t)(row - fr + (ln >> 2)) * ldc + (col0 - 8 * fq) + bj * 128 + (ln & 3) * 8) = wt;
                        }
                        if (vn == 8 || vn == 9) {
                            unsigned short* r0 = (unsigned short*)((char*)PT + (size_t)512 * LDT * 2 + ((size_t)(row >> 3) * 1024 + ((vn - 8) * 2 + bj) * 128 + 32 * wc + 4 * fq) * 16 + (row & 7) * 2);
                            r0[0] = (unsigned short)(w.x & 0xffffu); r0[8] = (unsigned short)(w.x >> 16); r0[16] = (unsigned short)(w.y & 0xffffu); r0[24] = (unsigned short)(w.y >> 16);
                            r0[128] = (unsigned short)(w.z & 0xffffu); r0[136] = (unsigned short)(w.z >> 16); r0[144] = (unsigned short)(w.w & 0xffffu); r0[152] = (unsigned short)(w.w >> 16);
                        }
                    }
                }
        } else {
            const int frow0 = (vn - 12) * 256 + wr * 64 + fr;
            const int tok0 = pm * 256 + wc * 32 + 8 * fq;
            const bool rot = (vn == 14 || vn == 15) && pm < 128;
            if (vn < 14) {
#pragma unroll
                for (int ai = 0; ai < 2; ++ai)
#pragma unroll
                    for (int bj = 0; bj < 2; ++bj)
#pragma unroll
                        for (int m = 0; m < 4; ++m) {
                            const int f = frow0 + ai * 128 + m * 16, tok = tok0 + bj * 128;
                            const f32x4 v0 = acc[ai][bj][m][0], v1 = acc[ai][bj][m][1];
                            u32x4 w; w.x = cvt_pk_bf16(v0[0], v0[1]); w.y = cvt_pk_bf16(v0[2], v0[3]); w.z = cvt_pk_bf16(v1[0], v1[1]); w.w = cvt_pk_bf16(v1[2], v1[3]);
                            *(u32x4*)((char*)PT + (size_t)((tok >> 3) * 8 + (f >> 6)) * 1024 + (f & 63) * 16) = w;
                        }
                return;
            }
#pragma unroll
            for (int ai = 0; ai < 2; ++ai)
#pragma unroll
                for (int bj = 0; bj < 2; ++bj)
#pragma unroll
                    for (int mp = 0; mp < 2; ++mp) {
                        const int tok = tok0 + bj * 128;
                        f32x4 ca = {1.f, 1.f, 1.f, 1.f}, cb = ca, sa = {0.f, 0.f, 0.f, 0.f}, sb = sa;
                        if (rot) { const int i = 32 * wr + 16 * mp + fr, t = tok & 2047;
                            ca = *(const f32x4*)(COST + i * 2048 + t); cb = *(const f32x4*)(COST + i * 2048 + t + 4);
                            sa = *(const f32x4*)(SINT + i * 2048 + t); sb = *(const f32x4*)(SINT + i * 2048 + t + 4); }
                        const f32x4 x1a = acc[ai][bj][2 * mp][0], x1b = acc[ai][bj][2 * mp][1], x2a = acc[ai][bj][2 * mp + 1][0], x2b = acc[ai][bj][2 * mp + 1][1];
                        const f32x4 o1a = x1a * ca - x2a * sa, o1b = x1b * cb - x2b * sb, o2a = x1a * sa + x2a * ca, o2b = x1b * sb + x2b * cb;
                        char* r1 = (char*)PT + (size_t)512 * LDT * 2 + ((size_t)(tok >> 3) * 1024 + (frow0 - 512 + ai * 128 + (2 * mp) * 16)) * 16;
                        char* r2 = r1 + 16 * 16;
                        u32x4 w; w.x = cvt_pk_bf16(o1a[0], o1a[1]); w.y = cvt_pk_bf16(o1a[2], o1a[3]); w.z = cvt_pk_bf16(o1b[0], o1b[1]); w.w = cvt_pk_bf16(o1b[2], o1b[3]);
                        *(u32x4*)r1 = w;
                        w.x = cvt_pk_bf16(o2a[0], o2a[1]); w.y = cvt_pk_bf16(o2a[2], o2a[3]); w.z = cvt_pk_bf16(o2b[0], o2b[1]); w.w = cvt_pk_bf16(o2b[2], o2b[3]);
                        *(u32x4*)r2 = w;
                    }
        }
    }
};
struct OutSched {
    const char* Y; const char* WOT; int c, G;
    DI bool next(int i, pg8::Unit& u) const {
        const long L = (long)i * G + c; if (L >= 512) return false;
        u.pm = (int)(L >> 2); u.pn = (int)(L & 3); return true;
    }
    DI const char* aptr(const pg8::Unit& u) const { return Y + (size_t)u.pm * (256 * 1024 * 2); }
    DI const char* bptr(const pg8::Unit& u) const { return WOT + (size_t)u.pn * (256 * 1024 * 2); }
};
struct EpiOutF {
    static constexpr bool PERM = false;
    const float* x; const float* MOD; const float* gfin; float* out; float* xbuf; unsigned* cnt; LAS unsigned char* scr;
    DI void operator()(f32x4 (&acc)[2][2][4][2], const pg8::Unit& u, int wr, int wc, int fr_, int fq_) const {
        int fr = fr_, fq = fq_, tid = threadIdx.x;
        asm volatile("" : "+v"(fr), "+v"(fq), "+v"(tid));
        const int b = u.pm >> 3;
        const int col0 = u.pn * 256 + wc * 32 + 4 * fq;
        LAS float* P4s = (LAS float*)scr;
        LAS float* S = (LAS float*)(scr + 4096);
        f32x4 gt[2][2];
#pragma unroll
        for (int bj = 0; bj < 2; ++bj)
#pragma unroll
            for (int n = 0; n < 2; ++n) gt[bj][n] = *(const f32x4*)(MOD + b * 3072 + 2048 + col0 + bj * 128 + n * 16);
        int lane = fr + 16 * fq; const int rr = lane >> 3, pz = lane & 7;
        LAS unsigned char* tb = scr + 5120 + (wr * 4 + wc) * 2304;
        f32x4 xv[3][2][2];
        const float* xg = x + (size_t)(u.pm * 256 + wr * 64 + rr) * DM + u.pn * 256 + wc * 32 + pz * 4;
#define EPF_LOADX(B, ai_, m_) do { _Pragma("unroll") for (int bj = 0; bj < 2; ++bj) _Pragma("unroll") for (int k = 0; k < 2; ++k) \
            xv[B][bj][k] = *(const f32x4*)(xg + (size_t)((ai_) * 128 + (m_) * 16 + 8 * k) * DM + bj * 128); } while (0)
        EPF_LOADX(0, 0, 0); EPF_LOADX(1, 0, 1);
#pragma unroll
        for (int im = 0; im < 8; ++im) {
            const int ai = im >> 2, m = im & 3;
            if (im + 2 < 8) EPF_LOADX((im + 2) % 3, (im + 2) >> 2, (im + 2) & 3);
            __builtin_amdgcn_sched_barrier(0);
            float q0 = 0.f, q1 = 0.f; f32x4 uu[2];
#pragma unroll
            for (int bj = 0; bj < 2; ++bj) {
#pragma unroll
                for (int n = 0; n < 2; ++n) *(LAS f32x4*)(tb + fr * 144 + (16 * n + 4 * fq) * 4) = gt[bj][n] * acc[ai][bj][m][n];
#pragma unroll
                for (int k = 0; k < 2; ++k) {
                    const f32x4 t = *(const LAS f32x4*)(tb + (rr + 8 * k) * 144 + pz * 16);
                    const f32x4 v = xv[im % 3][bj][k] + t;
                    const float d = (v[0] * v[0] + v[1] * v[1]) + (v[2] * v[2] + v[3] * v[3]);
                    if (k == 0) q0 += d; else q1 += d;
                    uu[k] = v;
                }
                acc[ai][bj][m][0] = uu[0]; acc[ai][bj][m][1] = uu[1];
            }
            q0 += __shfl_xor(q0, 1); q1 += __shfl_xor(q1, 1); q0 += __shfl_xor(q0, 2); q1 += __shfl_xor(q1, 2); q0 += __shfl_xor(q0, 4); q1 += __shfl_xor(q1, 4);
            if (pz == 0) { P4s[(ai * 128 + wr * 64 + m * 16 + rr) * 4 + wc] = q0; P4s[(ai * 128 + wr * 64 + m * 16 + rr + 8) * 4 + wc] = q1; }
            __builtin_amdgcn_sched_barrier(0);
        }
#undef EPF_LOADX
        asm volatile("s_waitcnt lgkmcnt(0)" ::: "memory"); __builtin_amdgcn_s_barrier(); asm volatile("" ::: "memory");
        float* slot = xbuf + ((size_t)u.pm * 256) * 4;
        unsigned* pc = cnt + 64 * u.pm;
        if (tid < 256) {
            const float t = (P4s[tid * 4 + 0] + P4s[tid * 4 + 1]) + (P4s[tid * 4 + 2] + P4s[tid * 4 + 3]);
            __hip_atomic_store(slot + tid * 4 + u.pn, t, __ATOMIC_RELAXED, __HIP_MEMORY_SCOPE_AGENT);
            asm volatile("s_waitcnt vmcnt(0)" ::: "memory");
            if ((tid & 63) == 0) __hip_atomic_fetch_add(pc, 1u, __ATOMIC_RELAXED, __HIP_MEMORY_SCOPE_AGENT);
        }
        if (tid < 64) {
            unsigned sp = 0;
            while ((unsigned)__builtin_amdgcn_readfirstlane(__hip_atomic_load(pc, __ATOMIC_RELAXED, __HIP_MEMORY_SCOPE_AGENT)) < 16u) {
                __builtin_amdgcn_s_sleep(2); if (++sp > (1u << 20)) break; }
            __builtin_amdgcn_fence(__ATOMIC_ACQUIRE, "agent");
        }
        asm volatile("s_waitcnt vmcnt(0) lgkmcnt(0)" ::: "memory"); __builtin_amdgcn_s_barrier(); asm volatile("" ::: "memory");
        if (tid < 256) {
            float tot = 0.f;
#pragma unroll
            for (int t = 0; t < 4; ++t) tot += __hip_atomic_load(slot + tid * 4 + t, __ATOMIC_RELAXED, __HIP_MEMORY_SCOPE_AGENT);
            S[tid] = rsqrtf(tot * (1.f / DM) + EPSN);
        }
        asm volatile("s_waitcnt lgkmcnt(0)" ::: "memory"); __builtin_amdgcn_s_barrier(); asm volatile("" ::: "memory");
        f32x4 gf[2];
#pragma unroll
        for (int bj = 0; bj < 2; ++bj) gf[bj] = *(const f32x4*)(gfin + u.pn * 256 + bj * 128 + wc * 32 + pz * 4);
#pragma unroll
        for (int ai = 0; ai < 2; ++ai)
#pragma unroll
            for (int m = 0; m < 4; ++m)
#pragma unroll
                for (int k = 0; k < 2; ++k) {
                    const int r = ai * 128 + wr * 64 + m * 16 + rr + 8 * k; const float rs = S[r];
                    float* orow = out + (size_t)(u.pm * 256 + r) * DM + u.pn * 256 + wc * 32 + pz * 4;
#pragma unroll
                    for (int bj = 0; bj < 2; ++bj) *(f32x4*)(orow + bj * 128) = acc[ai][bj][m][k] * rs * gf[bj];
                }
        asm volatile("s_waitcnt lgkmcnt(0)" ::: "memory"); __builtin_amdgcn_s_barrier(); asm volatile("" ::: "memory");
    }
};

DI void wt_src(int np, int& src, float& sc) {
    const int vn = np >> 8; sc = 1.f;
    if (vn < 2) { src = np; sc = 0.125f * LOG2E; }
    else if (vn < 4) { src = np; }
    else if (vn < 6) { src = 1536 + (np - 1024); }
    else if (vn < 10) { const int hl = (np - 1536) & 511, head = hl >> 7, p = hl & 127, half = (p >> 2) & 1, i = 4 * (p >> 3) + (p & 3);
        src = (vn < 8 ? 2048 : 2560) + head * 128 + 64 * half + i; if (vn >= 8) sc = KSCALE; }
    else if (vn < 12) { src = 3584 + (np - 2560); }
    else if (vn < 14) { src = 1024 + (np - 3072); }
    else if (vn < 16) { const int hl = np - 3584, head = hl >> 7, p = hl & 127, half = (p >> 4) & 1, i = 16 * (p >> 5) + (p & 15);
        src = 2560 + head * 128 + 64 * half + i; sc = KSCALE; }
    else { src = 3072 + (np - 4096); }
}
DI void p0_transpose_item(const float* W, int N, bool is_in, bf16_t* WT, LAS float* scr, int item, int lane) {
    const int nblk = is_in ? (NWT / 32) : 32, kb = item / nblk, nb = item % nblk, k0 = 64 * kb, n0 = 32 * nb;
    int src; float sc;
    if (is_in) wt_src(n0 + (lane & 31), src, sc); else { src = n0 + (lane & 31); sc = 1.f; }
#pragma unroll 8
    for (int i = 0; i < 32; ++i) { const int kk = 2 * i + (lane >> 5); scr[kk * 33 + (lane & 31)] = W[(size_t)(k0 + kk) * N + src] * sc; }
    asm volatile("s_waitcnt lgkmcnt(0)" ::: "memory");
    const int c = lane & 7;
#pragma unroll
    for (int j = 0; j < 4; ++j) { const int n = (lane >> 3) + 8 * j; const LAS float* s = scr + (8 * c) * 33 + n;
        u32x4 o; o.x = cvt_pk_bf16(s[0 * 33], s[1 * 33]); o.y = cvt_pk_bf16(s[2 * 33], s[3 * 33]); o.z = cvt_pk_bf16(s[4 * 33], s[5 * 33]); o.w = cvt_pk_bf16(s[6 * 33], s[7 * 33]);
        *(u32x4*)(WT + (size_t)(n0 + n) * 1024 + k0 + 8 * c) = o; }
    asm volatile("s_waitcnt lgkmcnt(0)" ::: "memory");
}
DI void p0_gemv_item(const Params& p, float* MODP, LAS float* scr, int item, int lane) {
    const int q = item / 48, cgp = item % 48, col = cgp * 64 + lane;
    float acc[17];
#pragma unroll
    for (int bb = 0; bb < 17; ++bb) acc[bb] = 0.f;
    for (int kc = 0; kc < 4; ++kc) {
        const int kbase = q * 64 + kc * 16;
#pragma unroll
        for (int u = 0; u < 5; ++u) { const int idx = lane + 64 * u;
            if (idx < 272) { const int kk = idx / 17, bb = idx - kk * 17; const float v = bb < 16 ? p.c[bb * 1024 + kbase + kk] : p.c_ctx[kbase + kk]; scr[idx] = silu_f(v); } }
        asm volatile("s_waitcnt lgkmcnt(0)" ::: "memory");
        float wv[16];
#pragma unroll
        for (int kk = 0; kk < 16; ++kk) wv[kk] = p.w_ada[(size_t)(kbase + kk) * 3072 + col];
#pragma unroll
        for (int kk = 0; kk < 16; ++kk) {
#pragma unroll
            for (int bb = 0; bb < 17; ++bb) acc[bb] += scr[kk * 17 + bb] * wv[kk]; }
        asm volatile("s_waitcnt lgkmcnt(0)" ::: "memory");
    }
#pragma unroll
    for (int bb = 0; bb < 17; ++bb) MODP[(q * 17 + bb) * 3072 + col] = acc[bb];
}
DI void phase_p0(const Params& p, LAS unsigned char* lds, int vb, int G) {
    const int tid = threadIdx.x, lane = tid & 63, wave = tid >> 6;
    LAS float* scr = (LAS float*)(lds + wave * 16384);
    const int gw = vb * 8 + wave, NGW = G * 8;
    bf16_t* WT = (bf16_t*)(p.ws + WS_WT); bf16_t* WOT = (bf16_t*)(p.ws + WS_WOT); float* MODP = (float*)(p.ws + WS_MODP);
    constexpr int I_GEMV = 768, I_IN = 16 * (NWT / 32), I_OUT = 16 * 32;
    for (int it = gw; it < I_GEMV + I_IN + I_OUT; it += NGW) {
        if (it < I_GEMV) p0_gemv_item(p, MODP, scr, it, lane);
        else if (it < I_GEMV + I_IN) p0_transpose_item(p.w_in, 4096, true, WT, scr, it - I_GEMV, lane);
        else p0_transpose_item(p.w_out, 1024, false, WOT, scr, it - I_GEMV - I_IN, lane);
    }
    float* COS = (float*)(p.ws + WS_COS); float* SIN = (float*)(p.ws + WS_SIN); float* COST = (float*)(p.ws + WS_COST); float* SINT = (float*)(p.ws + WS_SINT);
    for (int idx = vb * 512 + tid; idx < 2048 * 64; idx += G * 512) {
        const int t = idx >> 6, i = idx & 63, f = i & 31; const float pos = (float)((i < 32) ? (t >> 6) : (t & 63));
        const float inv = exp2f(-(float)f * (13.287712379549449f / 32.f));
        const float ang = pos * inv; const float cs = __cosf(ang), sn = __sinf(ang);
        COS[idx] = cs; SIN[idx] = sn; COST[i * 2048 + t] = cs; SINT[i * 2048 + t] = sn;
    }
}
DI void norm_rows(const Params& p, const float* src, bf16_t* dst, int nrows, int bmod, int lane) {
    const float* MODP = (const float*)(p.ws + WS_MODP);
    f32x4 mul[4], sh[4];
#pragma unroll
    for (int j = 0; j < 4; ++j) { const int col = 4 * lane + 256 * j;
        f32x4 s = *(const f32x4*)(p.b_ada + col), sc = *(const f32x4*)(p.b_ada + 1024 + col);
#pragma unroll 2
        for (int q = 0; q < 16; ++q) { s += *(const f32x4*)(MODP + (q * 17 + bmod) * 3072 + col); sc += *(const f32x4*)(MODP + (q * 17 + bmod) * 3072 + 1024 + col); }
        sh[j] = s; mul[j] = *(const f32x4*)(p.norm_g + col) * (sc + 1.0f); }
    for (int r = 0; r < nrows; r += 2) {
        const f32x4* xr = (const f32x4*)(src + (size_t)r * DM) + lane;
        f32x4 v[2][4]; float sq[2];
#pragma unroll
        for (int q = 0; q < 2; ++q)
#pragma unroll
            for (int j = 0; j < 4; ++j) v[q][j] = xr[q * 256 + 64 * j];
#pragma unroll
        for (int q = 0; q < 2; ++q) { float s = 0.f;
#pragma unroll
            for (int j = 0; j < 4; ++j) s += (v[q][j].x * v[q][j].x + v[q][j].y * v[q][j].y) + (v[q][j].z * v[q][j].z + v[q][j].w * v[q][j].w);
            sq[q] = s; }
#pragma unroll
        for (int o = 1; o < 64; o <<= 1) { sq[0] += __shfl_xor(sq[0], o); sq[1] += __shfl_xor(sq[1], o); }
#pragma unroll
        for (int q = 0; q < 2; ++q) { const float rstd = rsqrtf(sq[q] * (1.f / DM) + EPSN);
            u32x2* o8 = (u32x2*)(dst + (size_t)(r + q) * DM) + lane;
#pragma unroll
            for (int j = 0; j < 4; ++j) { const f32x4 h = v[q][j] * rstd * mul[j] + sh[j]; u32x2 w; w.x = cvt_pk_bf16(h.x, h.y); w.y = cvt_pk_bf16(h.z, h.w); o8[64 * j] = w; } }
    }
}
DI void phase_p0b(const Params& p, int vb, int G) {
    const int tid = threadIdx.x, lane = tid & 63, wave = tid >> 6;
    const int gw = vb * 8 + wave, NGW = G * 8;
    bf16_t* XN = (bf16_t*)(p.ws + WS_XN);
    for (int wv = gw; wv < 2048; wv += NGW) {
        const int b = wv >> 7, r0 = b * 2048 + (wv & 127) * 16;
        norm_rows(p, p.x + (size_t)r0 * DM, XN + (size_t)r0 * DM, 16, b, lane);
    }
    for (int wv = gw; wv < 2048; wv += NGW)
        norm_rows(p, p.ctx + (size_t)(wv * 2) * DM, XN + (size_t)(MLAT + wv * 2) * DM, 2, 16, lane);
    const float* MODP = (const float*)(p.ws + WS_MODP); float* MOD = (float*)(p.ws + WS_MOD);
    for (int idx = vb * 512 + tid; idx < 17 * 3072; idx += G * 512) {
        const int col = idx % 3072;
        float a = p.b_ada[col];
#pragma unroll
        for (int q = 0; q < 16; ++q) a += MODP[q * 17 * 3072 + idx];
        MOD[idx] = a;
    }
}

DI void ret_state_item(const Params& p, int item) {
    const int lane = threadIdx.x & 63, wave = __builtin_amdgcn_readfirstlane(threadIdx.x >> 6);
    const int dvq = item & 3, h = (item >> 2) & 3, b = item >> 4;
    const int dir = wave & 1, mt = wave >> 1, c = lane & 15, g = lane >> 4;
    const bf16_t* PT = (const bf16_t*)(p.ws + WS_PT);
    bf16_t* SO = (bf16_t*)(p.ws + (dir ? WS_SB : WS_SF)) + (size_t)((b * 4 + h) * 16) * 16384;
    const float lg2 = -__expf(dir ? p.dec_b[h] : p.dec_f[h]) * LOG2E;
    float w8[8];
#pragma unroll
    for (int j = 0; j < 8; ++j) w8[j] = ex2(lg2 * (float)(dir ? (8 * g + j) : (31 - 8 * g - j)));
    const float g32 = ex2(lg2 * 32.f);
    const unsigned loff = (unsigned)((g * 1024 + c) * 16);
    const char* RT = (const char*)(p.ws + WS_RT);
    const char* abase = RT + (size_t)(h * 128 + 32 * mt) * 16;
    const char* bbase = RT + (size_t)(512 + h * 128 + 32 * dvq) * 16;
    const int ctxb = MLAT + b * CTXL, latb = b * SEQ;
    f32x4 acc[2][2];
#pragma unroll
    for (int at = 0; at < 2; ++at)
#pragma unroll
        for (int nt = 0; nt < 2; ++nt) acc[at][nt] = (f32x4){0.f, 0.f, 0.f, 0.f};
    bf16x8 fa[2][2][4], fb[2][2][4];
#define RS_TOK(i) (dir ? ((i) < 2 ? ctxb + 128 * (1 - (i)) : latb + 128 * (17 - (i))) : ((i) < 2 ? ctxb + 128 * (i) : latb + 128 * ((i) - 2)))
#define RS_LOAD(B, i) do { const int tb_ = RS_TOK(i); _Pragma("unroll") for (int ks = 0; ks < 4; ++ks) { \
        const size_t to_ = (size_t)((tb_ >> 3) + 4 * ks) * 16384; \
        fa[B][0][ks] = ldg8u((const bf16_t*)(abase + to_), loff); fa[B][1][ks] = ldg8u((const bf16_t*)(abase + to_ + 256), loff); \
        fb[B][0][ks] = ldg8u((const bf16_t*)(bbase + to_), loff); fb[B][1][ks] = ldg8u((const bf16_t*)(bbase + to_ + 256), loff); } } while (0)
#define RS_STORE(i) do { const int n_ = dir ? 17 - (i) : (i) - 2; bf16_t* so_ = SO + (size_t)n_ * 16384; \
        _Pragma("unroll") for (int at = 0; at < 2; ++at) _Pragma("unroll") for (int nt = 0; nt < 2; ++nt) { \
            u32x2 w_; w_.x = cvt_pk_bf16(acc[at][nt][0], acc[at][nt][1]); w_.y = cvt_pk_bf16(acc[at][nt][2], acc[at][nt][3]); \
            *(u32x2*)(so_ + (32 * dvq + 16 * nt + c) * 128 + 32 * mt + 8 * g + 4 * at) = w_; } } while (0)
#define RS_COMPUTE(B) do { _Pragma("unroll") for (int kk = 0; kk < 4; ++kk) { const int ks = dir ? 3 - kk : kk; \
        _Pragma("unroll") for (int at = 0; at < 2; ++at) _Pragma("unroll") for (int nt = 0; nt < 2; ++nt) acc[at][nt] *= g32; \
        _Pragma("unroll") for (int at = 0; at < 2; ++at) { \
            const u32x4 w_ = __builtin_bit_cast(u32x4, fa[B][at][ks]); u32x4 o_; \
            o_.x = cvt_pk_bf16(bflo(w_.x) * w8[0], bfhi(w_.x) * w8[1]); o_.y = cvt_pk_bf16(bflo(w_.y) * w8[2], bfhi(w_.y) * w8[3]); \
            o_.z = cvt_pk_bf16(bflo(w_.z) * w8[4], bfhi(w_.z) * w8[5]); o_.w = cvt_pk_bf16(bflo(w_.w) * w8[6], bfhi(w_.w) * w8[7]); \
            const bf16x8 aw_ = __builtin_bit_cast(bf16x8, o_); \
            acc[at][0] = mfma16(aw_, fb[B][0][ks], acc[at][0]); acc[at][1] = mfma16(aw_, fb[B][1][ks], acc[at][1]); } } } while (0)
    RS_LOAD(0, 0); __builtin_amdgcn_sched_barrier(0);
    for (int i = 0; i < 18; i += 2) {
        if (i + 1 < 17) RS_LOAD(1, i + 1);
        __builtin_amdgcn_sched_barrier(0);
        if (i >= 2) RS_STORE(i);
        if (i < 17) RS_COMPUTE(0);
        if (i + 2 < 17) RS_LOAD(0, i + 2);
        __builtin_amdgcn_sched_barrier(0);
        if (i + 1 >= 2) RS_STORE(i + 1);
        if (i + 1 < 17) RS_COMPUTE(1);
    }
#undef RS_TOK
#undef RS_LOAD
#undef RS_STORE
#undef RS_COMPUTE
}

template <bool LOCAL>
DI void na_step1(const bf16x8 (&kf)[2][2], const bf16x8 (&vf)[4], const bf16x8 (&qf)[2], f32x4 (&O)[4], float& mrun, float& lrun,
                 const LAS float* bp, const f32x4 (&madd)[2]) {
    f32x4 s[2];
    if (LOCAL) {
#pragma unroll
        for (int tau = 0; tau < 2; ++tau) {
            float b0 = bp[4 * tau], b1 = bp[4 * tau + 1], b2 = bp[4 * tau + 2], b3 = bp[4 * tau + 3];
            asm volatile("" : "+v"(b0), "+v"(b1), "+v"(b2), "+v"(b3));
            s[tau] = (f32x4){b0, b1, b2, b3} + madd[tau];
        }
    } else { s[0] = (f32x4){0.f, 0.f, 0.f, 0.f}; s[1] = s[0]; }
#pragma unroll
    for (int tau = 0; tau < 2; ++tau) { s[tau] = mfma16(kf[tau][0], qf[0], s[tau]); s[tau] = mfma16(kf[tau][1], qf[1], s[tau]); }
    float mx = fmaxf(fmaxf(fmaxf(s[0][0], s[0][1]), fmaxf(s[0][2], s[0][3])), fmaxf(fmaxf(s[1][0], s[1][1]), fmaxf(s[1][2], s[1][3])));
    mx = fmaxf(mx, __shfl_xor(mx, 16)); mx = fmaxf(mx, __shfl_xor(mx, 32));
    const float mnew = fmaxf(mrun, mx), alpha = ex2(mrun - mnew);
    mrun = mnew;
    float ps = 0.f;
#pragma unroll
    for (int tau = 0; tau < 2; ++tau)
#pragma unroll
        for (int e = 0; e < 4; ++e) { s[tau][e] = ex2(s[tau][e] - mnew); ps += s[tau][e]; }
    lrun = lrun * alpha + ps;
    u32x4 pw; pw.x = cvt_pk_bf16(s[0][0], s[0][1]); pw.y = cvt_pk_bf16(s[0][2], s[0][3]); pw.z = cvt_pk_bf16(s[1][0], s[1][1]); pw.w = cvt_pk_bf16(s[1][2], s[1][3]);
    const bf16x8 pf = __builtin_bit_cast(bf16x8, pw);
#pragma unroll
    for (int dt = 0; dt < 4; ++dt) { O[dt] *= alpha; O[dt] = mfma16(vf[dt], pf, O[dt]); }
}
DI void na_step2(const bf16x8 (&kf)[2][2], const bf16x8 (&vf)[4], const bf16x8 (&kc)[2][2], const bf16x8 (&vc)[4], const bf16x8 (&qf)[2], f32x4 (&O)[4], float& mrun, float& lrun,
                 const LAS float* bp, const f32x4 (&madd)[2]) {
    f32x4 s[4];
#pragma unroll
    for (int tau = 0; tau < 2; ++tau) {
        float b0 = bp[4 * tau], b1 = bp[4 * tau + 1], b2 = bp[4 * tau + 2], b3 = bp[4 * tau + 3];
        asm volatile("" : "+v"(b0), "+v"(b1), "+v"(b2), "+v"(b3));
        s[tau] = (f32x4){b0, b1, b2, b3} + madd[tau];
        s[2 + tau] = (f32x4){0.f, 0.f, 0.f, 0.f};
    }
#pragma unroll
    for (int tau = 0; tau < 2; ++tau) { s[tau] = mfma16(kf[tau][0], qf[0], s[tau]); s[2 + tau] = mfma16(kc[tau][0], qf[0], s[2 + tau]); }
#pragma unroll
    for (int tau = 0; tau < 2; ++tau) { s[tau] = mfma16(kf[tau][1], qf[1], s[tau]); s[2 + tau] = mfma16(kc[tau][1], qf[1], s[2 + tau]); }
    float mx = fmaxf(fmaxf(fmaxf(s[0][0], s[0][1]), fmaxf(s[0][2], s[0][3])), fmaxf(fmaxf(s[1][0], s[1][1]), fmaxf(s[1][2], s[1][3])));
    mx = fmaxf(mx, fmaxf(fmaxf(fmaxf(s[2][0], s[2][1]), fmaxf(s[2][2], s[2][3])), fmaxf(fmaxf(s[3][0], s[3][1]), fmaxf(s[3][2], s[3][3]))));
    mx = fmaxf(mx, __shfl_xor(mx, 16)); mx = fmaxf(mx, __shfl_xor(mx, 32));
    const float mnew = fmaxf(mrun, mx), alpha = ex2(mrun - mnew);
    mrun = mnew;
#pragma unroll
    for (int t = 0; t < 4; ++t) { s[t] = s[t] - mnew;
#pragma unroll
        for (int e = 0; e < 4; ++e) s[t][e] = ex2(s[t][e]); }
    const f32x4 s4 = (s[0] + s[1]) + (s[2] + s[3]);
    const float ps = (s4[0] + s4[1]) + (s4[2] + s4[3]);
    lrun = lrun * alpha + ps;
    u32x4 pw; pw.x = cvt_pk_bf16(s[0][0], s[0][1]); pw.y = cvt_pk_bf16(s[0][2], s[0][3]); pw.z = cvt_pk_bf16(s[1][0], s[1][1]); pw.w = cvt_pk_bf16(s[1][2], s[1][3]);
    const bf16x8 pfl = __builtin_bit_cast(bf16x8, pw);
    pw.x = cvt_pk_bf16(s[2][0], s[2][1]); pw.y = cvt_pk_bf16(s[2][2], s[2][3]); pw.z = cvt_pk_bf16(s[3][0], s[3][1]); pw.w = cvt_pk_bf16(s[3][2], s[3][3]);
    const bf16x8 pfc = __builtin_bit_cast(bf16x8, pw);
#pragma unroll
    for (int dt = 0; dt < 4; ++dt) { O[dt] *= alpha; O[dt] = mfma16(vf[dt], pfl, O[dt]); O[dt] = mfma16(vc[dt], pfc, O[dt]); }
}
DI void na_item(const Params& p, LAS unsigned char* lds, int item) {
    const int tid = threadIdx.x, lane = tid & 63, wave = __builtin_amdgcn_readfirstlane(tid >> 6);
    const int half = item & 1, h = (item >> 1) & 7, b = item >> 4;
    const int j = wave & 3, rr = wave >> 2, c = lane & 15, g = lane >> 4;
    const bf16_t* P = (const bf16_t*)(p.ws + WS_P); const char* KT = (const char*)(p.ws + WS_KT); const char* VT = (const char*)(p.ws + WS_VT);
    bf16_t* Y = (bf16_t*)(p.ws + WS_Y);
    LAS float* rpb = (LAS float*)lds;
    LAS unsigned char* Kc = lds + 4096;
    LAS unsigned char* Vc = lds + 4096 + 32768;
    __syncthreads();
    for (int idx = tid; idx < 15 * 64; idx += 512) { const int dr = idx >> 6, xx = (idx & 63) - 16;
        rpb[idx] = (xx >= 0 && xx < 31) ? p.na_rpb[(h * 15 + dr) * 31 + xx] * LOG2E : 0.f; }
#pragma unroll
    for (int i = 0; i < 4; ++i) { const int idx = tid + 512 * i, blk = idx >> 6, q = idx & 63;
        const size_t tb = (size_t)(((MLAT + b * CTXL) >> 3) + blk) * 8 + h;
        { const int row = blk * 8 + (q & 7), pc = (q >> 5) * 4 + ((q >> 3) & 3);
          *(LAS bf16x8*)(Kc + row * 128 + ((pc ^ (((row >> 1) & 1) | (((row >> 3) & 3) << 1))) << 4)) = *(const bf16x8*)(KT + tb * 1024 + q * 16); }
        { const int row = q, pc = blk;
          *(LAS bf16x8*)(Vc + row * 512 + ((pc ^ (row & 15)) << 4)) = *(const bf16x8*)(VT + tb * 1024 + q * 16); } }
    __syncthreads();
    const int cw0 = (j == 0) ? 0 : (j == 1) ? 8 : (j == 2) ? 24 : 32;
    const int kap0 = 8 * (c >> 2) + (c & 3);
    const int cq = 16 * j + c; int c0 = cq - 8; c0 = c0 < 0 ? 0 : (c0 > 48 ? 48 : c0);
    const LAS float* rpbl = rpb + 16 + (cw0 + 8 * g - cq + 15);
    f32x4 madd[2];
#pragma unroll
    for (int tau = 0; tau < 2; ++tau)
#pragma unroll
        for (int e = 0; e < 4; ++e) { const int ck = cw0 + 8 * g + 4 * tau + e; madd[tau][e] = (ck >= c0 && ck < c0 + 16) ? 0.f : -INFINITY; }
    const unsigned klo = (unsigned)((c >> 2) * 8192 + (g * 8 + (c & 3)) * 16), vlo = (unsigned)(g * 8192 + c * 16);
    const unsigned kcb = (unsigned)(kap0 * 128), vcb = (unsigned)(c * 512);
    unsigned kx[2]; kx[0] = (unsigned)(((g) ^ (c >> 1)) << 4); kx[1] = (unsigned)(((4 + g) ^ (c >> 1)) << 4);
    for (int ui = 0; ui < 8; ++ui) {
        const int rp = 8 * half + ui, r = 2 * rp + rr;
        int r0 = r - 4; r0 = r0 < 0 ? 0 : (r0 > 24 ? 24 : r0);
        const size_t tok = (size_t)(b * SEQ + r * 64 + 16 * j + c);
        bf16x8 qf[2];
#pragma unroll
        for (int ks = 0; ks < 2; ++ks) qf[ks] = ldg8(P + tok * LDP + PC_NAQ + h * 64 + 32 * ks + 8 * g);
        f32x4 O[4]; float mrun = -1e30f, lrun = 0.f;
#pragma unroll
        for (int dt = 0; dt < 4; ++dt) O[dt] = (f32x4){0.f, 0.f, 0.f, 0.f};
        const size_t tb0 = (size_t)(((b * SEQ + r0 * 64 + cw0) >> 3) * 8 + h) * 1024;
        const char* kb0 = KT + tb0; const char* vb0 = VT + tb0;
        const LAS float* bp0 = rpbl + (r0 - r + 7) * 64;
        bf16x8 kf[2][2][2], vf[2][4], kc[2][2], vc[4];
#define NA_LOADL(B, st) do { _Pragma("unroll") for (int tau = 0; tau < 2; ++tau) _Pragma("unroll") for (int ks = 0; ks < 2; ++ks) \
            kf[B][tau][ks] = ldg8u((const bf16_t*)(kb0 + (size_t)(st) * 65536 + ks * 512 + tau * 64), klo); \
            _Pragma("unroll") for (int dt = 0; dt < 4; ++dt) vf[B][dt] = ldg8u((const bf16_t*)(vb0 + (size_t)(st) * 65536 + dt * 256), vlo); } while (0)
#define NA_LOADC(st) do { _Pragma("unroll") for (int tau = 0; tau < 2; ++tau) _Pragma("unroll") for (int ks = 0; ks < 2; ++ks) \
            kc[tau][ks] = *(const LAS bf16x8*)(Kc + kcb + kx[ks] + (32 * (st) + 4 * tau) * 128); \
            { unsigned va_ = vcb + (unsigned)((((4 * (st) + g) ^ c)) << 4); _Pragma("unroll") for (int dt = 0; dt < 4; ++dt) vc[dt] = *(const LAS bf16x8*)(Vc + va_ + (16 * dt) * 512); } } while (0)
        NA_LOADL(0, 0); __builtin_amdgcn_sched_barrier(0);
#pragma unroll 1
        for (int st = 0; st < 8; st += 2) {
            NA_LOADL(1, st + 1); __builtin_amdgcn_sched_barrier(0);
            NA_LOADC(st);
            na_step2(kf[0], vf[0], kc, vc, qf, O, mrun, lrun, bp0 + st * 64, madd);
            if (st + 2 < 8) NA_LOADL(0, st + 2);
            __builtin_amdgcn_sched_barrier(0);
            NA_LOADC(st + 1);
            na_step2(kf[1], vf[1], kc, vc, qf, O, mrun, lrun, bp0 + (st + 1) * 64, madd);
        }
#undef NA_LOADL
#undef NA_LOADC
        lrun += __shfl_xor(lrun, 16); lrun += __shfl_xor(lrun, 32);
        const float inv = __builtin_amdgcn_rcpf(lrun);
#pragma unroll
        for (int dt = 0; dt < 4; ++dt) {
            const f32x4 o = O[dt] * inv;
            const u32x2 gw = *(const u32x2*)(P + tok * LDP + PC_NAG + h * 64 + 16 * dt + 4 * g);
            u32x2 w; w.x = cvt_pk_bf16(o[0] * silu_f(bflo(gw.x)), o[1] * silu_f(bfhi(gw.x))); w.y = cvt_pk_bf16(o[2] * silu_f(bflo(gw.y)), o[3] * silu_f(bfhi(gw.y)));
            *(u32x2*)(Y + tok * DM + h * 64 + 16 * dt + 4 * g) = w;
        }
    }
}

DI void ret_out_phase(const Params& p, LAS unsigned char* lds, int vb, int G) {
    const int tid = threadIdx.x, lane = tid & 63, wave = __builtin_amdgcn_readfirstlane(tid >> 6), c = lane & 15, g = lane >> 4;
    const bf16_t* P = (const bf16_t*)(p.ws + WS_P); const bf16_t* PT = (const bf16_t*)(p.ws + WS_PT);
    const bf16_t* SFg = (const bf16_t*)(p.ws + WS_SF); const bf16_t* SBg = (const bf16_t*)(p.ws + WS_SB); const char* RTg = (const char*)(p.ws + WS_RT);
    bf16_t* Y = (bf16_t*)(p.ws + WS_Y);
    LAS unsigned char* Ks = lds; LAS unsigned char* Vs = lds + 32768; LAS unsigned char* SFs = lds + 65536; LAS unsigned char* SBs = lds + 98304;
    const int prow = tid >> 4, pc = tid & 15;
    const unsigned wK = (unsigned)(prow * 256 + ((pc ^ ((prow & 3) | (((prow >> 3) & 3) << 2))) << 4));
    const unsigned wV = (unsigned)(prow * 256 + ((pc ^ (prow & 15)) << 4));
    unsigned xo[4];
#pragma unroll
    for (int x = 0; x < 4; ++x) xo[x] = (unsigned)((((4 * x + g) ^ c)) << 4);
    const unsigned rK = (unsigned)((8 * (c >> 2) + (c & 3)) * 256), rV = (unsigned)(c * 256);
    bf16x8 st[8];
#define RO_LOAD_KV(uu) do { const int n_ = (uu) & 15, h_ = ((uu) >> 4) & 3, b_ = (uu) >> 6; \
        const bf16_t* kp_ = P + (size_t)(b_ * SEQ + 128 * n_ + prow) * LDP + PC_RK + h_ * 128 + pc * 8; \
        const char* vp_ = RTg + ((size_t)(((b_ * SEQ + 128 * n_) >> 3) + (tid >> 7)) * 1024 + 512 + h_ * 128 + (tid & 127)) * 16; \
        _Pragma("unroll") for (int i = 0; i < 4; ++i) { st[i] = ldg8(kp_ + (size_t)(32 * i) * LDP); st[4 + i] = *(const bf16x8*)(vp_ + (size_t)(4 * i) * 16384); } } while (0)
#define RO_LOAD_S(uu) do { const int n_ = (uu) & 15, h_ = ((uu) >> 4) & 3, b_ = (uu) >> 6; \
        const size_t so_ = (size_t)((b_ * 4 + h_) * 16 + n_) * 16384 + prow * 128 + pc * 8; \
        _Pragma("unroll") for (int i = 0; i < 4; ++i) { st[i] = ldg8(SFg + so_ + (32 * i) * 128); st[4 + i] = ldg8(SBg + so_ + (32 * i) * 128); } } while (0)
#define RO_STORE_KV() do { _Pragma("unroll") for (int i = 0; i < 4; ++i) { \
        *(LAS bf16x8*)(Ks + wK + i * 8192) = st[i]; \
        *(LAS bf16x8*)(Vs + (tid & 127) * 256 + (((((tid >> 7) + 4 * i)) ^ (tid & 15)) << 4)) = st[4 + i]; } } while (0)
#define RO_STORE(A0, W0, A1, W1) do { _Pragma("unroll") for (int i = 0; i < 4; ++i) { \
        *(LAS bf16x8*)((A0) + (W0) + i * 8192) = st[i]; *(LAS bf16x8*)((A1) + (W1) + i * 8192) = st[4 + i]; } } while (0)
    int u = vb;
    if (u < 1024) RO_LOAD_KV(u);
    for (; u < 1024; u += G) {
        const int n = u & 15, h = (u >> 4) & 3, b = u >> 6;
        const int tl = 16 * wave + c;
        const size_t tok = (size_t)(b * SEQ + 128 * n + tl);
        const float lgf2 = -__expf(p.dec_f[h]) * LOG2E, lgb2 = -__expf(p.dec_b[h]) * LOG2E;
        RO_STORE_KV();
        RO_LOAD_S(u); __builtin_amdgcn_sched_barrier(0);
        bf16x8 qf[4];
#pragma unroll
        for (int ks = 0; ks < 4; ++ks) qf[ks] = ldg8(P + tok * LDP + PC_RQ + h * 128 + 32 * ks + 8 * g);
        u32x2 gwv[8];
#pragma unroll
        for (int dt = 0; dt < 8; ++dt) gwv[dt] = *(const u32x2*)(P + tok * LDP + PC_RG + h * 128 + 16 * dt + 4 * g);
        __syncthreads();
        f32x4 O[8];
#pragma unroll
        for (int dt = 0; dt < 8; ++dt) O[dt] = (f32x4){0.f, 0.f, 0.f, 0.f};
#pragma unroll
        for (int sg = 0; sg < 4; ++sg) {
            int tlv = tl - 8 * g; asm volatile("" : "+v"(tlv));
            f32x4 s_[2];
#pragma unroll
            for (int tau = 0; tau < 2; ++tau) {
                s_[tau] = (f32x4){0.f, 0.f, 0.f, 0.f};
#pragma unroll
                for (int ks = 0; ks < 4; ++ks) { unsigned a_ = rK + xo[ks]; asm volatile("" : "+v"(a_)); s_[tau] = mfma16(*(const LAS bf16x8*)(Ks + a_ + (32 * sg + 4 * tau) * 256), qf[ks], s_[tau]); }
            }
#pragma unroll
            for (int tau = 0; tau < 2; ++tau)
#pragma unroll
                for (int e = 0; e < 4; ++e) {
                    const int dl_ = tlv - (32 * sg + 4 * tau + e);
                    const float lg_ = dl_ > 0 ? lgf2 : lgb2; float d_ = ex2(lg_ * fabsf((float)dl_)); d_ = dl_ == 0 ? 2.0f : d_; s_[tau][e] *= d_; }
            u32x4 pw_; pw_.x = cvt_pk_bf16(s_[0][0], s_[0][1]); pw_.y = cvt_pk_bf16(s_[0][2], s_[0][3]); pw_.z = cvt_pk_bf16(s_[1][0], s_[1][1]); pw_.w = cvt_pk_bf16(s_[1][2], s_[1][3]);
            const bf16x8 pf = __builtin_bit_cast(bf16x8, pw_);
            unsigned av_ = 32768u + rV + xo[sg]; asm volatile("" : "+v"(av_));
#pragma unroll
            for (int dt = 0; dt < 8; ++dt) O[dt] = mfma16(*(const LAS bf16x8*)(lds + av_ + (16 * dt) * 256), pf, O[dt]);
            __builtin_amdgcn_sched_barrier(0);
        }
        RO_STORE(SFs, wV, SBs, wV);
        if (u + G < 1024) RO_LOAD_KV(u + G);
        __builtin_amdgcn_sched_barrier(0);
        __syncthreads();
        const float cF = ex2(lgf2 * (float)(tl + 1)), cB = ex2(lgb2 * (float)(128 - tl));
#pragma unroll
        for (int ks = 0; ks < 4; ++ks) {
            const bf16x8 qF_ = scale_frag(qf[ks], cF), qB_ = scale_frag(qf[ks], cB);
            unsigned af_ = 65536u + rV + xo[ks], ab_ = 98304u + rV + xo[ks]; asm volatile("" : "+v"(af_), "+v"(ab_));
#pragma unroll
            for (int dt = 0; dt < 8; ++dt) {
                O[dt] = mfma16(*(const LAS bf16x8*)(lds + af_ + (16 * dt) * 256), qF_, O[dt]);
                O[dt] = mfma16(*(const LAS bf16x8*)(lds + ab_ + (16 * dt) * 256), qB_, O[dt]);
            }
            __builtin_amdgcn_sched_barrier(0);
        }
        float ss = 0.f;
#pragma unroll
        for (int dt = 0; dt < 8; ++dt) ss += (O[dt][0] * O[dt][0] + O[dt][1] * O[dt][1]) + (O[dt][2] * O[dt][2] + O[dt][3] * O[dt][3]);
        ss += __shfl_xor(ss, 16); ss += __shfl_xor(ss, 32);
        const float rstd = rsqrtf(ss * (1.f / 128.f) + EPSN);
#pragma unroll
        for (int dt = 0; dt < 8; ++dt) {
            const int dv = 16 * dt + 4 * g;
            const f32x4 gn = *(const f32x4*)(p.ret_norm_g + h * 128 + dv);
            const u32x2 gw = gwv[dt];
            const f32x4 o = O[dt] * rstd * gn;
            u32x2 w; w.x = cvt_pk_bf16(o[0] * silu_f(bflo(gw.x)), o[1] * silu_f(bfhi(gw.x))); w.y = cvt_pk_bf16(o[2] * silu_f(bflo(gw.y)), o[3] * silu_f(bfhi(gw.y)));
            *(u32x2*)(Y + tok * DM + 512 + h * 128 + dv) = w;
        }
    }
#undef RO_LOAD_KV
#undef RO_LOAD_S
#undef RO_STORE
#undef RO_STORE_KV
}

DI void phase_p5(const Params& p, int vb, int G) {
    const int tid = threadIdx.x, lane = tid & 63, wave = tid >> 6;
    const int gw = vb * 8 + wave, NGW = G * 8;
    f32x4 gn[4];
#pragma unroll
    for (int j = 0; j < 4; ++j) gn[j] = *(const f32x4*)(p.final_g + 4 * lane + 256 * j);
    for (int grp = gw; grp < MLAT / 4; grp += NGW) {
        f32x4* xr = (f32x4*)(p.out + (size_t)grp * 4 * DM) + lane;
        f32x4 v[4][4]; float sq[4];
#pragma unroll
        for (int r = 0; r < 4; ++r)
#pragma unroll
            for (int j = 0; j < 4; ++j) v[r][j] = xr[r * 256 + 64 * j];
#pragma unroll
        for (int r = 0; r < 4; ++r) { float s = 0.f;
#pragma unroll
            for (int j = 0; j < 4; ++j) s += (v[r][j].x * v[r][j].x + v[r][j].y * v[r][j].y) + (v[r][j].z * v[r][j].z + v[r][j].w * v[r][j].w);
            sq[r] = s; }
#pragma unroll
        for (int o = 1; o < 64; o <<= 1)
#pragma unroll
            for (int r = 0; r < 4; ++r) sq[r] += __shfl_xor(sq[r], o);
#pragma unroll
        for (int r = 0; r < 4; ++r) { const float rstd = rsqrtf(sq[r] * (1.f / DM) + EPSN);
#pragma unroll
            for (int j = 0; j < 4; ++j) xr[r * 256 + 64 * j] = v[r][j] * rstd * gn[j]; }
    }
}

#define XB_TMO      128
#define XB_XCNT(j)  (256  + 64 * (j))
#define XB_XSUB(j)  (1280 + 64 * (j))
#define XB_XGEN(j)  (2304 + 64 * (j))
#define XB_TOP      3328
#define XB_TOPGEN   3392
#define XCD_BAR_WORDS 3456
#define XB_SPIN_CAP (1u << 18)
DI unsigned xb_ld(unsigned* p)              { return __hip_atomic_load(p, __ATOMIC_RELAXED, __HIP_MEMORY_SCOPE_AGENT); }
DI unsigned xb_add(unsigned* p, unsigned v) { return __hip_atomic_fetch_add(p, v, __ATOMIC_RELAXED, __HIP_MEMORY_SCOPE_AGENT); }
DI unsigned xb_xcc_id() { return (unsigned)__builtin_amdgcn_s_getreg((3 << 11) | 20) & 0xFu; }
#define XB_SPIN(cond, bar) do { unsigned _sp = 0; while (cond) { __builtin_amdgcn_s_sleep(1); \
    if ((++_sp & 255u) == 0u) { if (xb_ld(&(bar)[XB_TMO])) break; if (_sp > XB_SPIN_CAP) { atomicAdd(&(bar)[XB_TMO], 1u); break; } } } } while (0)
struct XcdBarrier { unsigned* bar; unsigned x; volatile LAS unsigned* st; };
DI XcdBarrier xcd_barrier_post(unsigned* bar, volatile LAS unsigned* st) {
    XcdBarrier b; b.bar = bar; b.x = xb_xcc_id(); b.st = st;
    if (threadIdx.x == 0) (void)xb_add(&bar[XB_XCNT(b.x)], 1u);
    return b;
}
DI void xcd_barrier_complete(unsigned* bar, unsigned x, unsigned& nloc, unsigned& nx) {
    const unsigned G = gridDim.x * gridDim.y * gridDim.z;
    unsigned sum, cnt, mine, sp = 0u;
    for (;;) {
        sum = 0u; cnt = 0u; mine = 0u;
#pragma unroll
        for (unsigned j = 0; j < 16; ++j) { const unsigned c = xb_ld(&bar[XB_XCNT(j)]); sum += c; cnt += (c > 0u) ? 1u : 0u; mine = (j == x) ? c : mine; }
        if (sum == G) break;
        __builtin_amdgcn_s_sleep(1);
        if ((++sp & 255u) == 0u) { if (xb_ld(&bar[XB_TMO])) break; if (sp > XB_SPIN_CAP) { atomicAdd(&bar[XB_TMO], 1u); break; } }
    }
    nloc = mine > 0u ? mine : 1u; nx = cnt > 0u ? cnt : 1u;
}
DI void xcd_barrier(const XcdBarrier& b) {
    asm volatile("s_waitcnt vmcnt(0)" ::: "memory");
    __syncthreads();
    if (threadIdx.x == 0) {
        unsigned* bar = b.bar;
        __builtin_amdgcn_s_waitcnt(0);
        unsigned nloc = b.st[0], nx = b.st[1];
        if (nloc == 0u) { xcd_barrier_complete(bar, b.x, nloc, nx); b.st[0] = nloc; b.st[1] = nx; }
        const unsigned old = xb_add(&bar[XB_XSUB(b.x)], 1u);
        const unsigned gen = old / nloc;
        if (old + 1u == (gen + 1u) * nloc) {
            __builtin_amdgcn_fence(__ATOMIC_RELEASE, "agent");
            asm volatile("s_waitcnt vmcnt(0)" ::: "memory");
            const unsigned og = xb_add(&bar[XB_TOP], 1u);
            const unsigned tg = og / nx;
            if (og + 1u == (tg + 1u) * nx) xb_add(&bar[XB_TOPGEN], 1u);
            else XB_SPIN(xb_ld(&bar[XB_TOPGEN]) == tg, bar);
            __builtin_amdgcn_fence(__ATOMIC_ACQUIRE, "agent");
            xb_add(&bar[XB_XGEN(b.x)], 1u);
            asm volatile("s_waitcnt vmcnt(0)" ::: "memory");
        } else {
            XB_SPIN(xb_ld(&bar[XB_XGEN(b.x)]) == gen, bar);
            __builtin_amdgcn_fence(__ATOMIC_ACQUIRE, "agent");
            asm volatile("s_waitcnt vmcnt(0)" ::: "memory");
        }
    }
    __syncthreads();
}
__global__ void __launch_bounds__(512, 2) mega_fwd(Params p) {
    extern __shared__ __attribute__((aligned(16))) unsigned char lds_raw[];
    LAS unsigned char* lds = (LAS unsigned char*)lds_raw;
    const int G = gridDim.x, bx = blockIdx.x;
    const int vb = (G % 8 == 0) ? (bx % 8) * (G / 8) + bx / 8 : bx;
    const int tid = threadIdx.x;
    volatile LAS unsigned* MISC = (volatile LAS unsigned*)(lds + 131072);
    if (tid < 16) MISC[tid] = 0u;
    __syncthreads();
    (void)xcd_barrier_post((unsigned*)p.ws, MISC);
#define GRID_BAR() do { XcdBarrier b_; b_.bar = (unsigned*)p.ws; b_.x = xb_xcc_id(); b_.st = (volatile LAS unsigned*)(lds + 131072); xcd_barrier(b_); } while (0)

#ifndef REPMASK
#define REPMASK 0
#endif
#define PH_P0()  phase_p0(p, lds, vb, G)
#define PH_P0B() phase_p0b(p, vb, G)
#define PH_P1()  do { InSched S{(const char*)(p.ws + WS_XN), (const char*)(p.ws + WS_WT), bx, G}; \
        EpiIn E{(bf16_t*)(p.ws + WS_P), (bf16_t*)(p.ws + WS_KT), (bf16_t*)(p.ws + WS_PT), (const float*)(p.ws + WS_COS), (const float*)(p.ws + WS_SIN), (const float*)(p.ws + WS_COST), (const float*)(p.ws + WS_SINT), lds + 131072 + 256}; \
        pg8::gemm_phase<EpiIn, InSched>(lds, S, E); } while (0)
#define PH_R1()  do { for (int it = vb; it < 256; it += G) ret_state_item(p, it); } while (0)
#define PH_NA()  do { for (int it = vb; it < 256; it += G) na_item(p, lds, it); } while (0)
#define PH_R2()  ret_out_phase(p, lds, vb, G)
#define PH_P4()  do { OutSched S{(const char*)(p.ws + WS_Y), (const char*)(p.ws + WS_WOT), vb, G}; \
        EpiOutF E{p.x, (const float*)(p.ws + WS_MOD), p.final_g, p.out, (float*)(p.ws + WS_XBUF), (unsigned*)(p.ws + WS_CNT), lds + 131072 + 256}; \
        pg8::gemm_phase<EpiOutF, OutSched>(lds, S, E); } while (0)
    PH_P0();
#if REPMASK & 1
    PH_P0();
#endif
    GRID_BAR();
    PH_P0B();
#if REPMASK & 2
    PH_P0B();
#endif
    GRID_BAR();
    PH_P1();
#if REPMASK & 4
    PH_P1();
#endif
    GRID_BAR();
    PH_R1();
#if REPMASK & 8
    PH_R1();
#endif
    PH_NA();
#if REPMASK & 16
    PH_NA();
#endif
    GRID_BAR();
    PH_R2();
#if REPMASK & 32
    PH_R2();
#endif
    GRID_BAR();
    PH_P4();
}

extern "C" void kernel_launch(void* const* d_in, const int* in_sizes, int n_in, void* d_out, int out_size, void* d_ws, size_t ws_size, hipStream_t stream) {
    static int grid = 0;
    if (grid == 0) {
        if (n_in != 14 || out_size != MLAT * DM || ws_size < WS_END) { fprintf(stderr, "kernel_launch: unexpected shapes (n_in %d, out %d, ws %zu)\n", n_in, out_size, ws_size); grid = -1; return; }
        int dev = 0, cus = 0, per_cu = 0;
        hipGetDevice(&dev);
        hipDeviceGetAttribute(&cus, hipDeviceAttributeMultiprocessorCount, dev);
        hipFuncSetAttribute((const void*)mega_fwd, hipFuncAttributeMaxDynamicSharedMemorySize, LDS_BYTES);
        hipOccupancyMaxActiveBlocksPerMultiprocessor(&per_cu, (const void*)mega_fwd, 512, LDS_BYTES);
        if (per_cu < 1 || cus < 1) { fprintf(stderr, "kernel_launch: occupancy query says %d blocks per CU (%d CUs)\n", per_cu, cus); grid = -1; return; }
        grid = cus;
    }
    if (grid < 0) return;
    Params p{};
    p.x = (const float*)d_in[0]; p.c = (const float*)d_in[1]; p.ctx = (const float*)d_in[2]; p.c_ctx = (const float*)d_in[3];
    p.norm_g = (const float*)d_in[4]; p.w_ada = (const float*)d_in[5]; p.b_ada = (const float*)d_in[6]; p.w_in = (const float*)d_in[7];
    p.na_rpb = (const float*)d_in[8]; p.dec_f = (const float*)d_in[9]; p.dec_b = (const float*)d_in[10]; p.ret_norm_g = (const float*)d_in[11];
    p.w_out = (const float*)d_in[12]; p.final_g = (const float*)d_in[13];
    p.out = (float*)d_out; p.ws = (unsigned char*)d_ws;
    if (hipMemsetAsync(d_ws, 0, 65536, stream) != hipSuccess) { fprintf(stderr, "kernel_launch: memset of the barrier words failed\n"); return; }
    hipLaunchKernelGGL(mega_fwd, dim3(grid), dim3(512), LDS_BYTES, stream, p);
    const hipError_t e = hipPeekAtLastError();
    if (e != hipSuccess) fprintf(stderr, "launch failed: %s (grid %d)\n", hipGetErrorString(e), grid);
}
```

```cpp
#include <hip/hip_runtime.h>
#include <cstdio>
#include <cstdint>

#define DI __device__ __forceinline__
#define LAS __attribute__((address_space(3)))
typedef unsigned short bf16_t;
typedef short bf16x8 __attribute__((ext_vector_type(8)));
typedef float f32x4 __attribute__((ext_vector_type(4)));
typedef unsigned u32x4 __attribute__((ext_vector_type(4)));
typedef unsigned u32x2 __attribute__((ext_vector_type(2)));

constexpr int DM = 1024, NBATCH = 16, SEQ = 2048, CTXL = 256;
constexpr int MLAT = NBATCH * SEQ, MCTX = NBATCH * CTXL, MTOT = MLAT + MCTX;
constexpr int LDP = 2560 + 128;
constexpr int LDT = MTOT + 128;
constexpr int LDKC = 512 + 128;
constexpr int PC_NAQ = 0, PC_NAG = 512, PC_RQ = 1024, PC_RK = 1536, PC_RG = 2048;
constexpr int PT_NAV = 0, PT_RK = 512, PT_RV = 1024;
constexpr float LOG2E = 1.4426950408889634f;
constexpr float KSCALE = 0.08838834764831845f;
constexpr float EPSN = 1e-6f;
constexpr int NWT = 4608;

constexpr size_t MiB = 1u << 20;
constexpr size_t WS_WT = 2 * MiB, WS_WOT = 12 * MiB, WS_MODP = 24 * MiB  , WS_MOD = 15 * MiB;
constexpr size_t WS_CNT = 16384;
constexpr size_t WS_XBUF = 20 * MiB;
constexpr size_t WS_COS = 16 * MiB, WS_SIN = WS_COS + 512 * 1024, WS_COST = 17 * MiB, WS_SINT = WS_COST + 512 * 1024;
constexpr size_t WS_XN = 32 * MiB;
constexpr size_t WS_Y = 32 * MiB;
constexpr size_t WS_P = 104 * MiB;
constexpr size_t WS_KT = 272 * MiB;
constexpr size_t WS_PT = 310 * MiB;
constexpr size_t WS_VT = WS_PT;
constexpr size_t WS_RT = WS_PT + (size_t)512 * LDT * 2;
static_assert((size_t)MTOT * 1024 * 2 <= (size_t)1024 * LDT * 2, "RT fits the old PT rows");
constexpr size_t WS_SF = 419 * MiB, WS_SB = 451 * MiB;
constexpr size_t WS_END = 483 * MiB;
static_assert(WS_P + (size_t)MLAT * LDP * 2 <= WS_KT && WS_KT + (size_t)MTOT * 512 * 2 <= WS_PT && (size_t)MTOT * 512 * 2 <= (size_t)512 * LDT * 2 && WS_PT + (size_t)1536 * LDT * 2 <= WS_SF, "ws map");

constexpr int LDS_BYTES = 131072 + 256 + 5120 + 8 * 2304;

struct Params {
    const float *x, *c, *ctx, *c_ctx, *norm_g, *w_ada, *b_ada, *w_in, *na_rpb, *dec_f, *dec_b, *ret_norm_g, *w_out, *final_g;
    float* out; unsigned char* ws;
};

DI unsigned cvt_pk_bf16(float lo, float hi) { unsigned r; asm volatile("v_cvt_pk_bf16_f32 %0, %1, %2" : "=v"(r) : "v"(lo), "v"(hi)); return r; }
DI float bf2f(unsigned short v) { return __uint_as_float(((unsigned)v) << 16); }
DI float bflo(unsigned w) { return __uint_as_float(w << 16); }
DI float bfhi(unsigned w) { return __uint_as_float(w & 0xffff0000u); }
DI f32x4 mfma16(bf16x8 a, bf16x8 b, f32x4 c) { return __builtin_amdgcn_mfma_f32_16x16x32_bf16(a, b, c, 0, 0, 0); }
DI bf16x8 ldg8(const bf16_t* p) { return *(const bf16x8*)p; }
#define GAS __attribute__((address_space(1)))
DI bf16x8 ldg8u(const bf16_t* ub, unsigned off_bytes) {
    const GAS char* gp = (const GAS char*)ub; asm volatile("" : "+s"(gp));
    return *(const GAS bf16x8*)(gp + off_bytes); }
DI float ex2(float x) { return __builtin_amdgcn_exp2f(x); }
DI float wave_sum(float v) {
#pragma unroll
    for (int o = 1; o < 64; o <<= 1) v += __shfl_xor(v, o);
    return v;
}
DI float silu_f(float v) { return v * __builtin_amdgcn_rcpf(1.f + ex2(v * -LOG2E)); }
DI bf16x8 scale_frag(bf16x8 a, float s) {
    u32x4 w = __builtin_bit_cast(u32x4, a), o;
    o.x = cvt_pk_bf16(bflo(w.x) * s, bfhi(w.x) * s); o.y = cvt_pk_bf16(bflo(w.y) * s, bfhi(w.y) * s);
    o.z = cvt_pk_bf16(bflo(w.z) * s, bfhi(w.z) * s); o.w = cvt_pk_bf16(bflo(w.w) * s, bfhi(w.w) * s);
    return __builtin_bit_cast(bf16x8, o);
}

namespace pg8 {
constexpr int BM = 256, BK = 64, HALF = 128, HTB = HALF * BK * 2, STAGE_BYTES = 8 * HTB;
constexpr int GK = 1024;
__host__ __device__ __forceinline__ int lds_byte(int r, int c) { const int st = (r >> 4) * 2 + (c >> 5), rr = r & 15, cc = c & 31, ob = rr * 64 + cc * 2; return st * 1024 + (ob ^ (((ob >> 9) & 1) << 5)); }
__host__ __device__ __forceinline__ void stage_rc(int b, int& R, int& C) { const int st = b / 1024, sb = b % 1024, swz = sb ^ (((sb >> 9) & 1) << 5); R = (st >> 1) * 16 + swz / 64; C = (st & 1) * 32 + (swz % 64) / 2; }
__host__ __device__ __forceinline__ int perm32(int rho) { const int n = rho >> 4, i = rho & 15; return 8 * (i >> 2) + 4 * n + (i & 3); }

struct Unit { int pm, pn; };

template <class Epi, class Sched>
DI void gemm_phase(LAS unsigned char* lds, const Sched& S, const Epi& E) {
    const int tid = threadIdx.x, wid = __builtin_amdgcn_readfirstlane(tid >> 6), lane = tid & 63, wr = wid >> 2, wc = wid & 3, fr = lane & 15, fq = lane >> 4;
    constexpr int K = GK, nt = K / BK;
    unsigned voffA[2], voffB[2];
#pragma unroll
    for (int i = 0; i < 2; ++i) { int R, C; stage_rc(tid * 16 + i * 8192, R, C); const int Rb = Epi::PERM ? ((R & ~31) + perm32(R & 31)) : R;
        voffA[i] = (unsigned)(R * K + C) * 2u; voffB[i] = (unsigned)(Rb * K + C) * 2u; }
    const size_t kstep = (size_t)(BK * 2);
    const size_t hstep = (size_t)HALF * K * 2;
    const unsigned ldsw = (unsigned)wid * 1024u;
    const int aoff = lds_byte(wr * 64 + fr, fq * 8), boff = lds_byte(wc * 32 + fr, fq * 8);
#define PG8_SA(b, h) (((b) * 2 + (h)) * HTB)
#define PG8_SB(b, h) ((4 + (b) * 2 + (h)) * HTB)
#define PG8_STAGE(bufoff, gbase, voff) do { _Pragma("unroll") for (int _i = 0; _i < 2; ++_i) \
        __builtin_amdgcn_global_load_lds((const unsigned*)((const char*)(gbase) + (voff)[_i]), (LAS unsigned*)(lds + (bufoff) + ldsw + _i * 8192), 16, 0, 0); } while (0)
#define PG8_LDA(dst, b, h) do { _Pragma("unroll") for (int m = 0; m < 4; ++m) _Pragma("unroll") for (int k = 0; k < 2; ++k) dst[m][k] = *(const LAS bf16x8*)(lds + PG8_SA(b, h) + aoff + m * 2048 + k * 1024); } while (0)
#define PG8_LDB(dst, b, h) do { _Pragma("unroll") for (int n = 0; n < 2; ++n) _Pragma("unroll") for (int k = 0; k < 2; ++k) dst[n][k] = *(const LAS bf16x8*)(lds + PG8_SB(b, h) + boff + n * 2048 + k * 1024); } while (0)
#define PG8_MMA(ai, bj, At, Bt) do { __builtin_amdgcn_s_setprio(1); _Pragma("unroll") for (int m = 0; m < 4; ++m) _Pragma("unroll") for (int n = 0; n < 2; ++n) _Pragma("unroll") for (int k = 0; k < 2; ++k) \
        acc[ai][bj][m][n] = __builtin_amdgcn_mfma_f32_16x16x32_bf16(Bt[n][k], At[m][k], acc[ai][bj][m][n], 0, 0, 0); __builtin_amdgcn_s_setprio(0); } while (0)
#define PG8_WAIT_V(n) asm volatile("s_waitcnt vmcnt(" #n ")" ::: "memory")
#define PG8_WAIT_L(n) asm volatile("s_waitcnt lgkmcnt(" #n ")" ::: "memory")
#define PG8_BAR __builtin_amdgcn_s_barrier()
#define PG8_SCHED __builtin_amdgcn_sched_barrier(0)
    Unit cur, nxt; int ui = 0;
    if (!S.next(0, cur)) return;
    f32x4 acc[2][2][4][2];
#pragma unroll
    for (int a = 0; a < 2; ++a)
#pragma unroll
        for (int b = 0; b < 2; ++b)
#pragma unroll
            for (int m = 0; m < 4; ++m)
#pragma unroll
                for (int n = 0; n < 2; ++n) acc[a][b][m][n] = (f32x4){0.f, 0.f, 0.f, 0.f};
    bf16x8 At[4][2], B0[2][2], B1[2][2];
    const char* cA = S.aptr(cur); const char* cB = S.bptr(cur);
    PG8_STAGE(PG8_SB(0, 0), cB, voffB); PG8_STAGE(PG8_SB(0, 1), cB + hstep, voffB); PG8_STAGE(PG8_SA(0, 0), cA, voffA); PG8_STAGE(PG8_SA(0, 1), cA + hstep, voffA);
    if (wr == 1) PG8_BAR;
    PG8_WAIT_V(2); PG8_BAR;
    PG8_STAGE(PG8_SB(1, 0), cB + kstep, voffB); PG8_STAGE(PG8_SA(1, 0), cA + kstep, voffA); PG8_STAGE(PG8_SB(1, 1), cB + hstep + kstep, voffB);
    PG8_WAIT_V(6); PG8_BAR;
    for (;;) {
        const bool has_next = S.next(ui + 1, nxt);
        const char* nA = has_next ? S.aptr(nxt) : cA; const char* nB = has_next ? S.bptr(nxt) : cB;
        for (int t = 0; t < nt; t += 2) {
            const bool last = (t == nt - 2);
            const char* a1 = cA + (size_t)(t + 1) * kstep;
            const char* a2 = last ? nA : cA + (size_t)(t + 2) * kstep; const char* b2 = last ? nB : cB + (size_t)(t + 2) * kstep;
            const char* a3 = a2 + kstep; const char* b3 = b2 + kstep;
            PG8_LDB(B0, 0, 0); PG8_LDB(B1, 0, 1); PG8_SCHED; PG8_LDA(At, 0, 0); PG8_STAGE(PG8_SA(1, 1), a1 + hstep, voffA);
            PG8_WAIT_V(8); PG8_WAIT_L(0); PG8_BAR; PG8_MMA(0, 0, At, B0); PG8_MMA(0, 1, At, B1); PG8_BAR; PG8_SCHED;
            PG8_LDA(At, 0, 1); PG8_STAGE(PG8_SB(0, 0), b2, voffB); PG8_STAGE(PG8_SB(0, 1), b2 + hstep, voffB); PG8_STAGE(PG8_SA(0, 0), a2, voffA);
            PG8_WAIT_V(8); PG8_WAIT_L(0); PG8_BAR; PG8_MMA(1, 0, At, B0); PG8_MMA(1, 1, At, B1); PG8_BAR; PG8_SCHED;
            PG8_LDB(B0, 1, 0); PG8_LDB(B1, 1, 1); PG8_SCHED; PG8_LDA(At, 1, 0); PG8_STAGE(PG8_SA(0, 1), a2 + hstep, voffA);
            PG8_WAIT_V(8); PG8_WAIT_L(0); PG8_BAR; PG8_MMA(0, 0, At, B0); PG8_MMA(0, 1, At, B1); PG8_BAR; PG8_SCHED;
            PG8_LDA(At, 1, 1); PG8_STAGE(PG8_SB(1, 0), b3, voffB); PG8_STAGE(PG8_SB(1, 1), b3 + hstep, voffB); PG8_STAGE(PG8_SA(1, 0), a3, voffA);
            PG8_WAIT_V(8); PG8_WAIT_L(0); PG8_BAR; PG8_MMA(1, 0, At, B0); PG8_MMA(1, 1, At, B1); PG8_BAR; PG8_SCHED;
        }
        if (wr == 0) PG8_BAR;
        E(acc, cur, wr, wc, fr, fq);
        if (!has_next) break;
#pragma unroll
        for (int a = 0; a < 2; ++a)
#pragma unroll
            for (int b = 0; b < 2; ++b)
#pragma unroll
                for (int m = 0; m < 4; ++m)
#pragma unroll
                    for (int n = 0; n < 2; ++n) acc[a][b][m][n] = (f32x4){0.f, 0.f, 0.f, 0.f};
        cur = nxt; cA = nA; cB = nB; ++ui;
        if (wr == 1) PG8_BAR;
    }
    PG8_WAIT_V(0);
    PG8_BAR;
#undef PG8_SA
#undef PG8_SB
#undef PG8_STAGE
#undef PG8_LDA
#undef PG8_LDB
#undef PG8_MMA
#undef PG8_WAIT_V
#undef PG8_WAIT_L
#undef PG8_BAR
#undef PG8_SCHED
}
}

struct InSched {
    const char* XN; const char* WT; int c, G;
    DI bool next(int i, pg8::Unit& u) const {
        const long L = (long)i * G + c;
        if (L < 2048) {
            int wgid = (int)L; wgid = (wgid & 7) * 256 + (wgid >> 3);
            const int gid = wgid >> 7, rem = wgid & 127, vs = rem >> 3;
            u.pm = gid * 8 + (rem & 7); u.pn = vs < 14 ? vs : vs + 2; return true;
        }
        if (L < 2176) { const int l2 = (int)L - 2048; u.pm = 128 + (l2 & 15); const int j = l2 >> 4; u.pn = j < 2 ? 2 + j : 10 + j; return true; }
        return false;
    }
    DI const char* aptr(const pg8::Unit& u) const { return u.pn < 12 ? XN + (size_t)u.pm * (256 * 1024 * 2) : WT + (size_t)u.pn * (256 * 1024 * 2); }
    DI const char* bptr(const pg8::Unit& u) const { return u.pn < 12 ? WT + (size_t)u.pn * (256 * 1024 * 2) : XN + (size_t)u.pm * (256 * 1024 * 2); }
};
struct EpiIn {
    static constexpr bool PERM = true;
    bf16_t *P, *KT, *PT; const float *COS, *SIN, *COST, *SINT; LAS unsigned char* scr;
    DI void operator()(const f32x4 (&acc)[2][2][4][2], const pg8::Unit& u, int wr, int wc, int fr_, int fq_) const {
        int fr = fr_, fq = fq_; asm volatile("" : "+v"(fr), "+v"(fq));
        const int vn = u.pn, pm = u.pm;
        if (vn < 12) {
            const int rowb = pm * 256 + wr * 64 + fr;
            if (vn == 2 || vn == 3) {
                const int colk = (vn - 2) * 256 + wc * 32 + 8 * fq;
#pragma unroll
                for (int ai = 0; ai < 2; ++ai)
#pragma unroll
                    for (int m = 0; m < 4; ++m) {
                        const int tok = rowb + ai * 128 + m * 16;
#pragma unroll
                        for (int bj = 0; bj < 2; ++bj) {
                            const int col = colk + bj * 128, hh = col >> 6, ks = (col >> 5) & 1, gg = (col >> 3) & 3;
                            const f32x4 v0 = acc[ai][bj][m][0], v1 = acc[ai][bj][m][1];
                            u32x4 w; w.x = cvt_pk_bf16(v0[0], v0[1]); w.y = cvt_pk_bf16(v0[2], v0[3]); w.z = cvt_pk_bf16(v1[0], v1[1]); w.w = cvt_pk_bf16(v1[2], v1[3]);
                            __builtin_nontemporal_store(w, (u32x4*)((char*)KT + (size_t)((tok >> 3) * 8 + hh) * 1024 + ks * 512 + (gg * 8 + (tok & 7)) * 16));
                        }
                    }
                return;
            }
            bf16_t* base = P; const int ldc = LDP;
            const int col0 = (vn < 2 ? vn : vn - 2) * 256 + wc * 32 + 8 * fq;
            const bool rot = (vn >= 6 && vn < 10);
            const int i0 = 16 * wc + 4 * fq;
#pragma unroll
            for (int ai = 0; ai < 2; ++ai)
#pragma unroll
                for (int m = 0; m < 4; ++m) {
                    const int row = rowb + ai * 128 + m * 16;
                    f32x4 c4 = {1.f, 1.f, 1.f, 1.f}, s4 = {0.f, 0.f, 0.f, 0.f};
                    if (rot) { const int t = row & 2047; c4 = *(const f32x4*)(COS + t * 64 + i0); s4 = *(const f32x4*)(SIN + t * 64 + i0); }
                    bf16_t* rowp = base + (size_t)row * ldc + col0;
#pragma unroll
                    for (int bj = 0; bj < 2; ++bj) {
                        const f32x4 v0 = acc[ai][bj][m][0], v1 = acc[ai][bj][m][1];
                        const f32x4 o0 = v0 * c4 - v1 * s4, o1 = v0 * s4 + v1 * c4;
                        u32x4 w; w.x = cvt_pk_bf16(o0[0], o0[1]); w.y = cvt_pk_bf16(o0[2], o0[3]); w.z = cvt_pk_bf16(o1[0], o1[1]); w.w = cvt_pk_bf16(o1[2], o1[3]);
                        {
                            LAS unsigned char* tbw = scr + 5120 + (wr * 4 + wc) * 2304;
                            const int ln = fr + 16 * fq;
                            *(LAS u32x4*)(tbw + fr * 80 + fq * 16) = w;
                            const u32x4 wt = *(const LAS u32x4*)(tbw + (ln >> 2) * 80 + (ln & 3) * 16);
                            __builtin_nontemporal_store(wt, (u32x4*)(base + (size_t)(row - fr + (ln >> 2)) * ldc + (col0 - 8 * fq) + bj * 128 + (ln & 3) * 8));
                        }
                        if (vn == 8 || vn == 9) {
                            unsigned short* r0 = (unsigned short*)((char*)PT + (size_t)512 * LDT * 2 + ((size_t)(row >> 3) * 1024 + ((vn - 8) * 2 + bj) * 128 + 32 * wc + 4 * fq) * 16 + (row & 7) * 2);
                            r0[0] = (unsigned short)(w.x & 0xffffu); r0[8] = (unsigned short)(w.x >> 16); r0[16] = (unsigned short)(w.y & 0xffffu); r0[24] = (unsigned short)(w.y >> 16);
                            r0[128] = (unsigned short)(w.z & 0xffffu); r0[136] = (unsigned short)(w.z >> 16); r0[144] = (unsigned short)(w.w & 0xffffu); r0[152] = (unsigned short)(w.w >> 16);
                        }
                    }
                }
        } else {
            const int frow0 = (vn - 12) * 256 + wr * 64 + fr;
            const int tok0 = pm * 256 + wc * 32 + 8 * fq;
            const bool rot = (vn == 14 || vn == 15) && pm < 128;
            if (vn < 14) {
#pragma unroll
                for (int ai = 0; ai < 2; ++ai)
#pragma unroll
                    for (int bj = 0; bj < 2; ++bj)
#pragma unroll
                        for (int m = 0; m < 4; ++m) {
                            const int f = frow0 + ai * 128 + m * 16, tok = tok0 + bj * 128;
                            const f32x4 v0 = acc[ai][bj][m][0], v1 = acc[ai][bj][m][1];
                            u32x4 w; w.x = cvt_pk_bf16(v0[0], v0[1]); w.y = cvt_pk_bf16(v0[2], v0[3]); w.z = cvt_pk_bf16(v1[0], v1[1]); w.w = cvt_pk_bf16(v1[2], v1[3]);
                            __builtin_nontemporal_store(w, (u32x4*)((char*)PT + (size_t)((tok >> 3) * 8 + (f >> 6)) * 1024 + (f & 63) * 16));
                        }
                return;
            }
#pragma unroll
            for (int ai = 0; ai < 2; ++ai)
#pragma unroll
                for (int bj = 0; bj < 2; ++bj)
#pragma unroll
                    for (int mp = 0; mp < 2; ++mp) {
                        const int tok = tok0 + bj * 128;
                        f32x4 ca = {1.f, 1.f, 1.f, 1.f}, cb = ca, sa = {0.f, 0.f, 0.f, 0.f}, sb = sa;
                        if (rot) { const int i = 32 * wr + 16 * mp + fr, t = tok & 2047;
                            ca = *(const f32x4*)(COST + i * 2048 + t); cb = *(const f32x4*)(COST + i * 2048 + t + 4);
                            sa = *(const f32x4*)(SINT + i * 2048 + t); sb = *(const f32x4*)(SINT + i * 2048 + t + 4); }
                        const f32x4 x1a = acc[ai][bj][2 * mp][0], x1b = acc[ai][bj][2 * mp][1], x2a = acc[ai][bj][2 * mp + 1][0], x2b = acc[ai][bj][2 * mp + 1][1];
                        const f32x4 o1a = x1a * ca - x2a * sa, o1b = x1b * cb - x2b * sb, o2a = x1a * sa + x2a * ca, o2b = x1b * sb + x2b * cb;
                        char* r1 = (char*)PT + (size_t)512 * LDT * 2 + ((size_t)(tok >> 3) * 1024 + (frow0 - 512 + ai * 128 + (2 * mp) * 16)) * 16;
                        char* r2 = r1 + 16 * 16;
                        u32x4 w; w.x = cvt_pk_bf16(o1a[0], o1a[1]); w.y = cvt_pk_bf16(o1a[2], o1a[3]); w.z = cvt_pk_bf16(o1b[0], o1b[1]); w.w = cvt_pk_bf16(o1b[2], o1b[3]);
                        __builtin_nontemporal_store(w, (u32x4*)r1);
                        w.x = cvt_pk_bf16(o2a[0], o2a[1]); w.y = cvt_pk_bf16(o2a[2], o2a[3]); w.z = cvt_pk_bf16(o2b[0], o2b[1]); w.w = cvt_pk_bf16(o2b[2], o2b[3]);
                        __builtin_nontemporal_store(w, (u32x4*)r2);
                    }
        }
    }
};
struct OutSched {
    const char* Y; const char* WOT; int c, G;
    DI bool next(int i, pg8::Unit& u) const {
        const long L = (long)i * G + c; if (L >= 512) return false;
        u.pm = (int)(L >> 2); u.pn = (int)(L & 3); return true;
    }
    DI const char* aptr(const pg8::Unit& u) const { return Y + (size_t)u.pm * (256 * 1024 * 2); }
    DI const char* bptr(const pg8::Unit& u) const { return WOT + (size_t)u.pn * (256 * 1024 * 2); }
};
struct EpiOutF {
    static constexpr bool PERM = false;
    const float* x; const float* MOD; const float* gfin; float* out; float* xbuf; unsigned* cnt; LAS unsigned char* scr;
    DI void operator()(f32x4 (&acc)[2][2][4][2], const pg8::Unit& u, int wr, int wc, int fr_, int fq_) const {
        int fr = fr_, fq = fq_, tid = threadIdx.x;
        asm volatile("" : "+v"(fr), "+v"(fq), "+v"(tid));
        const int b = u.pm >> 3;
        const int col0 = u.pn * 256 + wc * 32 + 4 * fq;
        LAS float* P4s = (LAS float*)scr;
        LAS float* S = (LAS float*)(scr + 4096);
        f32x4 gt[2][2];
#pragma unroll
        for (int bj = 0; bj < 2; ++bj)
#pragma unroll
            for (int n = 0; n < 2; ++n) gt[bj][n] = *(const f32x4*)(MOD + b * 3072 + 2048 + col0 + bj * 128 + n * 16);
        int lane = fr + 16 * fq; const int rr = lane >> 3, pz = lane & 7;
        LAS unsigned char* tb = scr + 5120 + (wr * 4 + wc) * 2304;
        f32x4 xv[3][2][2];
        const float* xg = x + (size_t)(u.pm * 256 + wr * 64 + rr) * DM + u.pn * 256 + wc * 32 + pz * 4;
#define EPF_LOADX(B, ai_, m_) do { _Pragma("unroll") for (int bj = 0; bj < 2; ++bj) _Pragma("unroll") for (int k = 0; k < 2; ++k) \
            xv[B][bj][k] = *(const f32x4*)(xg + (size_t)((ai_) * 128 + (m_) * 16 + 8 * k) * DM + bj * 128); } while (0)
        EPF_LOADX(0, 0, 0); EPF_LOADX(1, 0, 1);
#pragma unroll
        for (int im = 0; im < 8; ++im) {
            const int ai = im >> 2, m = im & 3;
            if (im + 2 < 8) EPF_LOADX((im + 2) % 3, (im + 2) >> 2, (im + 2) & 3);
            __builtin_amdgcn_sched_barrier(0);
            float q0 = 0.f, q1 = 0.f; f32x4 uu[2];
#pragma unroll
            for (int bj = 0; bj < 2; ++bj) {
#pragma unroll
                for (int n = 0; n < 2; ++n) *(LAS f32x4*)(tb + fr * 144 + (16 * n + 4 * fq) * 4) = gt[bj][n] * acc[ai][bj][m][n];
#pragma unroll
                for (int k = 0; k < 2; ++k) {
                    const f32x4 t = *(const LAS f32x4*)(tb + (rr + 8 * k) * 144 + pz * 16);
                    const f32x4 v = xv[im % 3][bj][k] + t;
                    const float d = (v[0] * v[0] + v[1] * v[1]) + (v[2] * v[2] + v[3] * v[3]);
                    if (k == 0) q0 += d; else q1 += d;
                    uu[k] = v;
                }
                acc[ai][bj][m][0] = uu[0]; acc[ai][bj][m][1] = uu[1];
            }
            q0 += __shfl_xor(q0, 1); q1 += __shfl_xor(q1, 1); q0 += __shfl_xor(q0, 2); q1 += __shfl_xor(q1, 2); q0 += __shfl_xor(q0, 4); q1 += __shfl_xor(q1, 4);
            if (pz == 0) { P4s[(ai * 128 + wr * 64 + m * 16 + rr) * 4 + wc] = q0; P4s[(ai * 128 + wr * 64 + m * 16 + rr + 8) * 4 + wc] = q1; }
            __builtin_amdgcn_sched_barrier(0);
        }
#undef EPF_LOADX
        asm volatile("s_waitcnt lgkmcnt(0)" ::: "memory"); __builtin_amdgcn_s_barrier(); asm volatile("" ::: "memory");
        float* slot = xbuf + ((size_t)u.pm * 256) * 4;
        unsigned* pc = cnt + 64 * u.pm;
        if (tid < 256) {
            const float t = (P4s[tid * 4 + 0] + P4s[tid * 4 + 1]) + (P4s[tid * 4 + 2] + P4s[tid * 4 + 3]);
            __hip_atomic_store(slot + tid * 4 + u.pn, t, __ATOMIC_RELAXED, __HIP_MEMORY_SCOPE_AGENT);
            asm volatile("s_waitcnt vmcnt(0)" ::: "memory");
            if ((tid & 63) == 0) __hip_atomic_fetch_add(pc, 1u, __ATOMIC_RELAXED, __HIP_MEMORY_SCOPE_AGENT);
        }
        if (tid < 64) {
            unsigned sp = 0;
            while ((unsigned)__builtin_amdgcn_readfirstlane(__hip_atomic_load(pc, __ATOMIC_RELAXED, __HIP_MEMORY_SCOPE_AGENT)) < 16u) {
                __builtin_amdgcn_s_sleep(2); if (++sp > (1u << 20)) break; }
            __builtin_amdgcn_fence(__ATOMIC_ACQUIRE, "agent");
        }
        asm volatile("s_waitcnt vmcnt(0) lgkmcnt(0)" ::: "memory"); __builtin_amdgcn_s_barrier(); asm volatile("" ::: "memory");
        if (tid < 256) {
            float tot = 0.f;
#pragma unroll
            for (int t = 0; t < 4; ++t) tot += __hip_atomic_load(slot + tid * 4 + t, __ATOMIC_RELAXED, __HIP_MEMORY_SCOPE_AGENT);
            S[tid] = rsqrtf(tot * (1.f / DM) + EPSN);
        }
        asm volatile("s_waitcnt lgkmcnt(0)" ::: "memory"); __builtin_amdgcn_s_barrier(); asm volatile("" ::: "memory");
        f32x4 gf[2];
#pragma unroll
        for (int bj = 0; bj < 2; ++bj) gf[bj] = *(const f32x4*)(gfin + u.pn * 256 + bj * 128 + wc * 32 + pz * 4);
#pragma unroll
        for (int ai = 0; ai < 2; ++ai)
#pragma unroll
            for (int m = 0; m < 4; ++m)
#pragma unroll
                for (int k = 0; k < 2; ++k) {
                    const int r = ai * 128 + wr * 64 + m * 16 + rr + 8 * k; const float rs = S[r];
                    float* orow = out + (size_t)(u.pm * 256 + r) * DM + u.pn * 256 + wc * 32 + pz * 4;
#pragma unroll
                    for (int bj = 0; bj < 2; ++bj) *(f32x4*)(orow + bj * 128) = acc[ai][bj][m][k] * rs * gf[bj];
                }
        asm volatile("s_waitcnt lgkmcnt(0)" ::: "memory"); __builtin_amdgcn_s_barrier(); asm volatile("" ::: "memory");
    }
};

DI void wt_src(int np, int& src, float& sc) {
    const int vn = np >> 8; sc = 1.f;
    if (vn < 2) { src = np; sc = 0.125f * LOG2E; }
    else if (vn < 4) { src = np; }
    else if (vn < 6) { src = 1536 + (np - 1024); }
    else if (vn < 10) { const int hl = (np - 1536) & 511, head = hl >> 7, p = hl & 127, half = (p >> 2) & 1, i = 4 * (p >> 3) + (p & 3);
        src = (vn < 8 ? 2048 : 2560) + head * 128 + 64 * half + i; if (vn >= 8) sc = KSCALE; }
    else if (vn < 12) { src = 3584 + (np - 2560); }
    else if (vn < 14) { src = 1024 + (np - 3072); }
    else if (vn < 16) { const int hl = np - 3584, head = hl >> 7, p = hl & 127, half = (p >> 4) & 1, i = 16 * (p >> 5) + (p & 15);
        src = 2560 + head * 128 + 64 * half + i; sc = KSCALE; }
    else { src = 3072 + (np - 4096); }
}
DI void p0_transpose_item(const float* W, int N, bool is_in, bf16_t* WT, LAS float* scr, int item, int lane) {
    const int nblk = is_in ? (NWT / 32) : 32, kb = item / nblk, nb = item % nblk, k0 = 64 * kb, n0 = 32 * nb;
    int src; float sc;
    if (is_in) wt_src(n0 + (lane & 31), src, sc); else { src = n0 + (lane & 31); sc = 1.f; }
#pragma unroll 8
    for (int i = 0; i < 32; ++i) { const int kk = 2 * i + (lane >> 5); scr[kk * 33 + (lane & 31)] = W[(size_t)(k0 + kk) * N + src] * sc; }
    asm volatile("s_waitcnt lgkmcnt(0)" ::: "memory");
    const int c = lane & 7;
#pragma unroll
    for (int j = 0; j < 4; ++j) { const int n = (lane >> 3) + 8 * j; const LAS float* s = scr + (8 * c) * 33 + n;
        u32x4 o; o.x = cvt_pk_bf16(s[0 * 33], s[1 * 33]); o.y = cvt_pk_bf16(s[2 * 33], s[3 * 33]); o.z = cvt_pk_bf16(s[4 * 33], s[5 * 33]); o.w = cvt_pk_bf16(s[6 * 33], s[7 * 33]);
        *(u32x4*)(WT + (size_t)(n0 + n) * 1024 + k0 + 8 * c) = o; }
    asm volatile("s_waitcnt lgkmcnt(0)" ::: "memory");
}
DI void p0_gemv_item(const Params& p, float* MODP, LAS float* scr, int item, int lane) {
    const int q = item / 48, cgp = item % 48, col = cgp * 64 + lane;
    float acc[17];
#pragma unroll
    for (int bb = 0; bb < 17; ++bb) acc[bb] = 0.f;
    for (int kc = 0; kc < 4; ++kc) {
        const int kbase = q * 64 + kc * 16;
#pragma unroll
        for (int u = 0; u < 5; ++u) { const int idx = lane + 64 * u;
            if (idx < 272) { const int kk = idx / 17, bb = idx - kk * 17; const float v = bb < 16 ? p.c[bb * 1024 + kbase + kk] : p.c_ctx[kbase + kk]; scr[idx] = silu_f(v); } }
        asm volatile("s_waitcnt lgkmcnt(0)" ::: "memory");
        float wv[16];
#pragma unroll
        for (int kk = 0; kk < 16; ++kk) wv[kk] = p.w_ada[(size_t)(kbase + kk) * 3072 + col];
#pragma unroll
        for (int kk = 0; kk < 16; ++kk) {
#pragma unroll
            for (int bb = 0; bb < 17; ++bb) acc[bb] += scr[kk * 17 + bb] * wv[kk]; }
        asm volatile("s_waitcnt lgkmcnt(0)" ::: "memory");
    }
#pragma unroll
    for (int bb = 0; bb < 17; ++bb) MODP[(q * 17 + bb) * 3072 + col] = acc[bb];
}
DI void phase_p0(const Params& p, LAS unsigned char* lds, int vb, int G) {
    const int tid = threadIdx.x, lane = tid & 63, wave = tid >> 6;
    LAS float* scr = (LAS float*)(lds + wave * 16384);
    const int gw = vb * 8 + wave, NGW = G * 8;
    bf16_t* WT = (bf16_t*)(p.ws + WS_WT); bf16_t* WOT = (bf16_t*)(p.ws + WS_WOT); float* MODP = (float*)(p.ws + WS_MODP);
    constexpr int I_GEMV = 768, I_IN = 16 * (NWT / 32), I_OUT = 16 * 32;
    for (int it = gw; it < I_GEMV + I_IN + I_OUT; it += NGW) {
        if (it < I_GEMV) p0_gemv_item(p, MODP, scr, it, lane);
        else if (it < I_GEMV + I_IN) p0_transpose_item(p.w_in, 4096, true, WT, scr, it - I_GEMV, lane);
        else p0_transpose_item(p.w_out, 1024, false, WOT, scr, it - I_GEMV - I_IN, lane);
    }
    float* COS = (float*)(p.ws + WS_COS); float* SIN = (float*)(p.ws + WS_SIN); float* COST = (float*)(p.ws + WS_COST); float* SINT = (float*)(p.ws + WS_SINT);
    for (int idx = vb * 512 + tid; idx < 2048 * 64; idx += G * 512) {
        const int t = idx >> 6, i = idx & 63, f = i & 31; const float pos = (float)((i < 32) ? (t >> 6) : (t & 63));
        const float inv = exp2f(-(float)f * (13.287712379549449f / 32.f));
        const float ang = pos * inv; const float cs = __cosf(ang), sn = __sinf(ang);
        COS[idx] = cs; SIN[idx] = sn; COST[i * 2048 + t] = cs; SINT[i * 2048 + t] = sn;
    }
}
DI void norm_rows(const Params& p, const float* src, bf16_t* dst, int nrows, int bmod, int lane) {
    const float* MODP = (const float*)(p.ws + WS_MODP);
    f32x4 mul[4], sh[4];
#pragma unroll
    for (int j = 0; j < 4; ++j) { const int col = 4 * lane + 256 * j;
        f32x4 s = *(const f32x4*)(p.b_ada + col), sc = *(const f32x4*)(p.b_ada + 1024 + col);
#pragma unroll 2
        for (int q = 0; q < 16; ++q) { s += *(const f32x4*)(MODP + (q * 17 + bmod) * 3072 + col); sc += *(const f32x4*)(MODP + (q * 17 + bmod) * 3072 + 1024 + col); }
        sh[j] = s; mul[j] = *(const f32x4*)(p.norm_g + col) * (sc + 1.0f); }
    for (int r = 0; r < nrows; r += 2) {
        const f32x4* xr = (const f32x4*)(src + (size_t)r * DM) + lane;
        f32x4 v[2][4]; float sq[2];
#pragma unroll
        for (int q = 0; q < 2; ++q)
#pragma unroll
            for (int j = 0; j < 4; ++j) v[q][j] = xr[q * 256 + 64 * j];
#pragma unroll
        for (int q = 0; q < 2; ++q) { float s = 0.f;
#pragma unroll
            for (int j = 0; j < 4; ++j) s += (v[q][j].x * v[q][j].x + v[q][j].y * v[q][j].y) + (v[q][j].z * v[q][j].z + v[q][j].w * v[q][j].w);
            sq[q] = s; }
#pragma unroll
        for (int o = 1; o < 64; o <<= 1) { sq[0] += __shfl_xor(sq[0], o); sq[1] += __shfl_xor(sq[1], o); }
#pragma unroll
        for (int q = 0; q < 2; ++q) { const float rstd = rsqrtf(sq[q] * (1.f / DM) + EPSN);
            u32x2* o8 = (u32x2*)(dst + (size_t)(r + q) * DM) + lane;
#pragma unroll
            for (int j = 0; j < 4; ++j) { const f32x4 h = v[q][j] * rstd * mul[j] + sh[j]; u32x2 w; w.x = cvt_pk_bf16(h.x, h.y); w.y = cvt_pk_bf16(h.z, h.w); o8[64 * j] = w; } }
    }
}
DI void phase_p0b(const Params& p, int vb, int G) {
    const int tid = threadIdx.x, lane = tid & 63, wave = tid >> 6;
    const int gw = vb * 8 + wave, NGW = G * 8;
    bf16_t* XN = (bf16_t*)(p.ws + WS_XN);
    for (int wv = gw; wv < 2048; wv += NGW) {
        const int b = wv >> 7, r0 = b * 2048 + (wv & 127) * 16;
        norm_rows(p, p.x + (size_t)r0 * DM, XN + (size_t)r0 * DM, 16, b, lane);
    }
    for (int wv = gw; wv < 2048; wv += NGW)
        norm_rows(p, p.ctx + (size_t)(wv * 2) * DM, XN + (size_t)(MLAT + wv * 2) * DM, 2, 16, lane);
    const float* MODP = (const float*)(p.ws + WS_MODP); float* MOD = (float*)(p.ws + WS_MOD);
    for (int idx = vb * 512 + tid; idx < 17 * 3072; idx += G * 512) {
        const int col = idx % 3072;
        float a = p.b_ada[col];
#pragma unroll
        for (int q = 0; q < 16; ++q) a += MODP[q * 17 * 3072 + idx];
        MOD[idx] = a;
    }
}

DI void ret_state_item(const Params& p, int item) {
    const int lane = threadIdx.x & 63, wave = __builtin_amdgcn_readfirstlane(threadIdx.x >> 6);
    const int dvq = item & 3, h = (item >> 2) & 3, b = item >> 4;
    const int dir = wave & 1, mt = wave >> 1, c = lane & 15, g = lane >> 4;
    const bf16_t* PT = (const bf16_t*)(p.ws + WS_PT);
    bf16_t* SO = (bf16_t*)(p.ws + (dir ? WS_SB : WS_SF)) + (size_t)((b * 4 + h) * 16) * 16384;
    const float lg2 = -__expf(dir ? p.dec_b[h] : p.dec_f[h]) * LOG2E;
    float w8[8];
#pragma unroll
    for (int j = 0; j < 8; ++j) w8[j] = ex2(lg2 * (float)(dir ? (8 * g + j) : (31 - 8 * g - j)));
    const float g32 = ex2(lg2 * 32.f);
    const unsigned loff = (unsigned)((g * 1024 + c) * 16);
    const char* RT = (const char*)(p.ws + WS_RT);
    const char* abase = RT + (size_t)(h * 128 + 32 * mt) * 16;
    const char* bbase = RT + (size_t)(512 + h * 128 + 32 * dvq) * 16;
    const int ctxb = MLAT + b * CTXL, latb = b * SEQ;
    f32x4 acc[2][2];
#pragma unroll
    for (int at = 0; at < 2; ++at)
#pragma unroll
        for (int nt = 0; nt < 2; ++nt) acc[at][nt] = (f32x4){0.f, 0.f, 0.f, 0.f};
    bf16x8 fa[2][2][4], fb[2][2][4];
#define RS_TOK(i) (dir ? ((i) < 2 ? ctxb + 128 * (1 - (i)) : latb + 128 * (17 - (i))) : ((i) < 2 ? ctxb + 128 * (i) : latb + 128 * ((i) - 2)))
#define RS_LOAD(B, i) do { const int tb_ = RS_TOK(i); _Pragma("unroll") for (int ks = 0; ks < 4; ++ks) { \
        const size_t to_ = (size_t)((tb_ >> 3) + 4 * ks) * 16384; \
        fa[B][0][ks] = ldg8u((const bf16_t*)(abase + to_), loff); fa[B][1][ks] = ldg8u((const bf16_t*)(abase + to_ + 256), loff); \
        fb[B][0][ks] = ldg8u((const bf16_t*)(bbase + to_), loff); fb[B][1][ks] = ldg8u((const bf16_t*)(bbase + to_ + 256), loff); } } while (0)
#define RS_STORE(i) do { const int n_ = dir ? 17 - (i) : (i) - 2; bf16_t* so_ = SO + (size_t)n_ * 16384; \
        _Pragma("unroll") for (int at = 0; at < 2; ++at) _Pragma("unroll") for (int nt = 0; nt < 2; ++nt) { \
            u32x2 w_; w_.x = cvt_pk_bf16(acc[at][nt][0], acc[at][nt][1]); w_.y = cvt_pk_bf16(acc[at][nt][2], acc[at][nt][3]); \
            *(u32x2*)(so_ + (32 * dvq + 16 * nt + c) * 128 + 32 * mt + 8 * g + 4 * at) = w_; } } while (0)
#define RS_COMPUTE(B) do { _Pragma("unroll") for (int kk = 0; kk < 4; ++kk) { const int ks = dir ? 3 - kk : kk; \
        _Pragma("unroll") for (int at = 0; at < 2; ++at) _Pragma("unroll") for (int nt = 0; nt < 2; ++nt) acc[at][nt] *= g32; \
        _Pragma("unroll") for (int at = 0; at < 2; ++at) { \
            const u32x4 w_ = __builtin_bit_cast(u32x4, fa[B][at][ks]); u32x4 o_; \
            o_.x = cvt_pk_bf16(bflo(w_.x) * w8[0], bfhi(w_.x) * w8[1]); o_.y = cvt_pk_bf16(bflo(w_.y) * w8[2], bfhi(w_.y) * w8[3]); \
            o_.z = cvt_pk_bf16(bflo(w_.z) * w8[4], bfhi(w_.z) * w8[5]); o_.w = cvt_pk_bf16(bflo(w_.w) * w8[6], bfhi(w_.w) * w8[7]); \
            const bf16x8 aw_ = __builtin_bit_cast(bf16x8, o_); \
            acc[at][0] = mfma16(aw_, fb[B][0][ks], acc[at][0]); acc[at][1] = mfma16(aw_, fb[B][1][ks], acc[at][1]); } } } while (0)
    RS_LOAD(0, 0); __builtin_amdgcn_sched_barrier(0);
    for (int i = 0; i < 18; i += 2) {
        if (i + 1 < 17) RS_LOAD(1, i + 1);
        __builtin_amdgcn_sched_barrier(0);
        if (i >= 2) RS_STORE(i);
        if (i < 17) RS_COMPUTE(0);
        if (i + 2 < 17) RS_LOAD(0, i + 2);
        __builtin_amdgcn_sched_barrier(0);
        if (i + 1 >= 2) RS_STORE(i + 1);
        if (i + 1 < 17) RS_COMPUTE(1);
    }
#undef RS_TOK
#undef RS_LOAD
#undef RS_STORE
#undef RS_COMPUTE
}

template <bool LOCAL>
DI void na_step1(const bf16x8 (&kf)[2][2], const bf16x8 (&vf)[4], const bf16x8 (&qf)[2], f32x4 (&O)[4], float& mrun, float& lrun,
                 const LAS float* bp, const f32x4 (&madd)[2]) {
    f32x4 s[2];
    if (LOCAL) {
#pragma unroll
        for (int tau = 0; tau < 2; ++tau) {
            float b0 = bp[4 * tau], b1 = bp[4 * tau + 1], b2 = bp[4 * tau + 2], b3 = bp[4 * tau + 3];
            asm volatile("" : "+v"(b0), "+v"(b1), "+v"(b2), "+v"(b3));
            s[tau] = (f32x4){b0, b1, b2, b3} + madd[tau];
        }
    } else { s[0] = (f32x4){0.f, 0.f, 0.f, 0.f}; s[1] = s[0]; }
#pragma unroll
    for (int tau = 0; tau < 2; ++tau) { s[tau] = mfma16(kf[tau][0], qf[0], s[tau]); s[tau] = mfma16(kf[tau][1], qf[1], s[tau]); }
    float mx = fmaxf(fmaxf(fmaxf(s[0][0], s[0][1]), fmaxf(s[0][2], s[0][3])), fmaxf(fmaxf(s[1][0], s[1][1]), fmaxf(s[1][2], s[1][3])));
    mx = fmaxf(mx, __shfl_xor(mx, 16)); mx = fmaxf(mx, __shfl_xor(mx, 32));
    const float mnew = fmaxf(mrun, mx), alpha = ex2(mrun - mnew);
    mrun = mnew;
    float ps = 0.f;
#pragma unroll
    for (int tau = 0; tau < 2; ++tau)
#pragma unroll
        for (int e = 0; e < 4; ++e) { s[tau][e] = ex2(s[tau][e] - mnew); ps += s[tau][e]; }
    lrun = lrun * alpha + ps;
    u32x4 pw; pw.x = cvt_pk_bf16(s[0][0], s[0][1]); pw.y = cvt_pk_bf16(s[0][2], s[0][3]); pw.z = cvt_pk_bf16(s[1][0], s[1][1]); pw.w = cvt_pk_bf16(s[1][2], s[1][3]);
    const bf16x8 pf = __builtin_bit_cast(bf16x8, pw);
#pragma unroll
    for (int dt = 0; dt < 4; ++dt) { O[dt] *= alpha; O[dt] = mfma16(vf[dt], pf, O[dt]); }
}
DI void na_step2(const bf16x8 (&kf)[2][2], const bf16x8 (&vf)[4], const bf16x8 (&kc)[2][2], const bf16x8 (&vc)[4], const bf16x8 (&qf)[2], f32x4 (&O)[4], float& mrun, float& lrun,
                 const LAS float* bp, const f32x4 (&madd)[2]) {
    f32x4 s[4];
#pragma unroll
    for (int tau = 0; tau < 2; ++tau) {
        float b0 = bp[4 * tau], b1 = bp[4 * tau + 1], b2 = bp[4 * tau + 2], b3 = bp[4 * tau + 3];
        asm volatile("" : "+v"(b0), "+v"(b1), "+v"(b2), "+v"(b3));
        s[tau] = (f32x4){b0, b1, b2, b3} + madd[tau];
        s[2 + tau] = (f32x4){0.f, 0.f, 0.f, 0.f};
    }
#pragma unroll
    for (int tau = 0; tau < 2; ++tau) { s[tau] = mfma16(kf[tau][0], qf[0], s[tau]); s[2 + tau] = mfma16(kc[tau][0], qf[0], s[2 + tau]); }
#pragma unroll
    for (int tau = 0; tau < 2; ++tau) { s[tau] = mfma16(kf[tau][1], qf[1], s[tau]); s[2 + tau] = mfma16(kc[tau][1], qf[1], s[2 + tau]); }
    float mx = fmaxf(fmaxf(fmaxf(s[0][0], s[0][1]), fmaxf(s[0][2], s[0][3])), fmaxf(fmaxf(s[1][0], s[1][1]), fmaxf(s[1][2], s[1][3])));
    mx = fmaxf(mx, fmaxf(fmaxf(fmaxf(s[2][0], s[2][1]), fmaxf(s[2][2], s[2][3])), fmaxf(fmaxf(s[3][0], s[3][1]), fmaxf(s[3][2], s[3][3]))));
    mx = fmaxf(mx, __shfl_xor(mx, 16)); mx = fmaxf(mx, __shfl_xor(mx, 32));
    const float mnew = fmaxf(mrun, mx), alpha = ex2(mrun - mnew);
    mrun = mnew;
    float ps = 0.f;
#pragma unroll
    for (int t = 0; t < 4; ++t)
#pragma unroll
        for (int e = 0; e < 4; ++e) { s[t][e] = ex2(s[t][e] - mnew); ps += s[t][e]; }
    lrun = lrun * alpha + ps;
    u32x4 pw; pw.x = cvt_pk_bf16(s[0][0], s[0][1]); pw.y = cvt_pk_bf16(s[0][2], s[0][3]); pw.z = cvt_pk_bf16(s[1][0], s[1][1]); pw.w = cvt_pk_bf16(s[1][2], s[1][3]);
    const bf16x8 pfl = __builtin_bit_cast(bf16x8, pw);
    pw.x = cvt_pk_bf16(s[2][0], s[2][1]); pw.y = cvt_pk_bf16(s[2][2], s[2][3]); pw.z = cvt_pk_bf16(s[3][0], s[3][1]); pw.w = cvt_pk_bf16(s[3][2], s[3][3]);
    const bf16x8 pfc = __builtin_bit_cast(bf16x8, pw);
#pragma unroll
    for (int dt = 0; dt < 4; ++dt) { O[dt] *= alpha; O[dt] = mfma16(vf[dt], pfl, O[dt]); O[dt] = mfma16(vc[dt], pfc, O[dt]); }
}
DI void na_item(const Params& p, LAS unsigned char* lds, int item) {
    const int tid = threadIdx.x, lane = tid & 63, wave = __builtin_amdgcn_readfirstlane(tid >> 6);
    const int half = item & 1, h = (item >> 1) & 7, b = item >> 4;
    const int j = wave & 3, rr = wave >> 2, c = lane & 15, g = lane >> 4;
    const bf16_t* P = (const bf16_t*)(p.ws + WS_P); const char* KT = (const char*)(p.ws + WS_KT); const char* VT = (const char*)(p.ws + WS_VT);
    bf16_t* Y = (bf16_t*)(p.ws + WS_Y);
    LAS float* rpb = (LAS float*)lds;
    LAS unsigned char* Kc = lds + 4096;
    LAS unsigned char* Vc = lds + 4096 + 32768;
    __syncthreads();
    for (int idx = tid; idx < 15 * 64; idx += 512) { const int dr = idx >> 6, xx = (idx & 63) - 16;
        rpb[idx] = (xx >= 0 && xx < 31) ? p.na_rpb[(h * 15 + dr) * 31 + xx] * LOG2E : 0.f; }
#pragma unroll
    for (int i = 0; i < 4; ++i) { const int idx = tid + 512 * i, blk = idx >> 6, q = idx & 63;
        const size_t tb = (size_t)(((MLAT + b * CTXL) >> 3) + blk) * 8 + h;
        { const int row = blk * 8 + (q & 7), pc = (q >> 5) * 4 + ((q >> 3) & 3);
          *(LAS bf16x8*)(Kc + row * 128 + ((pc ^ (((row >> 1) & 1) | (((row >> 3) & 3) << 1))) << 4)) = *(const bf16x8*)(KT + tb * 1024 + q * 16); }
        { const int row = q, pc = blk;
          *(LAS bf16x8*)(Vc + row * 512 + ((pc ^ (row & 15)) << 4)) = *(const bf16x8*)(VT + tb * 1024 + q * 16); } }
    __syncthreads();
    const int cw0 = (j == 0) ? 0 : (j == 1) ? 8 : (j == 2) ? 24 : 32;
    const int kap0 = 8 * (c >> 2) + (c & 3);
    const int cq = 16 * j + c; int c0 = cq - 8; c0 = c0 < 0 ? 0 : (c0 > 48 ? 48 : c0);
    const LAS float* rpbl = rpb + 16 + (cw0 + 8 * g - cq + 15);
    f32x4 madd[2];
#pragma unroll
    for (int tau = 0; tau < 2; ++tau)
#pragma unroll
        for (int e = 0; e < 4; ++e) { const int ck = cw0 + 8 * g + 4 * tau + e; madd[tau][e] = (ck >= c0 && ck < c0 + 16) ? 0.f : -INFINITY; }
    const unsigned klo = (unsigned)((c >> 2) * 8192 + (g * 8 + (c & 3)) * 16), vlo = (unsigned)(g * 8192 + c * 16);
    const unsigned kcb = (unsigned)(kap0 * 128), vcb = (unsigned)(c * 512);
    unsigned kx[2]; kx[0] = (unsigned)(((g) ^ (c >> 1)) << 4); kx[1] = (unsigned)(((4 + g) ^ (c >> 1)) << 4);
    for (int ui = 0; ui < 8; ++ui) {
        const int rp = 8 * half + ui, r = 2 * rp + rr;
        int r0 = r - 4; r0 = r0 < 0 ? 0 : (r0 > 24 ? 24 : r0);
        const size_t tok = (size_t)(b * SEQ + r * 64 + 16 * j + c);
        bf16x8 qf[2];
#pragma unroll
        for (int ks = 0; ks < 2; ++ks) qf[ks] = ldg8(P + tok * LDP + PC_NAQ + h * 64 + 32 * ks + 8 * g);
        f32x4 O[4]; float mrun = -1e30f, lrun = 0.f;
#pragma unroll
        for (int dt = 0; dt < 4; ++dt) O[dt] = (f32x4){0.f, 0.f, 0.f, 0.f};
        const size_t tb0 = (size_t)(((b * SEQ + r0 * 64 + cw0) >> 3) * 8 + h) * 1024;
        const char* kb0 = KT + tb0; const char* vb0 = VT + tb0;
        const LAS float* bp0 = rpbl + (r0 - r + 7) * 64;
        bf16x8 kf[2][2][2], vf[2][4], kc[2][2], vc[4];
#define NA_LOADL(B, st) do { _Pragma("unroll") for (int tau = 0; tau < 2; ++tau) _Pragma("unroll") for (int ks = 0; ks < 2; ++ks) \
            kf[B][tau][ks] = ldg8u((const bf16_t*)(kb0 + (size_t)(st) * 65536 + ks * 512 + tau * 64), klo); \
            _Pragma("unroll") for (int dt = 0; dt < 4; ++dt) vf[B][dt] = ldg8u((const bf16_t*)(vb0 + (size_t)(st) * 65536 + dt * 256), vlo); } while (0)
#define NA_LOADC(st) do { _Pragma("unroll") for (int tau = 0; tau < 2; ++tau) _Pragma("unroll") for (int ks = 0; ks < 2; ++ks) \
            kc[tau][ks] = *(const LAS bf16x8*)(Kc + kcb + kx[ks] + (32 * (st) + 4 * tau) * 128); \
            { unsigned va_ = vcb + (unsigned)((((4 * (st) + g) ^ c)) << 4); _Pragma("unroll") for (int dt = 0; dt < 4; ++dt) vc[dt] = *(const LAS bf16x8*)(Vc + va_ + (16 * dt) * 512); } } while (0)
        NA_LOADL(0, 0); __builtin_amdgcn_sched_barrier(0);
#pragma unroll 1
        for (int st = 0; st < 8; st += 2) {
            NA_LOADL(1, st + 1); __builtin_amdgcn_sched_barrier(0);
            NA_LOADC(st);
            na_step2(kf[0], vf[0], kc, vc, qf, O, mrun, lrun, bp0 + st * 64, madd);
            if (st + 2 < 8) NA_LOADL(0, st + 2);
            __builtin_amdgcn_sched_barrier(0);
            NA_LOADC(st + 1);
            na_step2(kf[1], vf[1], kc, vc, qf, O, mrun, lrun, bp0 + (st + 1) * 64, madd);
        }
#undef NA_LOADL
#undef NA_LOADC
        lrun += __shfl_xor(lrun, 16); lrun += __shfl_xor(lrun, 32);
        const float inv = __builtin_amdgcn_rcpf(lrun);
#pragma unroll
        for (int dt = 0; dt < 4; ++dt) {
            const f32x4 o = O[dt] * inv;
            const u32x2 gw = *(const u32x2*)(P + tok * LDP + PC_NAG + h * 64 + 16 * dt + 4 * g);
            u32x2 w; w.x = cvt_pk_bf16(o[0] * silu_f(bflo(gw.x)), o[1] * silu_f(bfhi(gw.x))); w.y = cvt_pk_bf16(o[2] * silu_f(bflo(gw.y)), o[3] * silu_f(bfhi(gw.y)));
            *(u32x2*)(Y + tok * DM + h * 64 + 16 * dt + 4 * g) = w;
        }
    }
}

DI void ret_out_phase(const Params& p, LAS unsigned char* lds, int vb, int G) {
    const int tid = threadIdx.x, lane = tid & 63, wave = __builtin_amdgcn_readfirstlane(tid >> 6), c = lane & 15, g = lane >> 4;
    const bf16_t* P = (const bf16_t*)(p.ws + WS_P); const bf16_t* PT = (const bf16_t*)(p.ws + WS_PT);
    const bf16_t* SFg = (const bf16_t*)(p.ws + WS_SF); const bf16_t* SBg = (const bf16_t*)(p.ws + WS_SB); const char* RTg = (const char*)(p.ws + WS_RT);
    bf16_t* Y = (bf16_t*)(p.ws + WS_Y);
    LAS unsigned char* Ks = lds; LAS unsigned char* Vs = lds + 32768; LAS unsigned char* SFs = lds + 65536; LAS unsigned char* SBs = lds + 98304;
    const int prow = tid >> 4, pc = tid & 15;
    const unsigned wK = (unsigned)(prow * 256 + ((pc ^ ((prow & 3) | (((prow >> 3) & 3) << 2))) << 4));
    const unsigned wV = (unsigned)(prow * 256 + ((pc ^ (prow & 15)) << 4));
    unsigned xo[4];
#pragma unroll
    for (int x = 0; x < 4; ++x) xo[x] = (unsigned)((((4 * x + g) ^ c)) << 4);
    const unsigned rK = (unsigned)((8 * (c >> 2) + (c & 3)) * 256), rV = (unsigned)(c * 256);
    bf16x8 st[8];
#define RO_LOAD_KV(uu) do { const int n_ = (uu) & 15, h_ = ((uu) >> 4) & 3, b_ = (uu) >> 6; \
        const bf16_t* kp_ = P + (size_t)(b_ * SEQ + 128 * n_ + prow) * LDP + PC_RK + h_ * 128 + pc * 8; \
        const char* vp_ = RTg + ((size_t)(((b_ * SEQ + 128 * n_) >> 3) + (tid >> 7)) * 1024 + 512 + h_ * 128 + (tid & 127)) * 16; \
        _Pragma("unroll") for (int i = 0; i < 4; ++i) { st[i] = ldg8(kp_ + (size_t)(32 * i) * LDP); st[4 + i] = *(const bf16x8*)(vp_ + (size_t)(4 * i) * 16384); } } while (0)
#define RO_LOAD_S(uu) do { const int n_ = (uu) & 15, h_ = ((uu) >> 4) & 3, b_ = (uu) >> 6; \
        const size_t so_ = (size_t)((b_ * 4 + h_) * 16 + n_) * 16384 + prow * 128 + pc * 8; \
        _Pragma("unroll") for (int i = 0; i < 4; ++i) { st[i] = ldg8(SFg + so_ + (32 * i) * 128); st[4 + i] = ldg8(SBg + so_ + (32 * i) * 128); } } while (0)
#define RO_STORE_KV() do { _Pragma("unroll") for (int i = 0; i < 4; ++i) { \
        *(LAS bf16x8*)(Ks + wK + i * 8192) = st[i]; \
        *(LAS bf16x8*)(Vs + (tid & 127) * 256 + (((((tid >> 7) + 4 * i)) ^ (tid & 15)) << 4)) = st[4 + i]; } } while (0)
#define RO_STORE(A0, W0, A1, W1) do { _Pragma("unroll") for (int i = 0; i < 4; ++i) { \
        *(LAS bf16x8*)((A0) + (W0) + i * 8192) = st[i]; *(LAS bf16x8*)((A1) + (W1) + i * 8192) = st[4 + i]; } } while (0)
    int u = vb;
    if (u < 1024) RO_LOAD_KV(u);
    for (; u < 1024; u += G) {
        const int n = u & 15, h = (u >> 4) & 3, b = u >> 6;
        const int tl = 16 * wave + c;
        const size_t tok = (size_t)(b * SEQ + 128 * n + tl);
        const float lgf2 = -__expf(p.dec_f[h]) * LOG2E, lgb2 = -__expf(p.dec_b[h]) * LOG2E;
        RO_STORE_KV();
        RO_LOAD_S(u); __builtin_amdgcn_sched_barrier(0);
        bf16x8 qf[4];
#pragma unroll
        for (int ks = 0; ks < 4; ++ks) qf[ks] = ldg8(P + tok * LDP + PC_RQ + h * 128 + 32 * ks + 8 * g);
        u32x2 gwv[8];
#pragma unroll
        for (int dt = 0; dt < 8; ++dt) gwv[dt] = *(const u32x2*)(P + tok * LDP + PC_RG + h * 128 + 16 * dt + 4 * g);
        __syncthreads();
        f32x4 O[8];
#pragma unroll
        for (int dt = 0; dt < 8; ++dt) O[dt] = (f32x4){0.f, 0.f, 0.f, 0.f};
#pragma unroll
        for (int sg = 0; sg < 4; ++sg) {
            int tlv = tl - 8 * g; asm volatile("" : "+v"(tlv));
            f32x4 s_[2];
#pragma unroll
            for (int tau = 0; tau < 2; ++tau) {
                s_[tau] = (f32x4){0.f, 0.f, 0.f, 0.f};
#pragma unroll
                for (int ks = 0; ks < 4; ++ks) { unsigned a_ = rK + xo[ks]; asm volatile("" : "+v"(a_)); s_[tau] = mfma16(*(const LAS bf16x8*)(Ks + a_ + (32 * sg + 4 * tau) * 256), qf[ks], s_[tau]); }
            }
#pragma unroll
            for (int tau = 0; tau < 2; ++tau)
#pragma unroll
                for (int e = 0; e < 4; ++e) {
                    const int dl_ = tlv - (32 * sg + 4 * tau + e);
                    const float lg_ = dl_ > 0 ? lgf2 : lgb2; float d_ = ex2(lg_ * fabsf((float)dl_)); d_ = dl_ == 0 ? 2.0f : d_; s_[tau][e] *= d_; }
            u32x4 pw_; pw_.x = cvt_pk_bf16(s_[0][0], s_[0][1]); pw_.y = cvt_pk_bf16(s_[0][2], s_[0][3]); pw_.z = cvt_pk_bf16(s_[1][0], s_[1][1]); pw_.w = cvt_pk_bf16(s_[1][2], s_[1][3]);
            const bf16x8 pf = __builtin_bit_cast(bf16x8, pw_);
            unsigned av_ = 32768u + rV + xo[sg]; asm volatile("" : "+v"(av_));
#pragma unroll
            for (int dt = 0; dt < 8; ++dt) O[dt] = mfma16(*(const LAS bf16x8*)(lds + av_ + (16 * dt) * 256), pf, O[dt]);
            __builtin_amdgcn_sched_barrier(0);
        }
        RO_STORE(SFs, wV, SBs, wV);
        if (u + G < 1024) RO_LOAD_KV(u + G);
        __builtin_amdgcn_sched_barrier(0);
        __syncthreads();
        const float cF = ex2(lgf2 * (float)(tl + 1)), cB = ex2(lgb2 * (float)(128 - tl));
#pragma unroll
        for (int ks = 0; ks < 4; ++ks) {
            const bf16x8 qF_ = scale_frag(qf[ks], cF), qB_ = scale_frag(qf[ks], cB);
            unsigned af_ = 65536u + rV + xo[ks], ab_ = 98304u + rV + xo[ks]; asm volatile("" : "+v"(af_), "+v"(ab_));
#pragma unroll
            for (int dt = 0; dt < 8; ++dt) {
                O[dt] = mfma16(*(const LAS bf16x8*)(lds + af_ + (16 * dt) * 256), qF_, O[dt]);
                O[dt] = mfma16(*(const LAS bf16x8*)(lds + ab_ + (16 * dt) * 256), qB_, O[dt]);
            }
            __builtin_amdgcn_sched_barrier(0);
        }
        float ss = 0.f;
#pragma unroll
        for (int dt = 0; dt < 8; ++dt) ss += (O[dt][0] * O[dt][0] + O[dt][1] * O[dt][1]) + (O[dt][2] * O[dt][2] + O[dt][3] * O[dt][3]);
        ss += __shfl_xor(ss, 16); ss += __shfl_xor(ss, 32);
        const float rstd = rsqrtf(ss * (1.f / 128.f) + EPSN);
#pragma unroll
        for (int dt = 0; dt < 8; ++dt) {
            const int dv = 16 * dt + 4 * g;
            const f32x4 gn = *(const f32x4*)(p.ret_norm_g + h * 128 + dv);
            const u32x2 gw = gwv[dt];
            const f32x4 o = O[dt] * rstd * gn;
            u32x2 w; w.x = cvt_pk_bf16(o[0] * silu_f(bflo(gw.x)), o[1] * silu_f(bfhi(gw.x))); w.y = cvt_pk_bf16(o[2] * silu_f(bflo(gw.y)), o[3] * silu_f(bfhi(gw.y)));
            *(u32x2*)(Y + tok * DM + 512 + h * 128 + dv) = w;
        }
    }
#undef RO_LOAD_KV
#undef RO_LOAD_S
#undef RO_STORE
#undef RO_STORE_KV
}

DI void phase_p5(const Params& p, int vb, int G) {
    const int tid = threadIdx.x, lane = tid & 63, wave = tid >> 6;
    const int gw = vb * 8 + wave, NGW = G * 8;
    f32x4 gn[4];
#pragma unroll
    for (int j = 0; j < 4; ++j) gn[j] = *(const f32x4*)(p.final_g + 4 * lane + 256 * j);
    for (int grp = gw; grp < MLAT / 4; grp += NGW) {
        f32x4* xr = (f32x4*)(p.out + (size_t)grp * 4 * DM) + lane;
        f32x4 v[4][4]; float sq[4];
#pragma unroll
        for (int r = 0; r < 4; ++r)
#pragma unroll
            for (int j = 0; j < 4; ++j) v[r][j] = xr[r * 256 + 64 * j];
#pragma unroll
        for (int r = 0; r < 4; ++r) { float s = 0.f;
#pragma unroll
            for (int j = 0; j < 4; ++j) s += (v[r][j].x * v[r][j].x + v[r][j].y * v[r][j].y) + (v[r][j].z * v[r][j].z + v[r][j].w * v[r][j].w);
            sq[r] = s; }
#pragma unroll
        for (int o = 1; o < 64; o <<= 1)
#pragma unroll
            for (int r = 0; r < 4; ++r) sq[r] += __shfl_xor(sq[r], o);
#pragma unroll
        for (int r = 0; r < 4; ++r) { const float rstd = rsqrtf(sq[r] * (1.f / DM) + EPSN);
#pragma unroll
            for (int j = 0; j < 4; ++j) xr[r * 256 + 64 * j] = v[r][j] * rstd * gn[j]; }
    }
}

#define XB_TMO      128
#define XB_XCNT(j)  (256  + 64 * (j))
#define XB_XSUB(j)  (1280 + 64 * (j))
#define XB_XGEN(j)  (2304 + 64 * (j))
#define XB_TOP      3328
#define XB_TOPGEN   3392
#define XCD_BAR_WORDS 3456
#define XB_SPIN_CAP (1u << 18)
DI unsigned xb_ld(unsigned* p)              { return __hip_atomic_load(p, __ATOMIC_RELAXED, __HIP_MEMORY_SCOPE_AGENT); }
DI unsigned xb_add(unsigned* p, unsigned v) { return __hip_atomic_fetch_add(p, v, __ATOMIC_RELAXED, __HIP_MEMORY_SCOPE_AGENT); }
DI unsigned xb_xcc_id() { return (unsigned)__builtin_amdgcn_s_getreg((3 << 11) | 20) & 0xFu; }
#define XB_SPIN(cond, bar) do { unsigned _sp = 0; while (cond) { __builtin_amdgcn_s_sleep(1); \
    if ((++_sp & 255u) == 0u) { if (xb_ld(&(bar)[XB_TMO])) break; if (_sp > XB_SPIN_CAP) { atomicAdd(&(bar)[XB_TMO], 1u); break; } } } } while (0)
struct XcdBarrier { unsigned* bar; unsigned x; volatile LAS unsigned* st; };
DI XcdBarrier xcd_barrier_post(unsigned* bar, volatile LAS unsigned* st) {
    XcdBarrier b; b.bar = bar; b.x = xb_xcc_id(); b.st = st;
    if (threadIdx.x == 0) (void)xb_add(&bar[XB_XCNT(b.x)], 1u);
    return b;
}
DI void xcd_barrier_complete(unsigned* bar, unsigned x, unsigned& nloc, unsigned& nx) {
    const unsigned G = gridDim.x * gridDim.y * gridDim.z;
    unsigned sum, cnt, mine, sp = 0u;
    for (;;) {
        sum = 0u; cnt = 0u; mine = 0u;
#pragma unroll
        for (unsigned j = 0; j < 16; ++j) { const unsigned c = xb_ld(&bar[XB_XCNT(j)]); sum += c; cnt += (c > 0u) ? 1u : 0u; mine = (j == x) ? c : mine; }
        if (sum == G) break;
        __builtin_amdgcn_s_sleep(1);
        if ((++sp & 255u) == 0u) { if (xb_ld(&bar[XB_TMO])) break; if (sp > XB_SPIN_CAP) { atomicAdd(&bar[XB_TMO], 1u); break; } }
    }
    nloc = mine > 0u ? mine : 1u; nx = cnt > 0u ? cnt : 1u;
}
DI void xcd_barrier(const XcdBarrier& b) {
    asm volatile("s_waitcnt vmcnt(0)" ::: "memory");
    __syncthreads();
    if (threadIdx.x == 0) {
        unsigned* bar = b.bar;
        __builtin_amdgcn_s_waitcnt(0);
        unsigned nloc = b.st[0], nx = b.st[1];
        if (nloc == 0u) { xcd_barrier_complete(bar, b.x, nloc, nx); b.st[0] = nloc; b.st[1] = nx; }
        const unsigned old = xb_add(&bar[XB_XSUB(b.x)], 1u);
        const unsigned gen = old / nloc;
        if (old + 1u == (gen + 1u) * nloc) {
            __builtin_amdgcn_fence(__ATOMIC_RELEASE, "agent");
            asm volatile("s_waitcnt vmcnt(0)" ::: "memory");
            const unsigned og = xb_add(&bar[XB_TOP], 1u);
            const unsigned tg = og / nx;
            if (og + 1u == (tg + 1u) * nx) xb_add(&bar[XB_TOPGEN], 1u);
            else XB_SPIN(xb_ld(&bar[XB_TOPGEN]) == tg, bar);
            __builtin_amdgcn_fence(__ATOMIC_ACQUIRE, "agent");
            xb_add(&bar[XB_XGEN(b.x)], 1u);
            asm volatile("s_waitcnt vmcnt(0)" ::: "memory");
        } else {
            XB_SPIN(xb_ld(&bar[XB_XGEN(b.x)]) == gen, bar);
            __builtin_amdgcn_fence(__ATOMIC_ACQUIRE, "agent");
            asm volatile("s_waitcnt vmcnt(0)" ::: "memory");
        }
    }
    __syncthreads();
}
__global__ void __launch_bounds__(512, 2) mega_fwd(Params p) {
    extern __shared__ __attribute__((aligned(16))) unsigned char lds_raw[];
    LAS unsigned char* lds = (LAS unsigned char*)lds_raw;
    const int G = gridDim.x, bx = blockIdx.x;
    const int vb = (G % 8 == 0) ? (bx % 8) * (G / 8) + bx / 8 : bx;
    const int tid = threadIdx.x;
    volatile LAS unsigned* MISC = (volatile LAS unsigned*)(lds + 131072);
    if (tid < 16) MISC[tid] = 0u;
    __syncthreads();
    (void)xcd_barrier_post((unsigned*)p.ws, MISC);
#define GRID_BAR() do { XcdBarrier b_; b_.bar = (unsigned*)p.ws; b_.x = xb_xcc_id(); b_.st = (volatile LAS unsigned*)(lds + 131072); xcd_barrier(b_); } while (0)

#ifndef REPMASK
#define REPMASK 0
#endif
#define PH_P0()  phase_p0(p, lds, vb, G)
#define PH_P0B() phase_p0b(p, vb, G)
#define PH_P1()  do { InSched S{(const char*)(p.ws + WS_XN), (const char*)(p.ws + WS_WT), bx, G}; \
        EpiIn E{(bf16_t*)(p.ws + WS_P), (bf16_t*)(p.ws + WS_KT), (bf16_t*)(p.ws + WS_PT), (const float*)(p.ws + WS_COS), (const float*)(p.ws + WS_SIN), (const float*)(p.ws + WS_COST), (const float*)(p.ws + WS_SINT), lds + 131072 + 256}; \
        pg8::gemm_phase<EpiIn, InSched>(lds, S, E); } while (0)
#define PH_R1()  do { for (int it = vb; it < 256; it += G) ret_state_item(p, it); } while (0)
#define PH_NA()  do { for (int it = vb; it < 256; it += G) na_item(p, lds, it); } while (0)
#define PH_R2()  ret_out_phase(p, lds, vb, G)
#define PH_P4()  do { OutSched S{(const char*)(p.ws + WS_Y), (const char*)(p.ws + WS_WOT), vb, G}; \
        EpiOutF E{p.x, (const float*)(p.ws + WS_MOD), p.final_g, p.out, (float*)(p.ws + WS_XBUF), (unsigned*)(p.ws + WS_CNT), lds + 131072 + 256}; \
        pg8::gemm_phase<EpiOutF, OutSched>(lds, S, E); } while (0)
    PH_P0();
#if REPMASK & 1
    PH_P0();
#endif
    GRID_BAR();
    PH_P0B();
#if REPMASK & 2
    PH_P0B();
#endif
    GRID_BAR();
    PH_P1();
#if REPMASK & 4
    PH_P1();
#endif
    GRID_BAR();
    PH_R1();
#if REPMASK & 8
    PH_R1();
#endif
    PH_NA();
#if REPMASK & 16
    PH_NA();
#endif
    GRID_BAR();
    PH_R2();
#if REPMASK & 32
    PH_R2();
#endif
    GRID_BAR();
    PH_P4();
}

extern "C" void kernel_launch(void* const* d_in, const int* in_sizes, int n_in, void* d_out, int out_size, void* d_ws, size_t ws_size, hipStream_t stream) {
    static int grid = 0;
    if (grid == 0) {
        if (n_in != 14 || out_size != MLAT * DM || ws_size < WS_END) { fprintf(stderr, "kernel_launch: unexpected shapes (n_in %d, out %d, ws %zu)\n", n_in, out_size, ws_size); grid = -1; return; }
        int dev = 0, cus = 0, per_cu = 0;
        hipGetDevice(&dev);
        hipDeviceGetAttribute(&cus, hipDeviceAttributeMultiprocessorCount, dev);
        hipFuncSetAttribute((const void*)mega_fwd, hipFuncAttributeMaxDynamicSharedMemorySize, LDS_BYTES);
        hipOccupancyMaxActiveBlocksPerMultiprocessor(&per_cu, (const void*)mega_fwd, 512, LDS_BYTES);
        if (per_cu < 1 || cus < 1) { fprintf(stderr, "kernel_launch: occupancy query says %d blocks per CU (%d CUs)\n", per_cu, cus); grid = -1; return; }
        grid = cus;
    }
    if (grid < 0) return;
    Params p{};
    p.x = (const float*)d_in[0]; p.c = (const float*)d_in[1]; p.ctx = (const float*)d_in[2]; p.c_ctx = (const float*)d_in[3];
    p.norm_g = (const float*)d_in[4]; p.w_ada = (const float*)d_in[5]; p.b_ada = (const float*)d_in[6]; p.w_in = (const float*)d_in[7];
    p.na_rpb = (const float*)d_in[8]; p.dec_f = (const float*)d_in[9]; p.dec_b = (const float*)d_in[10]; p.ret_norm_g = (const float*)d_in[11];
    p.w_out = (const float*)d_in[12]; p.final_g = (const float*)d_in[13];
    p.out = (float*)d_out; p.ws = (unsigned char*)d_ws;
    if (hipMemsetAsync(d_ws, 0, 65536, stream) != hipSuccess) { fprintf(stderr, "kernel_launch: memset of the barrier words failed\n"); return; }
    hipLaunchKernelGGL(mega_fwd, dim3(grid), dim3(512), LDS_BYTES, stream, p);
    const hipError_t e = hipPeekAtLastError();
    if (e != hipSuccess) fprintf(stderr, "launch failed: %s (grid %d)\n", hipGetErrorString(e), grid);
}
```

```cpp
#include <hip/hip_runtime.h>
#include <cstdio>
#include <cstdint>

#define DI __device__ __forceinline__
#define LAS __attribute__((address_space(3)))
typedef unsigned short bf16_t;
typedef short bf16x8 __attribute__((ext_vector_type(8)));
typedef float f32x4 __attribute__((ext_vector_type(4)));
typedef unsigned u32x4 __attribute__((ext_vector_type(4)));
typedef unsigned u32x2 __attribute__((ext_vector_type(2)));

constexpr int DM = 1024, NBATCH = 16, SEQ = 2048, CTXL = 256;
constexpr int MLAT = NBATCH * SEQ, MCTX = NBATCH * CTXL, MTOT = MLAT + MCTX;
constexpr int LDP = 2560 + 128;
constexpr int LDT = MTOT + 128;
constexpr int LDKC = 512 + 128;
constexpr int PC_NAQ = 0, PC_NAG = 512, PC_RQ = 1024, PC_RK = 1536, PC_RG = 2048;
constexpr int PT_NAV = 0, PT_RK = 512, PT_RV = 1024;
constexpr float LOG2E = 1.4426950408889634f;
constexpr float KSCALE = 0.08838834764831845f;
constexpr float EPSN = 1e-6f;
constexpr int NWT = 4608;

constexpr size_t MiB = 1u << 20;
constexpr size_t WS_WT = 2 * MiB, WS_WOT = 12 * MiB, WS_MODP = 24 * MiB  , WS_MOD = 15 * MiB;
constexpr size_t WS_CNT = 16384;
constexpr size_t WS_XBUF = 20 * MiB;
constexpr size_t WS_COS = 16 * MiB, WS_SIN = WS_COS + 512 * 1024, WS_COST = 17 * MiB, WS_SINT = WS_COST + 512 * 1024;
constexpr size_t WS_XN = 32 * MiB;
constexpr size_t WS_Y = 32 * MiB;
constexpr size_t WS_P = 104 * MiB;
constexpr size_t WS_KT = 272 * MiB;
constexpr size_t WS_PT = 310 * MiB;
constexpr size_t WS_VT = WS_PT;
constexpr size_t WS_RT = WS_PT + (size_t)512 * LDT * 2;
static_assert((size_t)MTOT * 1024 * 2 <= (size_t)1024 * LDT * 2, "RT fits the old PT rows");
constexpr size_t WS_SF = 419 * MiB, WS_SB = 451 * MiB;
constexpr size_t WS_END = 483 * MiB;
static_assert(WS_P + (size_t)MLAT * LDP * 2 <= WS_KT && WS_KT + (size_t)MTOT * 512 * 2 <= WS_PT && (size_t)MTOT * 512 * 2 <= (size_t)512 * LDT * 2 && WS_PT + (size_t)1536 * LDT * 2 <= WS_SF, "ws map");

constexpr int LDS_BYTES = 131072 + 256 + 5120 + 8 * 2304;

struct Params {
    const float *x, *c, *ctx, *c_ctx, *norm_g, *w_ada, *b_ada, *w_in, *na_rpb, *dec_f, *dec_b, *ret_norm_g, *w_out, *final_g;
    float* out; unsigned char* ws;
};

DI unsigned cvt_pk_bf16(float lo, float hi) { unsigned r; asm volatile("v_cvt_pk_bf16_f32 %0, %1, %2" : "=v"(r) : "v"(lo), "v"(hi)); return r; }
DI float bf2f(unsigned short v) { return __uint_as_float(((unsigned)v) << 16); }
DI float bflo(unsigned w) { return __uint_as_float(w << 16); }
DI float bfhi(unsigned w) { return __uint_as_float(w & 0xffff0000u); }
DI f32x4 mfma16(bf16x8 a, bf16x8 b, f32x4 c) { return __builtin_amdgcn_mfma_f32_16x16x32_bf16(a, b, c, 0, 0, 0); }
DI bf16x8 ldg8(const bf16_t* p) { return *(const bf16x8*)p; }
#define GAS __attribute__((address_space(1)))
DI bf16x8 ldg8u(const bf16_t* ub, unsigned off_bytes) {
    const GAS char* gp = (const GAS char*)ub; asm volatile("" : "+s"(gp));
    return *(const GAS bf16x8*)(gp + off_bytes); }
DI float ex2(float x) { return __builtin_amdgcn_exp2f(x); }
DI float wave_sum(float v) {
#pragma unroll
    for (int o = 1; o < 64; o <<= 1) v += __shfl_xor(v, o);
    return v;
}
DI float silu_f(float v) { return v * __builtin_amdgcn_rcpf(1.f + ex2(v * -LOG2E)); }
DI bf16x8 scale_frag(bf16x8 a, float s) {
    u32x4 w = __builtin_bit_cast(u32x4, a), o;
    o.x = cvt_pk_bf16(bflo(w.x) * s, bfhi(w.x) * s); o.y = cvt_pk_bf16(bflo(w.y) * s, bfhi(w.y) * s);
    o.z = cvt_pk_bf16(bflo(w.z) * s, bfhi(w.z) * s); o.w = cvt_pk_bf16(bflo(w.w) * s, bfhi(w.w) * s);
    return __builtin_bit_cast(bf16x8, o);
}

namespace pg8 {
constexpr int BM = 256, BK = 64, HALF = 128, HTB = HALF * BK * 2, STAGE_BYTES = 8 * HTB;
constexpr int GK = 1024;
__host__ __device__ __forceinline__ int lds_byte(int r, int c) { const int st = (r >> 4) * 2 + (c >> 5), rr = r & 15, cc = c & 31, ob = rr * 64 + cc * 2; return st * 1024 + (ob ^ (((ob >> 9) & 1) << 5)); }
__host__ __device__ __forceinline__ void stage_rc(int b, int& R, int& C) { const int st = b / 1024, sb = b % 1024, swz = sb ^ (((sb >> 9) & 1) << 5); R = (st >> 1) * 16 + swz / 64; C = (st & 1) * 32 + (swz % 64) / 2; }
__host__ __device__ __forceinline__ int perm32(int rho) { const int n = rho >> 4, i = rho & 15; return 8 * (i >> 2) + 4 * n + (i & 3); }

struct Unit { int pm, pn; };

template <class Epi, class Sched>
DI void gemm_phase(LAS unsigned char* lds, const Sched& S, const Epi& E) {
    const int tid = threadIdx.x, wid = __builtin_amdgcn_readfirstlane(tid >> 6), lane = tid & 63, wr = wid >> 2, wc = wid & 3, fr = lane & 15, fq = lane >> 4;
    constexpr int K = GK, nt = K / BK;
    unsigned voffA[2], voffB[2];
#pragma unroll
    for (int i = 0; i < 2; ++i) { int R, C; stage_rc(tid * 16 + i * 8192, R, C); const int Rb = Epi::PERM ? ((R & ~31) + perm32(R & 31)) : R;
        voffA[i] = (unsigned)(R * K + C) * 2u; voffB[i] = (unsigned)(Rb * K + C) * 2u; }
    const size_t kstep = (size_t)(BK * 2);
    const size_t hstep = (size_t)HALF * K * 2;
    const unsigned ldsw = (unsigned)wid * 1024u;
    const int aoff = lds_byte(wr * 64 + fr, fq * 8), boff = lds_byte(wc * 32 + fr, fq * 8);
#define PG8_SA(b, h) (((b) * 2 + (h)) * HTB)
#define PG8_SB(b, h) ((4 + (b) * 2 + (h)) * HTB)
#define PG8_STAGE(bufoff, gbase, voff) do { _Pragma("unroll") for (int _i = 0; _i < 2; ++_i) \
        __builtin_amdgcn_global_load_lds((const unsigned*)((const char*)(gbase) + (voff)[_i]), (LAS unsigned*)(lds + (bufoff) + ldsw + _i * 8192), 16, 0, 0); } while (0)
#define PG8_LDA(dst, b, h) do { _Pragma("unroll") for (int m = 0; m < 4; ++m) _Pragma("unroll") for (int k = 0; k < 2; ++k) dst[m][k] = *(const LAS bf16x8*)(lds + PG8_SA(b, h) + aoff + m * 2048 + k * 1024); } while (0)
#define PG8_LDB(dst, b, h) do { _Pragma("unroll") for (int n = 0; n < 2; ++n) _Pragma("unroll") for (int k = 0; k < 2; ++k) dst[n][k] = *(const LAS bf16x8*)(lds + PG8_SB(b, h) + boff + n * 2048 + k * 1024); } while (0)
#define PG8_MMA(ai, bj, At, Bt) do { __builtin_amdgcn_s_setprio(1); _Pragma("unroll") for (int m = 0; m < 4; ++m) _Pragma("unroll") for (int n = 0; n < 2; ++n) _Pragma("unroll") for (int k = 0; k < 2; ++k) \
        acc[ai][bj][m][n] = __builtin_amdgcn_mfma_f32_16x16x32_bf16(Bt[n][k], At[m][k], acc[ai][bj][m][n], 0, 0, 0); __builtin_amdgcn_s_setprio(0); } while (0)
#define PG8_WAIT_V(n) asm volatile("s_waitcnt vmcnt(" #n ")" ::: "memory")
#define PG8_WAIT_L(n) asm volatile("s_waitcnt lgkmcnt(" #n ")" ::: "memory")
#define PG8_BAR __builtin_amdgcn_s_barrier()
#define PG8_SCHED __builtin_amdgcn_sched_barrier(0)
    Unit cur, nxt; int ui = 0;
    if (!S.next(0, cur)) return;
    f32x4 acc[2][2][4][2];
#pragma unroll
    for (int a = 0; a < 2; ++a)
#pragma unroll
        for (int b = 0; b < 2; ++b)
#pragma unroll
            for (int m = 0; m < 4; ++m)
#pragma unroll
                for (int n = 0; n < 2; ++n) acc[a][b][m][n] = (f32x4){0.f, 0.f, 0.f, 0.f};
    bf16x8 At[4][2], B0[2][2], B1[2][2];
    const char* cA = S.aptr(cur); const char* cB = S.bptr(cur);
    PG8_STAGE(PG8_SB(0, 0), cB, voffB); PG8_STAGE(PG8_SB(0, 1), cB + hstep, voffB); PG8_STAGE(PG8_SA(0, 0), cA, voffA); PG8_STAGE(PG8_SA(0, 1), cA + hstep, voffA);
    if (wr == 1) PG8_BAR;
    PG8_WAIT_V(2); PG8_BAR;
    PG8_STAGE(PG8_SB(1, 0), cB + kstep, voffB); PG8_STAGE(PG8_SA(1, 0), cA + kstep, voffA); PG8_STAGE(PG8_SB(1, 1), cB + hstep + kstep, voffB);
    PG8_WAIT_V(6); PG8_BAR;
    for (;;) {
        const bool has_next = S.next(ui + 1, nxt);
        const char* nA = has_next ? S.aptr(nxt) : cA; const char* nB = has_next ? S.bptr(nxt) : cB;
        for (int t = 0; t < nt; t += 2) {
            const bool last = (t == nt - 2);
            const char* a1 = cA + (size_t)(t + 1) * kstep;
            const char* a2 = last ? nA : cA + (size_t)(t + 2) * kstep; const char* b2 = last ? nB : cB + (size_t)(t + 2) * kstep;
            const char* a3 = a2 + kstep; const char* b3 = b2 + kstep;
            PG8_LDB(B0, 0, 0); PG8_LDB(B1, 0, 1); PG8_SCHED; PG8_LDA(At, 0, 0); PG8_STAGE(PG8_SA(1, 1), a1 + hstep, voffA);
            PG8_WAIT_V(8); PG8_WAIT_L(0); PG8_BAR; PG8_MMA(0, 0, At, B0); PG8_MMA(0, 1, At, B1); PG8_BAR; PG8_SCHED;
            PG8_LDA(At, 0, 1); PG8_STAGE(PG8_SB(0, 0), b2, voffB); PG8_STAGE(PG8_SB(0, 1), b2 + hstep, voffB); PG8_STAGE(PG8_SA(0, 0), a2, voffA);
            PG8_WAIT_V(8); PG8_WAIT_L(0); PG8_BAR; PG8_MMA(1, 0, At, B0); PG8_MMA(1, 1, At, B1); PG8_BAR; PG8_SCHED;
            PG8_LDB(B0, 1, 0); PG8_LDB(B1, 1, 1); PG8_SCHED; PG8_LDA(At, 1, 0); PG8_STAGE(PG8_SA(0, 1), a2 + hstep, voffA);
            PG8_WAIT_V(8); PG8_WAIT_L(0); PG8_BAR; PG8_MMA(0, 0, At, B0); PG8_MMA(0, 1, At, B1); PG8_BAR; PG8_SCHED;
            PG8_LDA(At, 1, 1); PG8_STAGE(PG8_SB(1, 0), b3, voffB); PG8_STAGE(PG8_SB(1, 1), b3 + hstep, voffB); PG8_STAGE(PG8_SA(1, 0), a3, voffA);
            PG8_WAIT_V(8); PG8_WAIT_L(0); PG8_BAR; PG8_MMA(1, 0, At, B0); PG8_MMA(1, 1, At, B1); PG8_BAR; PG8_SCHED;
        }
        if (wr == 0) PG8_BAR;
        E(acc, cur, wr, wc, fr, fq);
        if (!has_next) break;
#pragma unroll
        for (int a = 0; a < 2; ++a)
#pragma unroll
            for (int b = 0; b < 2; ++b)
#pragma unroll
                for (int m = 0; m < 4; ++m)
#pragma unroll
                    for (int n = 0; n < 2; ++n) acc[a][b][m][n] = (f32x4){0.f, 0.f, 0.f, 0.f};
        cur = nxt; cA = nA; cB = nB; ++ui;
        if (wr == 1) PG8_BAR;
    }
    PG8_WAIT_V(0);
    PG8_BAR;
#undef PG8_SA
#undef PG8_SB
#undef PG8_STAGE
#undef PG8_LDA
#undef PG8_LDB
#undef PG8_MMA
#undef PG8_WAIT_V
#undef PG8_WAIT_L
#undef PG8_BAR
#undef PG8_SCHED
}
}

struct InSched {
    const char* XN; const char* WT; int c, G;
    DI bool next(int i, pg8::Unit& u) const {
        const long L = (long)i * G + c;
        if (L < 2048) {
            int wgid = (int)L; wgid = (wgid & 7) * 256 + (wgid >> 3);
            const int gid = wgid >> 7, rem = wgid & 127, vs = rem >> 3;
            u.pm = gid * 8 + (rem & 7); u.pn = vs < 14 ? vs : vs + 2; return true;
        }
        if (L < 2176) { const int l2 = (int)L - 2048; u.pm = 128 + (l2 & 15); const int j = l2 >> 4; u.pn = j < 2 ? 2 + j : 10 + j; return true; }
        return false;
    }
    DI const char* aptr(const pg8::Unit& u) const { return u.pn < 12 ? XN + (size_t)u.pm * (256 * 1024 * 2) : WT + (size_t)u.pn * (256 * 1024 * 2); }
    DI const char* bptr(const pg8::Unit& u) const { return u.pn < 12 ? WT + (size_t)u.pn * (256 * 1024 * 2) : XN + (size_t)u.pm * (256 * 1024 * 2); }
};
struct EpiIn {
    static constexpr bool PERM = true;
    bf16_t *P, *KT, *PT; const float *COS, *SIN, *COST, *SINT; LAS unsigned char* scr;
    DI void operator()(const f32x4 (&acc)[2][2][4][2], const pg8::Unit& u, int wr, int wc, int fr_, int fq_) const {
        int fr = fr_, fq = fq_; asm volatile("" : "+v"(fr), "+v"(fq));
        const int vn = u.pn, pm = u.pm;
        if (vn < 12) {
            const int rowb = pm * 256 + wr * 64 + fr;
            if (vn == 2 || vn == 3) {
                const int colk = (vn - 2) * 256 + wc * 32 + 8 * fq;
#pragma unroll
                for (int ai = 0; ai < 2; ++ai)
#pragma unroll
                    for (int m = 0; m < 4; ++m) {
                        const int tok = rowb + ai * 128 + m * 16;
#pragma unroll
                        for (int bj = 0; bj < 2; ++bj) {
                            const int col = colk + bj * 128, hh = col >> 6, ks = (col >> 5) & 1, gg = (col >> 3) & 3;
                            const f32x4 v0 = acc[ai][bj][m][0], v1 = acc[ai][bj][m][1];
                            u32x4 w; w.x = cvt_pk_bf16(v0[0], v0[1]); w.y = cvt_pk_bf16(v0[2], v0[3]); w.z = cvt_pk_bf16(v1[0], v1[1]); w.w = cvt_pk_bf16(v1[2], v1[3]);
                            __builtin_nontemporal_store(w, (u32x4*)((char*)KT + (size_t)((tok >> 3) * 8 + hh) * 1024 + ks * 512 + (gg * 8 + (tok & 7)) * 16));
                        }
                    }
                return;
            }
            bf16_t* base = P; const int ldc = LDP;
            const int col0 = (vn < 2 ? vn : vn - 2) * 256 + wc * 32 + 8 * fq;
            const bool rot = (vn >= 6 && vn < 10);
            const int i0 = 16 * wc + 4 * fq;
#pragma unroll
            for (int ai = 0; ai < 2; ++ai)
#pragma unroll
                for (int m = 0; m < 4; ++m) {
                    const int row = rowb + ai * 128 + m * 16;
                    f32x4 c4 = {1.f, 1.f, 1.f, 1.f}, s4 = {0.f, 0.f, 0.f, 0.f};
                    if (rot) { const int t = row & 2047; c4 = *(const f32x4*)(COS + t * 64 + i0); s4 = *(const f32x4*)(SIN + t * 64 + i0); }
                    bf16_t* rowp = base + (size_t)row * ldc + col0;
#pragma unroll
                    for (int bj = 0; bj < 2; ++bj) {
                        const f32x4 v0 = acc[ai][bj][m][0], v1 = acc[ai][bj][m][1];
                        const f32x4 o0 = v0 * c4 - v1 * s4, o1 = v0 * s4 + v1 * c4;
                        u32x4 w; w.x = cvt_pk_bf16(o0[0], o0[1]); w.y = cvt_pk_bf16(o0[2], o0[3]); w.z = cvt_pk_bf16(o1[0], o1[1]); w.w = cvt_pk_bf16(o1[2], o1[3]);
                        {
                            LAS unsigned char* tbw = scr + 5120 + (wr * 4 + wc) * 2304;
                            const int ln = fr + 16 * fq;
                            *(LAS u32x4*)(tbw + fr * 80 + fq * 16) = w;
                            const u32x4 wt = *(const LAS u32x4*)(tbw + (ln >> 2) * 80 + (ln & 3) * 16);
                            __builtin_nontemporal_store(wt, (u32x4*)(base + (size_t)(row - fr + (ln >> 2)) * ldc + (col0 - 8 * fq) + bj * 128 + (ln & 3) * 8));
                        }
                        if (vn == 8 || vn == 9) {
                            unsigned short* r0 = (unsigned short*)((char*)PT + (size_t)512 * LDT * 2 + ((size_t)(row >> 3) * 1024 + ((vn - 8) * 2 + bj) * 128 + 32 * wc + 4 * fq) * 16 + (row & 7) * 2);
                            r0[0] = (unsigned short)(w.x & 0xffffu); r0[8] = (unsigned short)(w.x >> 16); r0[16] = (unsigned short)(w.y & 0xffffu); r0[24] = (unsigned short)(w.y >> 16);
                            r0[128] = (unsigned short)(w.z & 0xffffu); r0[136] = (unsigned short)(w.z >> 16); r0[144] = (unsigned short)(w.w & 0xffffu); r0[152] = (unsigned short)(w.w >> 16);
                        }
                    }
                }
        } else {
            const int frow0 = (vn - 12) * 256 + wr * 64 + fr;
            const int tok0 = pm * 256 + wc * 32 + 8 * fq;
            const bool rot = (vn == 14 || vn == 15) && pm < 128;
            if (vn < 14) {
#pragma unroll
                for (int ai = 0; ai < 2; ++ai)
#pragma unroll
                    for (int bj = 0; bj < 2; ++bj)
#pragma unroll
                        for (int m = 0; m < 4; ++m) {
                            const int f = frow0 + ai * 128 + m * 16, tok = tok0 + bj * 128;
                            const f32x4 v0 = acc[ai][bj][m][0], v1 = acc[ai][bj][m][1];
                            u32x4 w; w.x = cvt_pk_bf16(v0[0], v0[1]); w.y = cvt_pk_bf16(v0[2], v0[3]); w.z = cvt_pk_bf16(v1[0], v1[1]); w.w = cvt_pk_bf16(v1[2], v1[3]);
                            __builtin_nontemporal_store(w, (u32x4*)((char*)PT + (size_t)((tok >> 3) * 8 + (f >> 6)) * 1024 + (f & 63) * 16));
                        }
                return;
            }
#pragma unroll
            for (int ai = 0; ai < 2; ++ai)
#pragma unroll
                for (int bj = 0; bj < 2; ++bj)
#pragma unroll
                    for (int mp = 0; mp < 2; ++mp) {
                        const int tok = tok0 + bj * 128;
                        f32x4 ca = {1.f, 1.f, 1.f, 1.f}, cb = ca, sa = {0.f, 0.f, 0.f, 0.f}, sb = sa;
                        if (rot) { const int i = 32 * wr + 16 * mp + fr, t = tok & 2047;
                            ca = *(const f32x4*)(COST + i * 2048 + t); cb = *(const f32x4*)(COST + i * 2048 + t + 4);
                            sa = *(const f32x4*)(SINT + i * 2048 + t); sb = *(const f32x4*)(SINT + i * 2048 + t + 4); }
                        const f32x4 x1a = acc[ai][bj][2 * mp][0], x1b = acc[ai][bj][2 * mp][1], x2a = acc[ai][bj][2 * mp + 1][0], x2b = acc[ai][bj][2 * mp + 1][1];
                        const f32x4 o1a = x1a * ca - x2a * sa, o1b = x1b * cb - x2b * sb, o2a = x1a * sa + x2a * ca, o2b = x1b * sb + x2b * cb;
                        char* r1 = (char*)PT + (size_t)512 * LDT * 2 + ((size_t)(tok >> 3) * 1024 + (frow0 - 512 + ai * 128 + (2 * mp) * 16)) * 16;
                        char* r2 = r1 + 16 * 16;
                        u32x4 w; w.x = cvt_pk_bf16(o1a[0], o1a[1]); w.y = cvt_pk_bf16(o1a[2], o1a[3]); w.z = cvt_pk_bf16(o1b[0], o1b[1]); w.w = cvt_pk_bf16(o1b[2], o1b[3]);
                        __builtin_nontemporal_store(w, (u32x4*)r1);
                        w.x = cvt_pk_bf16(o2a[0], o2a[1]); w.y = cvt_pk_bf16(o2a[2], o2a[3]); w.z = cvt_pk_bf16(o2b[0], o2b[1]); w.w = cvt_pk_bf16(o2b[2], o2b[3]);
                        __builtin_nontemporal_store(w, (u32x4*)r2);
                    }
        }
    }
};
struct OutSched {
    const char* Y; const char* WOT; int c, G;
    DI bool next(int i, pg8::Unit& u) const {
        const long L = (long)i * G + c; if (L >= 512) return false;
        u.pm = (int)(L >> 2); u.pn = (int)(L & 3); return true;
    }
    DI const char* aptr(const pg8::Unit& u) const { return Y + (size_t)u.pm * (256 * 1024 * 2); }
    DI const char* bptr(const pg8::Unit& u) const { return WOT + (size_t)u.pn * (256 * 1024 * 2); }
};
struct EpiOutF {
    static constexpr bool PERM = false;
    const float* x; const float* MOD; const float* gfin; float* out; float* xbuf; unsigned* cnt; LAS unsigned char* scr;
    DI void operator()(f32x4 (&acc)[2][2][4][2], const pg8::Unit& u, int wr, int wc, int fr_, int fq_) const {
        int fr = fr_, fq = fq_, tid = threadIdx.x;
        asm volatile("" : "+v"(fr), "+v"(fq), "+v"(tid));
        const int b = u.pm >> 3;
        const int col0 = u.pn * 256 + wc * 32 + 4 * fq;
        LAS float* P4s = (LAS float*)scr;
        LAS float* S = (LAS float*)(scr + 4096);
        f32x4 gt[2][2];
#pragma unroll
        for (int bj = 0; bj < 2; ++bj)
#pragma unroll
            for (int n = 0; n < 2; ++n) gt[bj][n] = *(const f32x4*)(MOD + b * 3072 + 2048 + col0 + bj * 128 + n * 16);
        int lane = fr + 16 * fq; const int rr = lane >> 3, pz = lane & 7;
        LAS unsigned char* tb = scr + 5120 + (wr * 4 + wc) * 2304;
        f32x4 xv[3][2][2];
        const float* xg = x + (size_t)(u.pm * 256 + wr * 64 + rr) * DM + u.pn * 256 + wc * 32 + pz * 4;
#define EPF_LOADX(B, ai_, m_) do { _Pragma("unroll") for (int bj = 0; bj < 2; ++bj) _Pragma("unroll") for (int k = 0; k < 2; ++k) \
            xv[B][bj][k] = *(const f32x4*)(xg + (size_t)((ai_) * 128 + (m_) * 16 + 8 * k) * DM + bj * 128); } while (0)
        EPF_LOADX(0, 0, 0); EPF_LOADX(1, 0, 1);
#pragma unroll
        for (int im = 0; im < 8; ++im) {
            const int ai = im >> 2, m = im & 3;
            if (im + 2 < 8) EPF_LOADX((im + 2) % 3, (im + 2) >> 2, (im + 2) & 3);
            __builtin_amdgcn_sched_barrier(0);
            float q0 = 0.f, q1 = 0.f; f32x4 uu[2];
#pragma unroll
            for (int bj = 0; bj < 2; ++bj) {
#pragma unroll
                for (int n = 0; n < 2; ++n) *(LAS f32x4*)(tb + fr * 144 + (16 * n + 4 * fq) * 4) = gt[bj][n] * acc[ai][bj][m][n];
#pragma unroll
                for (int k = 0; k < 2; ++k) {
                    const f32x4 t = *(const LAS f32x4*)(tb + (rr + 8 * k) * 144 + pz * 16);
                    const f32x4 v = xv[im % 3][bj][k] + t;
                    const float d = (v[0] * v[0] + v[1] * v[1]) + (v[2] * v[2] + v[3] * v[3]);
                    if (k == 0) q0 += d; else q1 += d;
                    uu[k] = v;
                }
                acc[ai][bj][m][0] = uu[0]; acc[ai][bj][m][1] = uu[1];
            }
            q0 += __shfl_xor(q0, 1); q1 += __shfl_xor(q1, 1); q0 += __shfl_xor(q0, 2); q1 += __shfl_xor(q1, 2); q0 += __shfl_xor(q0, 4); q1 += __shfl_xor(q1, 4);
            if (pz == 0) { P4s[(ai * 128 + wr * 64 + m * 16 + rr) * 4 + wc] = q0; P4s[(ai * 128 + wr * 64 + m * 16 + rr + 8) * 4 + wc] = q1; }
            __builtin_amdgcn_sched_barrier(0);
        }
#undef EPF_LOADX
        asm volatile("s_waitcnt lgkmcnt(0)" ::: "memory"); __builtin_amdgcn_s_barrier(); asm volatile("" ::: "memory");
        float* slot = xbuf + ((size_t)u.pm * 256) * 4;
        unsigned* pc = cnt + 64 * u.pm;
        if (tid < 256) {
            const float t = (P4s[tid * 4 + 0] + P4s[tid * 4 + 1]) + (P4s[tid * 4 + 2] + P4s[tid * 4 + 3]);
            __hip_atomic_store(slot + tid * 4 + u.pn, t, __ATOMIC_RELAXED, __HIP_MEMORY_SCOPE_AGENT);
            asm volatile("s_waitcnt vmcnt(0)" ::: "memory");
            if ((tid & 63) == 0) __hip_atomic_fetch_add(pc, 1u, __ATOMIC_RELAXED, __HIP_MEMORY_SCOPE_AGENT);
        }
        if (tid < 64) {
            unsigned sp = 0;
            while ((unsigned)__builtin_amdgcn_readfirstlane(__hip_atomic_load(pc, __ATOMIC_RELAXED, __HIP_MEMORY_SCOPE_AGENT)) < 16u) {
                __builtin_amdgcn_s_sleep(2); if (++sp > (1u << 20)) break; }
            __builtin_amdgcn_fence(__ATOMIC_ACQUIRE, "agent");
        }
        asm volatile("s_waitcnt vmcnt(0) lgkmcnt(0)" ::: "memory"); __builtin_amdgcn_s_barrier(); asm volatile("" ::: "memory");
        if (tid < 256) {
            float tot = 0.f;
#pragma unroll
            for (int t = 0; t < 4; ++t) tot += __hip_atomic_load(slot + tid * 4 + t, __ATOMIC_RELAXED, __HIP_MEMORY_SCOPE_AGENT);
            S[tid] = rsqrtf(tot * (1.f / DM) + EPSN);
        }
        asm volatile("s_waitcnt lgkmcnt(0)" ::: "memory"); __builtin_amdgcn_s_barrier(); asm volatile("" ::: "memory");
        f32x4 gf[2];
#pragma unroll
        for (int bj = 0; bj < 2; ++bj) gf[bj] = *(const f32x4*)(gfin + u.pn * 256 + bj * 128 + wc * 32 + pz * 4);
#pragma unroll
        for (int ai = 0; ai < 2; ++ai)
#pragma unroll
            for (int m = 0; m < 4; ++m)
#pragma unroll
                for (int k = 0; k < 2; ++k) {
                    const int r = ai * 128 + wr * 64 + m * 16 + rr + 8 * k; const float rs = S[r];
                    float* orow = out + (size_t)(u.pm * 256 + r) * DM + u.pn * 256 + wc * 32 + pz * 4;
#pragma unroll
                    for (int bj = 0; bj < 2; ++bj) *(f32x4*)(orow + bj * 128) = acc[ai][bj][m][k] * rs * gf[bj];
                }
        asm volatile("s_waitcnt lgkmcnt(0)" ::: "memory"); __builtin_amdgcn_s_barrier(); asm volatile("" ::: "memory");
    }
};

DI void wt_src(int np, int& src, float& sc) {
    const int vn = np >> 8; sc = 1.f;
    if (vn < 2) { src = np; sc = 0.125f * LOG2E; }
    else if (vn < 4) { src = np; }
    else if (vn < 6) { src = 1536 + (np - 1024); }
    else if (vn < 10) { const int hl = (np - 1536) & 511, head = hl >> 7, p = hl & 127, half = (p >> 2) & 1, i = 4 * (p >> 3) + (p & 3);
        src = (vn < 8 ? 2048 : 2560) + head * 128 + 64 * half + i; if (vn >= 8) sc = KSCALE; }
    else if (vn < 12) { src = 3584 + (np - 2560); }
    else if (vn < 14) { src = 1024 + (np - 3072); }
    else if (vn < 16) { const int hl = np - 3584, head = hl >> 7, p = hl & 127, half = (p >> 4) & 1, i = 16 * (p >> 5) + (p & 15);
        src = 2560 + head * 128 + 64 * half + i; sc = KSCALE; }
    else { src = 3072 + (np - 4096); }
}
DI void p0_transpose_item(const float* W, int N, bool is_in, bf16_t* WT, LAS float* scr, int item, int lane) {
    const int nblk = is_in ? (NWT / 32) : 32, kb = item / nblk, nb = item % nblk, k0 = 64 * kb, n0 = 32 * nb;
    int src; float sc;
    if (is_in) wt_src(n0 + (lane & 31), src, sc); else { src = n0 + (lane & 31); sc = 1.f; }
#pragma unroll 8
    for (int i = 0; i < 32; ++i) { const int kk = 2 * i + (lane >> 5); scr[kk * 33 + (lane & 31)] = __builtin_nontemporal_load(W + (size_t)(k0 + kk) * N + src) * sc; }
    asm volatile("s_waitcnt lgkmcnt(0)" ::: "memory");
    const int c = lane & 7;
#pragma unroll
    for (int j = 0; j < 4; ++j) { const int n = (lane >> 3) + 8 * j; const LAS float* s = scr + (8 * c) * 33 + n;
        u32x4 o; o.x = cvt_pk_bf16(s[0 * 33], s[1 * 33]); o.y = cvt_pk_bf16(s[2 * 33], s[3 * 33]); o.z = cvt_pk_bf16(s[4 * 33], s[5 * 33]); o.w = cvt_pk_bf16(s[6 * 33], s[7 * 33]);
        *(u32x4*)(WT + (size_t)(n0 + n) * 1024 + k0 + 8 * c) = o; }
    asm volatile("s_waitcnt lgkmcnt(0)" ::: "memory");
}
DI void p0_gemv_item(const Params& p, float* MODP, LAS float* scr, int item, int lane) {
    const int q = item / 48, cgp = item % 48, col = cgp * 64 + lane;
    float acc[17];
#pragma unroll
    for (int bb = 0; bb < 17; ++bb) acc[bb] = 0.f;
    for (int kc = 0; kc < 4; ++kc) {
        const int kbase = q * 64 + kc * 16;
#pragma unroll
        for (int u = 0; u < 5; ++u) { const int idx = lane + 64 * u;
            if (idx < 272) { const int kk = idx / 17, bb = idx - kk * 17; const float v = bb < 16 ? p.c[bb * 1024 + kbase + kk] : p.c_ctx[kbase + kk]; scr[idx] = silu_f(v); } }
        asm volatile("s_waitcnt lgkmcnt(0)" ::: "memory");
        float wv[16];
#pragma unroll
        for (int kk = 0; kk < 16; ++kk) wv[kk] = p.w_ada[(size_t)(kbase + kk) * 3072 + col];
#pragma unroll
        for (int kk = 0; kk < 16; ++kk) {
#pragma unroll
            for (int bb = 0; bb < 17; ++bb) acc[bb] += scr[kk * 17 + bb] * wv[kk]; }
        asm volatile("s_waitcnt lgkmcnt(0)" ::: "memory");
    }
#pragma unroll
    for (int bb = 0; bb < 17; ++bb) MODP[(q * 17 + bb) * 3072 + col] = acc[bb];
}
DI void phase_p0(const Params& p, LAS unsigned char* lds, int vb, int G) {
    const int tid = threadIdx.x, lane = tid & 63, wave = tid >> 6;
    LAS float* scr = (LAS float*)(lds + wave * 16384);
    const int gw = vb * 8 + wave, NGW = G * 8;
    bf16_t* WT = (bf16_t*)(p.ws + WS_WT); bf16_t* WOT = (bf16_t*)(p.ws + WS_WOT); float* MODP = (float*)(p.ws + WS_MODP);
    constexpr int I_GEMV = 768, I_IN = 16 * (NWT / 32), I_OUT = 16 * 32;
    for (int it = gw; it < I_GEMV + I_IN + I_OUT; it += NGW) {
        if (it < I_GEMV) p0_gemv_item(p, MODP, scr, it, lane);
        else if (it < I_GEMV + I_IN) p0_transpose_item(p.w_in, 4096, true, WT, scr, it - I_GEMV, lane);
        else p0_transpose_item(p.w_out, 1024, false, WOT, scr, it - I_GEMV - I_IN, lane);
    }
    float* COS = (float*)(p.ws + WS_COS); float* SIN = (float*)(p.ws + WS_SIN); float* COST = (float*)(p.ws + WS_COST); float* SINT = (float*)(p.ws + WS_SINT);
    for (int idx = vb * 512 + tid; idx < 2048 * 64; idx += G * 512) {
        const int t = idx >> 6, i = idx & 63, f = i & 31; const float pos = (float)((i < 32) ? (t >> 6) : (t & 63));
        const float inv = exp2f(-(float)f * (13.287712379549449f / 32.f));
        const float ang = pos * inv; const float cs = __cosf(ang), sn = __sinf(ang);
        COS[idx] = cs; SIN[idx] = sn; COST[i * 2048 + t] = cs; SINT[i * 2048 + t] = sn;
    }
}
DI void norm_rows(const Params& p, const float* src, bf16_t* dst, int nrows, int bmod, int lane) {
    const float* MODP = (const float*)(p.ws + WS_MODP);
    f32x4 mul[4], sh[4];
#pragma unroll
    for (int j = 0; j < 4; ++j) { const int col = 4 * lane + 256 * j;
        f32x4 s = *(const f32x4*)(p.b_ada + col), sc = *(const f32x4*)(p.b_ada + 1024 + col);
#pragma unroll 2
        for (int q = 0; q < 16; ++q) { s += *(const f32x4*)(MODP + (q * 17 + bmod) * 3072 + col); sc += *(const f32x4*)(MODP + (q * 17 + bmod) * 3072 + 1024 + col); }
        sh[j] = s; mul[j] = *(const f32x4*)(p.norm_g + col) * (sc + 1.0f); }
    for (int r = 0; r < nrows; r += 2) {
        const f32x4* xr = (const f32x4*)(src + (size_t)r * DM) + lane;
        f32x4 v[2][4]; float sq[2];
#pragma unroll
        for (int q = 0; q < 2; ++q)
#pragma unroll
            for (int j = 0; j < 4; ++j) v[q][j] = __builtin_nontemporal_load(xr + q * 256 + 64 * j);
#pragma unroll
        for (int q = 0; q < 2; ++q) { float s = 0.f;
#pragma unroll
            for (int j = 0; j < 4; ++j) s += (v[q][j].x * v[q][j].x + v[q][j].y * v[q][j].y) + (v[q][j].z * v[q][j].z + v[q][j].w * v[q][j].w);
            sq[q] = s; }
#pragma unroll
        for (int o = 1; o < 64; o <<= 1) { sq[0] += __shfl_xor(sq[0], o); sq[1] += __shfl_xor(sq[1], o); }
#pragma unroll
        for (int q = 0; q < 2; ++q) { const float rstd = rsqrtf(sq[q] * (1.f / DM) + EPSN);
            u32x2* o8 = (u32x2*)(dst + (size_t)(r + q) * DM) + lane;
#pragma unroll
            for (int j = 0; j < 4; ++j) { const f32x4 h = v[q][j] * rstd * mul[j] + sh[j]; u32x2 w; w.x = cvt_pk_bf16(h.x, h.y); w.y = cvt_pk_bf16(h.z, h.w); o8[64 * j] = w; } }
    }
}
DI void phase_p0b(const Params& p, int vb, int G) {
    const int tid = threadIdx.x, lane = tid & 63, wave = tid >> 6;
    const int gw = vb * 8 + wave, NGW = G * 8;
    bf16_t* XN = (bf16_t*)(p.ws + WS_XN);
    for (int wv = gw; wv < 2048; wv += NGW) {
        const int b = wv >> 7, r0 = b * 2048 + (wv & 127) * 16;
        norm_rows(p, p.x + (size_t)r0 * DM, XN + (size_t)r0 * DM, 16, b, lane);
    }
    for (int wv = gw; wv < 2048; wv += NGW)
        norm_rows(p, p.ctx + (size_t)(wv * 2) * DM, XN + (size_t)(MLAT + wv * 2) * DM, 2, 16, lane);
    const float* MODP = (const float*)(p.ws + WS_MODP); float* MOD = (float*)(p.ws + WS_MOD);
    for (int idx = vb * 512 + tid; idx < 17 * 3072; idx += G * 512) {
        const int col = idx % 3072;
        float a = p.b_ada[col];
#pragma unroll
        for (int q = 0; q < 16; ++q) a += MODP[q * 17 * 3072 + idx];
        MOD[idx] = a;
    }
}

DI void ret_state_item(const Params& p, int item) {
    const int lane = threadIdx.x & 63, wave = __builtin_amdgcn_readfirstlane(threadIdx.x >> 6);
    const int dvq = item & 3, h = (item >> 2) & 3, b = item >> 4;
    const int dir = wave & 1, mt = wave >> 1, c = lane & 15, g = lane >> 4;
    const bf16_t* PT = (const bf16_t*)(p.ws + WS_PT);
    bf16_t* SO = (bf16_t*)(p.ws + (dir ? WS_SB : WS_SF)) + (size_t)((b * 4 + h) * 16) * 16384;
    const float lg2 = -__expf(dir ? p.dec_b[h] : p.dec_f[h]) * LOG2E;
    float w8[8];
#pragma unroll
    for (int j = 0; j < 8; ++j) w8[j] = ex2(lg2 * (float)(dir ? (8 * g + j) : (31 - 8 * g - j)));
    const float g32 = ex2(lg2 * 32.f);
    const unsigned loff = (unsigned)((g * 1024 + c) * 16);
    const char* RT = (const char*)(p.ws + WS_RT);
    const char* abase = RT + (size_t)(h * 128 + 32 * mt) * 16;
    const char* bbase = RT + (size_t)(512 + h * 128 + 32 * dvq) * 16;
    const int ctxb = MLAT + b * CTXL, latb = b * SEQ;
    f32x4 acc[2][2];
#pragma unroll
    for (int at = 0; at < 2; ++at)
#pragma unroll
        for (int nt = 0; nt < 2; ++nt) acc[at][nt] = (f32x4){0.f, 0.f, 0.f, 0.f};
    bf16x8 fa[2][2][4], fb[2][2][4];
#define RS_TOK(i) (dir ? ((i) < 2 ? ctxb + 128 * (1 - (i)) : latb + 128 * (17 - (i))) : ((i) < 2 ? ctxb + 128 * (i) : latb + 128 * ((i) - 2)))
#define RS_LOAD(B, i) do { const int tb_ = RS_TOK(i); _Pragma("unroll") for (int ks = 0; ks < 4; ++ks) { \
        const size_t to_ = (size_t)((tb_ >> 3) + 4 * ks) * 16384; \
        fa[B][0][ks] = ldg8u((const bf16_t*)(abase + to_), loff); fa[B][1][ks] = ldg8u((const bf16_t*)(abase + to_ + 256), loff); \
        fb[B][0][ks] = ldg8u((const bf16_t*)(bbase + to_), loff); fb[B][1][ks] = ldg8u((const bf16_t*)(bbase + to_ + 256), loff); } } while (0)
#define RS_STORE(i) do { const int n_ = dir ? 17 - (i) : (i) - 2; bf16_t* so_ = SO + (size_t)n_ * 16384; \
        _Pragma("unroll") for (int at = 0; at < 2; ++at) _Pragma("unroll") for (int nt = 0; nt < 2; ++nt) { \
            u32x2 w_; w_.x = cvt_pk_bf16(acc[at][nt][0], acc[at][nt][1]); w_.y = cvt_pk_bf16(acc[at][nt][2], acc[at][nt][3]); \
            __builtin_nontemporal_store(w_, (u32x2*)(so_ + (32 * dvq + 16 * nt + c) * 128 + 32 * mt + 8 * g + 4 * at)); } } while (0)
#define RS_COMPUTE(B) do { _Pragma("unroll") for (int kk = 0; kk < 4; ++kk) { const int ks = dir ? 3 - kk : kk; \
        _Pragma("unroll") for (int at = 0; at < 2; ++at) _Pragma("unroll") for (int nt = 0; nt < 2; ++nt) acc[at][nt] *= g32; \
        _Pragma("unroll") for (int at = 0; at < 2; ++at) { \
            const u32x4 w_ = __builtin_bit_cast(u32x4, fa[B][at][ks]); u32x4 o_; \
            o_.x = cvt_pk_bf16(bflo(w_.x) * w8[0], bfhi(w_.x) * w8[1]); o_.y = cvt_pk_bf16(bflo(w_.y) * w8[2], bfhi(w_.y) * w8[3]); \
            o_.z = cvt_pk_bf16(bflo(w_.z) * w8[4], bfhi(w_.z) * w8[5]); o_.w = cvt_pk_bf16(bflo(w_.w) * w8[6], bfhi(w_.w) * w8[7]); \
            const bf16x8 aw_ = __builtin_bit_cast(bf16x8, o_); \
            acc[at][0] = mfma16(aw_, fb[B][0][ks], acc[at][0]); acc[at][1] = mfma16(aw_, fb[B][1][ks], acc[at][1]); } } } while (0)
    RS_LOAD(0, 0); __builtin_amdgcn_sched_barrier(0);
    for (int i = 0; i < 18; i += 2) {
        if (i + 1 < 17) RS_LOAD(1, i + 1);
        __builtin_amdgcn_sched_barrier(0);
        if (i >= 2) RS_STORE(i);
        if (i < 17) RS_COMPUTE(0);
        if (i + 2 < 17) RS_LOAD(0, i + 2);
        __builtin_amdgcn_sched_barrier(0);
        if (i + 1 >= 2) RS_STORE(i + 1);
        if (i + 1 < 17) RS_COMPUTE(1);
    }
#undef RS_TOK
#undef RS_LOAD
#undef RS_STORE
#undef RS_COMPUTE
}

template <bool LOCAL>
DI void na_step1(const bf16x8 (&kf)[2][2], const bf16x8 (&vf)[4], const bf16x8 (&qf)[2], f32x4 (&O)[4], float& mrun, float& lrun,
                 const LAS float* bp, const f32x4 (&madd)[2]) {
    f32x4 s[2];
    if (LOCAL) {
#pragma unroll
        for (int tau = 0; tau < 2; ++tau) {
            float b0 = bp[4 * tau], b1 = bp[4 * tau + 1], b2 = bp[4 * tau + 2], b3 = bp[4 * tau + 3];
            asm volatile("" : "+v"(b0), "+v"(b1), "+v"(b2), "+v"(b3));
            s[tau] = (f32x4){b0, b1, b2, b3} + madd[tau];
        }
    } else { s[0] = (f32x4){0.f, 0.f, 0.f, 0.f}; s[1] = s[0]; }
#pragma unroll
    for (int tau = 0; tau < 2; ++tau) { s[tau] = mfma16(kf[tau][0], qf[0], s[tau]); s[tau] = mfma16(kf[tau][1], qf[1], s[tau]); }
    float mx = fmaxf(fmaxf(fmaxf(s[0][0], s[0][1]), fmaxf(s[0][2], s[0][3])), fmaxf(fmaxf(s[1][0], s[1][1]), fmaxf(s[1][2], s[1][3])));
    mx = fmaxf(mx, __shfl_xor(mx, 16)); mx = fmaxf(mx, __shfl_xor(mx, 32));
    const float mnew = fmaxf(mrun, mx), alpha = ex2(mrun - mnew);
    mrun = mnew;
    float ps = 0.f;
#pragma unroll
    for (int tau = 0; tau < 2; ++tau)
#pragma unroll
        for (int e = 0; e < 4; ++e) { s[tau][e] = ex2(s[tau][e] - mnew); ps += s[tau][e]; }
    lrun = lrun * alpha + ps;
    u32x4 pw; pw.x = cvt_pk_bf16(s[0][0], s[0][1]); pw.y = cvt_pk_bf16(s[0][2], s[0][3]); pw.z = cvt_pk_bf16(s[1][0], s[1][1]); pw.w = cvt_pk_bf16(s[1][2], s[1][3]);
    const bf16x8 pf = __builtin_bit_cast(bf16x8, pw);
#pragma unroll
    for (int dt = 0; dt < 4; ++dt) { O[dt] *= alpha; O[dt] = mfma16(vf[dt], pf, O[dt]); }
}
DI void na_step2(const bf16x8 (&kf)[2][2], const bf16x8 (&vf)[4], const bf16x8 (&kc)[2][2], const bf16x8 (&vc)[4], const bf16x8 (&qf)[2], f32x4 (&O)[4], float& mrun, float& lrun,
                 const LAS float* bp, const f32x4 (&madd)[2]) {
    f32x4 s[4];
#pragma unroll
    for (int tau = 0; tau < 2; ++tau) {
        float b0 = bp[4 * tau], b1 = bp[4 * tau + 1], b2 = bp[4 * tau + 2], b3 = bp[4 * tau + 3];
        asm volatile("" : "+v"(b0), "+v"(b1), "+v"(b2), "+v"(b3));
        s[tau] = (f32x4){b0, b1, b2, b3} + madd[tau];
        s[2 + tau] = (f32x4){0.f, 0.f, 0.f, 0.f};
    }
#pragma unroll
    for (int tau = 0; tau < 2; ++tau) { s[tau] = mfma16(kf[tau][0], qf[0], s[tau]); s[2 + tau] = mfma16(kc[tau][0], qf[0], s[2 + tau]); }
#pragma unroll
    for (int tau = 0; tau < 2; ++tau) { s[tau] = mfma16(kf[tau][1], qf[1], s[tau]); s[2 + tau] = mfma16(kc[tau][1], qf[1], s[2 + tau]); }
    float mx = fmaxf(fmaxf(fmaxf(s[0][0], s[0][1]), fmaxf(s[0][2], s[0][3])), fmaxf(fmaxf(s[1][0], s[1][1]), fmaxf(s[1][2], s[1][3])));
    mx = fmaxf(mx, fmaxf(fmaxf(fmaxf(s[2][0], s[2][1]), fmaxf(s[2][2], s[2][3])), fmaxf(fmaxf(s[3][0], s[3][1]), fmaxf(s[3][2], s[3][3]))));
    mx = fmaxf(mx, __shfl_xor(mx, 16)); mx = fmaxf(mx, __shfl_xor(mx, 32));
    const float mnew = fmaxf(mrun, mx), alpha = ex2(mrun - mnew);
    mrun = mnew;
    float ps = 0.f;
#pragma unroll
    for (int t = 0; t < 4; ++t)
#pragma unroll
        for (int e = 0; e < 4; ++e) { s[t][e] = ex2(s[t][e] - mnew); ps += s[t][e]; }
    lrun = lrun * alpha + ps;
    u32x4 pw; pw.x = cvt_pk_bf16(s[0][0], s[0][1]); pw.y = cvt_pk_bf16(s[0][2], s[0][3]); pw.z = cvt_pk_bf16(s[1][0], s[1][1]); pw.w = cvt_pk_bf16(s[1][2], s[1][3]);
    const bf16x8 pfl = __builtin_bit_cast(bf16x8, pw);
    pw.x = cvt_pk_bf16(s[2][0], s[2][1]); pw.y = cvt_pk_bf16(s[2][2], s[2][3]); pw.z = cvt_pk_bf16(s[3][0], s[3][1]); pw.w = cvt_pk_bf16(s[3][2], s[3][3]);
    const bf16x8 pfc = __builtin_bit_cast(bf16x8, pw);
#pragma unroll
    for (int dt = 0; dt < 4; ++dt) { O[dt] *= alpha; O[dt] = mfma16(vf[dt], pfl, O[dt]); O[dt] = mfma16(vc[dt], pfc, O[dt]); }
}
DI void na_item(const Params& p, LAS unsigned char* lds, int item) {
    const int tid = threadIdx.x, lane = tid & 63, wave = __builtin_amdgcn_readfirstlane(tid >> 6);
    const int half = item & 1, h = (item >> 1) & 7, b = item >> 4;
    const int j = wave & 3, rr = wave >> 2, c = lane & 15, g = lane >> 4;
    const bf16_t* P = (const bf16_t*)(p.ws + WS_P); const char* KT = (const char*)(p.ws + WS_KT); const char* VT = (const char*)(p.ws + WS_VT);
    bf16_t* Y = (bf16_t*)(p.ws + WS_Y);
    LAS float* rpb = (LAS float*)lds;
    LAS unsigned char* Kc = lds + 4096;
    LAS unsigned char* Vc = lds + 4096 + 32768;
    __syncthreads();
    for (int idx = tid; idx < 15 * 64; idx += 512) { const int dr = idx >> 6, xx = (idx & 63) - 16;
        rpb[idx] = (xx >= 0 && xx < 31) ? p.na_rpb[(h * 15 + dr) * 31 + xx] * LOG2E : 0.f; }
#pragma unroll
    for (int i = 0; i < 4; ++i) { const int idx = tid + 512 * i, blk = idx >> 6, q = idx & 63;
        const size_t tb = (size_t)(((MLAT + b * CTXL) >> 3) + blk) * 8 + h;
        { const int row = blk * 8 + (q & 7), pc = (q >> 5) * 4 + ((q >> 3) & 3);
          *(LAS bf16x8*)(Kc + row * 128 + ((pc ^ (((row >> 1) & 1) | (((row >> 3) & 3) << 1))) << 4)) = *(const bf16x8*)(KT + tb * 1024 + q * 16); }
        { const int row = q, pc = blk;
          *(LAS bf16x8*)(Vc + row * 512 + ((pc ^ (row & 15)) << 4)) = *(const bf16x8*)(VT + tb * 1024 + q * 16); } }
    __syncthreads();
    const int cw0 = (j == 0) ? 0 : (j == 1) ? 8 : (j == 2) ? 24 : 32;
    const int kap0 = 8 * (c >> 2) + (c & 3);
    const int cq = 16 * j + c; int c0 = cq - 8; c0 = c0 < 0 ? 0 : (c0 > 48 ? 48 : c0);
    const LAS float* rpbl = rpb + 16 + (cw0 + 8 * g - cq + 15);
    f32x4 madd[2];
#pragma unroll
    for (int tau = 0; tau < 2; ++tau)
#pragma unroll
        for (int e = 0; e < 4; ++e) { const int ck = cw0 + 8 * g + 4 * tau + e; madd[tau][e] = (ck >= c0 && ck < c0 + 16) ? 0.f : -INFINITY; }
    const unsigned klo = (unsigned)((c >> 2) * 8192 + (g * 8 + (c & 3)) * 16), vlo = (unsigned)(g * 8192 + c * 16);
    const unsigned kcb = (unsigned)(kap0 * 128), vcb = (unsigned)(c * 512);
    unsigned kx[2]; kx[0] = (unsigned)(((g) ^ (c >> 1)) << 4); kx[1] = (unsigned)(((4 + g) ^ (c >> 1)) << 4);
    for (int ui = 0; ui < 8; ++ui) {
        const int rp = 8 * half + ui, r = 2 * rp + rr;
        int r0 = r - 4; r0 = r0 < 0 ? 0 : (r0 > 24 ? 24 : r0);
        const size_t tok = (size_t)(b * SEQ + r * 64 + 16 * j + c);
        bf16x8 qf[2];
#pragma unroll
        for (int ks = 0; ks < 2; ++ks) qf[ks] = ldg8(P + tok * LDP + PC_NAQ + h * 64 + 32 * ks + 8 * g);
        f32x4 O[4]; float mrun = -1e30f, lrun = 0.f;
#pragma unroll
        for (int dt = 0; dt < 4; ++dt) O[dt] = (f32x4){0.f, 0.f, 0.f, 0.f};
        const size_t tb0 = (size_t)(((b * SEQ + r0 * 64 + cw0) >> 3) * 8 + h) * 1024;
        const char* kb0 = KT + tb0; const char* vb0 = VT + tb0;
        const LAS float* bp0 = rpbl + (r0 - r + 7) * 64;
        bf16x8 kf[2][2][2], vf[2][4], kc[2][2], vc[4];
#define NA_LOADL(B, st) do { _Pragma("unroll") for (int tau = 0; tau < 2; ++tau) _Pragma("unroll") for (int ks = 0; ks < 2; ++ks) \
            kf[B][tau][ks] = ldg8u((const bf16_t*)(kb0 + (size_t)(st) * 65536 + ks * 512 + tau * 64), klo); \
            _Pragma("unroll") for (int dt = 0; dt < 4; ++dt) vf[B][dt] = ldg8u((const bf16_t*)(vb0 + (size_t)(st) * 65536 + dt * 256), vlo); } while (0)
#define NA_LOADC(st) do { _Pragma("unroll") for (int tau = 0; tau < 2; ++tau) _Pragma("unroll") for (int ks = 0; ks < 2; ++ks) \
            kc[tau][ks] = *(const LAS bf16x8*)(Kc + kcb + kx[ks] + (32 * (st) + 4 * tau) * 128); \
            { unsigned va_ = vcb + (unsigned)((((4 * (st) + g) ^ c)) << 4); _Pragma("unroll") for (int dt = 0; dt < 4; ++dt) vc[dt] = *(const LAS bf16x8*)(Vc + va_ + (16 * dt) * 512); } } while (0)
        NA_LOADL(0, 0); __builtin_amdgcn_sched_barrier(0);
#pragma unroll 1
        for (int st = 0; st < 8; st += 2) {
            NA_LOADL(1, st + 1); __builtin_amdgcn_sched_barrier(0);
            NA_LOADC(st);
            na_step2(kf[0], vf[0], kc, vc, qf, O, mrun, lrun, bp0 + st * 64, madd);
            if (st + 2 < 8) NA_LOADL(0, st + 2);
            __builtin_amdgcn_sched_barrier(0);
            NA_LOADC(st + 1);
            na_step2(kf[1], vf[1], kc, vc, qf, O, mrun, lrun, bp0 + (st + 1) * 64, madd);
        }
#undef NA_LOADL
#undef NA_LOADC
        lrun += __shfl_xor(lrun, 16); lrun += __shfl_xor(lrun, 32);
        const float inv = __builtin_amdgcn_rcpf(lrun);
#pragma unroll
        for (int dt = 0; dt < 4; ++dt) {
            const f32x4 o = O[dt] * inv;
            const u32x2 gw = *(const u32x2*)(P + tok * LDP + PC_NAG + h * 64 + 16 * dt + 4 * g);
            u32x2 w; w.x = cvt_pk_bf16(o[0] * silu_f(bflo(gw.x)), o[1] * silu_f(bfhi(gw.x))); w.y = cvt_pk_bf16(o[2] * silu_f(bflo(gw.y)), o[3] * silu_f(bfhi(gw.y)));
            *(u32x2*)(Y + tok * DM + h * 64 + 16 * dt + 4 * g) = w;
        }
    }
}

DI void ret_out_phase(const Params& p, LAS unsigned char* lds, int vb, int G) {
    const int tid = threadIdx.x, lane = tid & 63, wave = __builtin_amdgcn_readfirstlane(tid >> 6), c = lane & 15, g = lane >> 4;
    const bf16_t* P = (const bf16_t*)(p.ws + WS_P); const bf16_t* PT = (const bf16_t*)(p.ws + WS_PT);
    const bf16_t* SFg = (const bf16_t*)(p.ws + WS_SF); const bf16_t* SBg = (const bf16_t*)(p.ws + WS_SB); const char* RTg = (const char*)(p.ws + WS_RT);
    bf16_t* Y = (bf16_t*)(p.ws + WS_Y);
    LAS unsigned char* Ks = lds; LAS unsigned char* Vs = lds + 32768; LAS unsigned char* SFs = lds + 65536; LAS unsigned char* SBs = lds + 98304;
    const int prow = tid >> 4, pc = tid & 15;
    const unsigned wK = (unsigned)(prow * 256 + ((pc ^ ((prow & 3) | (((prow >> 3) & 3) << 2))) << 4));
    const unsigned wV = (unsigned)(prow * 256 + ((pc ^ (prow & 15)) << 4));
    unsigned xo[4];
#pragma unroll
    for (int x = 0; x < 4; ++x) xo[x] = (unsigned)((((4 * x + g) ^ c)) << 4);
    const unsigned rK = (unsigned)((8 * (c >> 2) + (c & 3)) * 256), rV = (unsigned)(c * 256);
    bf16x8 st[8];
#define RO_LOAD_KV(uu) do { const int n_ = (uu) & 15, h_ = ((uu) >> 4) & 3, b_ = (uu) >> 6; \
        const bf16_t* kp_ = P + (size_t)(b_ * SEQ + 128 * n_ + prow) * LDP + PC_RK + h_ * 128 + pc * 8; \
        const char* vp_ = RTg + ((size_t)(((b_ * SEQ + 128 * n_) >> 3) + (tid >> 7)) * 1024 + 512 + h_ * 128 + (tid & 127)) * 16; \
        _Pragma("unroll") for (int i = 0; i < 4; ++i) { st[i] = ldg8(kp_ + (size_t)(32 * i) * LDP); st[4 + i] = *(const bf16x8*)(vp_ + (size_t)(4 * i) * 16384); } } while (0)
#define RO_LOAD_S(uu) do { const int n_ = (uu) & 15, h_ = ((uu) >> 4) & 3, b_ = (uu) >> 6; \
        const size_t so_ = (size_t)((b_ * 4 + h_) * 16 + n_) * 16384 + prow * 128 + pc * 8; \
        _Pragma("unroll") for (int i = 0; i < 4; ++i) { st[i] = ldg8(SFg + so_ + (32 * i) * 128); st[4 + i] = ldg8(SBg + so_ + (32 * i) * 128); } } while (0)
#define RO_STORE_KV() do { _Pragma("unroll") for (int i = 0; i < 4; ++i) { \
        *(LAS bf16x8*)(Ks + wK + i * 8192) = st[i]; \
        *(LAS bf16x8*)(Vs + (tid & 127) * 256 + (((((tid >> 7) + 4 * i)) ^ (tid & 15)) << 4)) = st[4 + i]; } } while (0)
#define RO_STORE(A0, W0, A1, W1) do { _Pragma("unroll") for (int i = 0; i < 4; ++i) { \
        *(LAS bf16x8*)((A0) + (W0) + i * 8192) = st[i]; *(LAS bf16x8*)((A1) + (W1) + i * 8192) = st[4 + i]; } } while (0)
    int u = vb;
    if (u < 1024) RO_LOAD_KV(u);
    for (; u < 1024; u += G) {
        const int n = u & 15, h = (u >> 4) & 3, b = u >> 6;
        const int tl = 16 * wave + c;
        const size_t tok = (size_t)(b * SEQ + 128 * n + tl);
        const float lgf2 = -__expf(p.dec_f[h]) * LOG2E, lgb2 = -__expf(p.dec_b[h]) * LOG2E;
        RO_STORE_KV();
        RO_LOAD_S(u); __builtin_amdgcn_sched_barrier(0);
        bf16x8 qf[4];
#pragma unroll
        for (int ks = 0; ks < 4; ++ks) qf[ks] = ldg8(P + tok * LDP + PC_RQ + h * 128 + 32 * ks + 8 * g);
        u32x2 gwv[8];
#pragma unroll
        for (int dt = 0; dt < 8; ++dt) gwv[dt] = *(const u32x2*)(P + tok * LDP + PC_RG + h * 128 + 16 * dt + 4 * g);
        __syncthreads();
        f32x4 O[8];
#pragma unroll
        for (int dt = 0; dt < 8; ++dt) O[dt] = (f32x4){0.f, 0.f, 0.f, 0.f};
#pragma unroll
        for (int sg = 0; sg < 4; ++sg) {
            int tlv = tl - 8 * g; asm volatile("" : "+v"(tlv));
            f32x4 s_[2];
#pragma unroll
            for (int tau = 0; tau < 2; ++tau) {
                s_[tau] = (f32x4){0.f, 0.f, 0.f, 0.f};
#pragma unroll
                for (int ks = 0; ks < 4; ++ks) { unsigned a_ = rK + xo[ks]; asm volatile("" : "+v"(a_)); s_[tau] = mfma16(*(const LAS bf16x8*)(Ks + a_ + (32 * sg + 4 * tau) * 256), qf[ks], s_[tau]); }
            }
#pragma unroll
            for (int tau = 0; tau < 2; ++tau)
#pragma unroll
                for (int e = 0; e < 4; ++e) {
                    const int dl_ = tlv - (32 * sg + 4 * tau + e);
                    const float lg_ = dl_ > 0 ? lgf2 : lgb2; float d_ = ex2(lg_ * fabsf((float)dl_)); d_ = dl_ == 0 ? 2.0f : d_; s_[tau][e] *= d_; }
            u32x4 pw_; pw_.x = cvt_pk_bf16(s_[0][0], s_[0][1]); pw_.y = cvt_pk_bf16(s_[0][2], s_[0][3]); pw_.z = cvt_pk_bf16(s_[1][0], s_[1][1]); pw_.w = cvt_pk_bf16(s_[1][2], s_[1][3]);
            const bf16x8 pf = __builtin_bit_cast(bf16x8, pw_);
            unsigned av_ = 32768u + rV + xo[sg]; asm volatile("" : "+v"(av_));
#pragma unroll
            for (int dt = 0; dt < 8; ++dt) O[dt] = mfma16(*(const LAS bf16x8*)(lds + av_ + (16 * dt) * 256), pf, O[dt]);
            __builtin_amdgcn_sched_barrier(0);
        }
        RO_STORE(SFs, wV, SBs, wV);
        if (u + G < 1024) RO_LOAD_KV(u + G);
        __builtin_amdgcn_sched_barrier(0);
        __syncthreads();
        const float cF = ex2(lgf2 * (float)(tl + 1)), cB = ex2(lgb2 * (float)(128 - tl));
#pragma unroll
        for (int ks = 0; ks < 4; ++ks) {
            const bf16x8 qF_ = scale_frag(qf[ks], cF), qB_ = scale_frag(qf[ks], cB);
            unsigned af_ = 65536u + rV + xo[ks], ab_ = 98304u + rV + xo[ks]; asm volatile("" : "+v"(af_), "+v"(ab_));
#pragma unroll
            for (int dt = 0; dt < 8; ++dt) {
                O[dt] = mfma16(*(const LAS bf16x8*)(lds + af_ + (16 * dt) * 256), qF_, O[dt]);
                O[dt] = mfma16(*(const LAS bf16x8*)(lds + ab_ + (16 * dt) * 256), qB_, O[dt]);
            }
            __builtin_amdgcn_sched_barrier(0);
        }
        float ss = 0.f;
#pragma unroll
        for (int dt = 0; dt < 8; ++dt) ss += (O[dt][0] * O[dt][0] + O[dt][1] * O[dt][1]) + (O[dt][2] * O[dt][2] + O[dt][3] * O[dt][3]);
        ss += __shfl_xor(ss, 16); ss += __shfl_xor(ss, 32);
        const float rstd = rsqrtf(ss * (1.f / 128.f) + EPSN);
#pragma unroll
        for (int dt = 0; dt < 8; ++dt) {
            const int dv = 16 * dt + 4 * g;
            const f32x4 gn = *(const f32x4*)(p.ret_norm_g + h * 128 + dv);
            const u32x2 gw = gwv[dt];
            const f32x4 o = O[dt] * rstd * gn;
            u32x2 w; w.x = cvt_pk_bf16(o[0] * silu_f(bflo(gw.x)), o[1] * silu_f(bfhi(gw.x))); w.y = cvt_pk_bf16(o[2] * silu_f(bflo(gw.y)), o[3] * silu_f(bfhi(gw.y)));
            *(u32x2*)(Y + tok * DM + 512 + h * 128 + dv) = w;
        }
    }
#undef RO_LOAD_KV
#undef RO_LOAD_S
#undef RO_STORE
#undef RO_STORE_KV
}

DI void phase_p5(const Params& p, int vb, int G) {
    const int tid = threadIdx.x, lane = tid & 63, wave = tid >> 6;
    const int gw = vb * 8 + wave, NGW = G * 8;
    f32x4 gn[4];
#pragma unroll
    for (int j = 0; j < 4; ++j) gn[j] = *(const f32x4*)(p.final_g + 4 * lane + 256 * j);
    for (int grp = gw; grp < MLAT / 4; grp += NGW) {
        f32x4* xr = (f32x4*)(p.out + (size_t)grp * 4 * DM) + lane;
        f32x4 v[4][4]; float sq[4];
#pragma unroll
        for (int r = 0; r < 4; ++r)
#pragma unroll
            for (int j = 0; j < 4; ++j) v[r][j] = xr[r * 256 + 64 * j];
#pragma unroll
        for (int r = 0; r < 4; ++r) { float s = 0.f;
#pragma unroll
            for (int j = 0; j < 4; ++j) s += (v[r][j].x * v[r][j].x + v[r][j].y * v[r][j].y) + (v[r][j].z * v[r][j].z + v[r][j].w * v[r][j].w);
            sq[r] = s; }
#pragma unroll
        for (int o = 1; o < 64; o <<= 1)
#pragma unroll
            for (int r = 0; r < 4; ++r) sq[r] += __shfl_xor(sq[r], o);
#pragma unroll
        for (int r = 0; r < 4; ++r) { const float rstd = rsqrtf(sq[r] * (1.f / DM) + EPSN);
#pragma unroll
            for (int j = 0; j < 4; ++j) xr[r * 256 + 64 * j] = v[r][j] * rstd * gn[j]; }
    }
}

#define XB_TMO      128
#define XB_XCNT(j)  (256  + 64 * (j))
#define XB_XSUB(j)  (1280 + 64 * (j))
#define XB_XGEN(j)  (2304 + 64 * (j))
#define XB_TOP      3328
#define XB_TOPGEN   3392
#define XCD_BAR_WORDS 3456
#define XB_SPIN_CAP (1u << 18)
DI unsigned xb_ld(unsigned* p)              { return __hip_atomic_load(p, __ATOMIC_RELAXED, __HIP_MEMORY_SCOPE_AGENT); }
DI unsigned xb_add(unsigned* p, unsigned v) { return __hip_atomic_fetch_add(p, v, __ATOMIC_RELAXED, __HIP_MEMORY_SCOPE_AGENT); }
DI unsigned xb_xcc_id() { return (unsigned)__builtin_amdgcn_s_getreg((3 << 11) | 20) & 0xFu; }
#define XB_SPIN(cond, bar) do { unsigned _sp = 0; while (cond) { __builtin_amdgcn_s_sleep(1); \
    if ((++_sp & 255u) == 0u) { if (xb_ld(&(bar)[XB_TMO])) break; if (_sp > XB_SPIN_CAP) { atomicAdd(&(bar)[XB_TMO], 1u); break; } } } } while (0)
struct XcdBarrier { unsigned* bar; unsigned x; volatile LAS unsigned* st; };
DI XcdBarrier xcd_barrier_post(unsigned* bar, volatile LAS unsigned* st) {
    XcdBarrier b; b.bar = bar; b.x = xb_xcc_id(); b.st = st;
    if (threadIdx.x == 0) (void)xb_add(&bar[XB_XCNT(b.x)], 1u);
    return b;
}
DI void xcd_barrier_complete(unsigned* bar, unsigned x, unsigned& nloc, unsigned& nx) {
    const unsigned G = gridDim.x * gridDim.y * gridDim.z;
    unsigned sum, cnt, mine, sp = 0u;
    for (;;) {
        sum = 0u; cnt = 0u; mine = 0u;
#pragma unroll
        for (unsigned j = 0; j < 16; ++j) { const unsigned c = xb_ld(&bar[XB_XCNT(j)]); sum += c; cnt += (c > 0u) ? 1u : 0u; mine = (j == x) ? c : mine; }
        if (sum == G) break;
        __builtin_amdgcn_s_sleep(1);
        if ((++sp & 255u) == 0u) { if (xb_ld(&bar[XB_TMO])) break; if (sp > XB_SPIN_CAP) { atomicAdd(&bar[XB_TMO], 1u); break; } }
    }
    nloc = mine > 0u ? mine : 1u; nx = cnt > 0u ? cnt : 1u;
}
DI void xcd_barrier(const XcdBarrier& b) {
    asm volatile("s_waitcnt vmcnt(0)" ::: "memory");
    __syncthreads();
    if (threadIdx.x == 0) {
        unsigned* bar = b.bar;
        __builtin_amdgcn_s_waitcnt(0);
        unsigned nloc = b.st[0], nx = b.st[1];
        if (nloc == 0u) { xcd_barrier_complete(bar, b.x, nloc, nx); b.st[0] = nloc; b.st[1] = nx; }
        const unsigned old = xb_add(&bar[XB_XSUB(b.x)], 1u);
        const unsigned gen = old / nloc;
        if (old + 1u == (gen + 1u) * nloc) {
            __builtin_amdgcn_fence(__ATOMIC_RELEASE, "agent");
            asm volatile("s_waitcnt vmcnt(0)" ::: "memory");
            const unsigned og = xb_add(&bar[XB_TOP], 1u);
            const unsigned tg = og / nx;
            if (og + 1u == (tg + 1u) * nx) xb_add(&bar[XB_TOPGEN], 1u);
            else XB_SPIN(xb_ld(&bar[XB_TOPGEN]) == tg, bar);
            __builtin_amdgcn_fence(__ATOMIC_ACQUIRE, "agent");
            xb_add(&bar[XB_XGEN(b.x)], 1u);
            asm volatile("s_waitcnt vmcnt(0)" ::: "memory");
        } else {
            XB_SPIN(xb_ld(&bar[XB_XGEN(b.x)]) == gen, bar);
            __builtin_amdgcn_fence(__ATOMIC_ACQUIRE, "agent");
            asm volatile("s_waitcnt vmcnt(0)" ::: "memory");
        }
    }
    __syncthreads();
}
__global__ void __launch_bounds__(512, 2) mega_fwd(Params p) {
    extern __shared__ __attribute__((aligned(16))) unsigned char lds_raw[];
    LAS unsigned char* lds = (LAS unsigned char*)lds_raw;
    const int G = gridDim.x, bx = blockIdx.x;
    const int vb = (G % 8 == 0) ? (bx % 8) * (G / 8) + bx / 8 : bx;
    const int tid = threadIdx.x;
    volatile LAS unsigned* MISC = (volatile LAS unsigned*)(lds + 131072);
    if (tid < 16) MISC[tid] = 0u;
    __syncthreads();
    (void)xcd_barrier_post((unsigned*)p.ws, MISC);
#define GRID_BAR() do { XcdBarrier b_; b_.bar = (unsigned*)p.ws; b_.x = xb_xcc_id(); b_.st = (volatile LAS unsigned*)(lds + 131072); xcd_barrier(b_); } while (0)

#ifndef REPMASK
#define REPMASK 0
#endif
#define PH_P0()  phase_p0(p, lds, vb, G)
#define PH_P0B() phase_p0b(p, vb, G)
#define PH_P1()  do { InSched S{(const char*)(p.ws + WS_XN), (const char*)(p.ws + WS_WT), bx, G}; \
        EpiIn E{(bf16_t*)(p.ws + WS_P), (bf16_t*)(p.ws + WS_KT), (bf16_t*)(p.ws + WS_PT), (const float*)(p.ws + WS_COS), (const float*)(p.ws + WS_SIN), (const float*)(p.ws + WS_COST), (const float*)(p.ws + WS_SINT), lds + 131072 + 256}; \
        pg8::gemm_phase<EpiIn, InSched>(lds, S, E); } while (0)
#define PH_R1()  do { for (int it = vb; it < 256; it += G) ret_state_item(p, it); } while (0)
#define PH_NA()  do { for (int it = vb; it < 256; it += G) na_item(p, lds, it); } while (0)
#define PH_R2()  ret_out_phase(p, lds, vb, G)
#define PH_P4()  do { OutSched S{(const char*)(p.ws + WS_Y), (const char*)(p.ws + WS_WOT), vb, G}; \
        EpiOutF E{p.x, (const float*)(p.ws + WS_MOD), p.final_g, p.out, (float*)(p.ws + WS_XBUF), (unsigned*)(p.ws + WS_CNT), lds + 131072 + 256}; \
        pg8::gemm_phase<EpiOutF, OutSched>(lds, S, E); } while (0)
    PH_P0();
#if REPMASK & 1
    PH_P0();
#endif
    GRID_BAR();
    PH_P0B();
#if REPMASK & 2
    PH_P0B();
#endif
    GRID_BAR();
    PH_P1();
#if REPMASK & 4
    PH_P1();
#endif
    GRID_BAR();
    PH_R1();
#if REPMASK & 8
    PH_R1();
#endif
    PH_NA();
#if REPMASK & 16
    PH_NA();
#endif
    GRID_BAR();
    PH_R2();
#if REPMASK & 32
    PH_R2();
#endif
    GRID_BAR();
    PH_P4();
}

extern "C" void kernel_launch(void* const* d_in, const int* in_sizes, int n_in, void* d_out, int out_size, void* d_ws, size_t ws_size, hipStream_t stream) {
    static int grid = 0;
    if (grid == 0) {
        if (n_in != 14 || out_size != MLAT * DM || ws_size < WS_END) { fprintf(stderr, "kernel_launch: unexpected shapes (n_in %d, out %d, ws %zu)\n", n_in, out_size, ws_size); grid = -1; return; }
        int dev = 0, cus = 0, per_cu = 0;
        hipGetDevice(&dev);
        hipDeviceGetAttribute(&cus, hipDeviceAttributeMultiprocessorCount, dev);
        hipFuncSetAttribute((const void*)mega_fwd, hipFuncAttributeMaxDynamicSharedMemorySize, LDS_BYTES);
        hipOccupancyMaxActiveBlocksPerMultiprocessor(&per_cu, (const void*)mega_fwd, 512, LDS_BYTES);
        if (per_cu < 1 || cus < 1) { fprintf(stderr, "kernel_launch: occupancy query says %d blocks per CU (%d CUs)\n", per_cu, cus); grid = -1; return; }
        grid = cus;
    }
    if (grid < 0) return;
    Params p{};
    p.x = (const float*)d_in[0]; p.c = (const float*)d_in[1]; p.ctx = (const float*)d_in[2]; p.c_ctx = (const float*)d_in[3];
    p.norm_g = (const float*)d_in[4]; p.w_ada = (const float*)d_in[5]; p.b_ada = (const float*)d_in[6]; p.w_in = (const float*)d_in[7];
    p.na_rpb = (const float*)d_in[8]; p.dec_f = (const float*)d_in[9]; p.dec_b = (const float*)d_in[10]; p.ret_norm_g = (const float*)d_in[11];
    p.w_out = (const float*)d_in[12]; p.final_g = (const float*)d_in[13];
    p.out = (float*)d_out; p.ws = (unsigned char*)d_ws;
    if (hipMemsetAsync(d_ws, 0, 65536, stream) != hipSuccess) { fprintf(stderr, "kernel_launch: memset of the barrier words failed\n"); return; }
    hipLaunchKernelGGL(mega_fwd, dim3(grid), dim3(512), LDS_BYTES, stream, p);
    const hipError_t e = hipPeekAtLastError();
    if (e != hipSuccess) fprintf(stderr, "launch failed: %s (grid %d)\n", hipGetErrorString(e), grid);
}
```

```cpp
#include <hip/hip_runtime.h>
#include <cstdio>
#include <cstdint>

#define DI __device__ __forceinline__
#define LAS __attribute__((address_space(3)))
typedef unsigned short bf16_t;
typedef short bf16x8 __attribute__((ext_vector_type(8)));
typedef float f32x4 __attribute__((ext_vector_type(4)));
typedef unsigned u32x4 __attribute__((ext_vector_type(4)));
typedef unsigned u32x2 __attribute__((ext_vector_type(2)));

constexpr int DM = 1024, NBATCH = 16, SEQ = 2048, CTXL = 256;
constexpr int MLAT = NBATCH * SEQ, MCTX = NBATCH * CTXL, MTOT = MLAT + MCTX;
constexpr int LDP = 2560 + 128;
constexpr int LDT = MTOT + 128;
constexpr int LDKC = 512 + 128;
constexpr int PC_NAQ = 0, PC_NAG = 512, PC_RQ = 1024, PC_RK = 1536, PC_RG = 2048;
constexpr int PT_NAV = 0, PT_RK = 512, PT_RV = 1024;
constexpr float LOG2E = 1.4426950408889634f;
constexpr float KSCALE = 0.08838834764831845f;
constexpr float EPSN = 1e-6f;
constexpr int NWT = 4608;

constexpr size_t MiB = 1u << 20;
constexpr size_t WS_WT = 2 * MiB, WS_WOT = 12 * MiB, WS_MODP = 24 * MiB  , WS_MOD = 15 * MiB;
constexpr size_t WS_CNT = 16384;
constexpr size_t WS_XBUF = 20 * MiB;
constexpr size_t WS_COS = 16 * MiB, WS_SIN = WS_COS + 512 * 1024, WS_COST = 17 * MiB, WS_SINT = WS_COST + 512 * 1024;
constexpr size_t WS_XN = 32 * MiB;
constexpr size_t WS_Y = 32 * MiB;
constexpr size_t WS_P = 104 * MiB;
constexpr size_t WS_KT = 272 * MiB;
constexpr size_t WS_PT = 310 * MiB;
constexpr size_t WS_VT = WS_PT;
constexpr size_t WS_RT = WS_PT + (size_t)512 * LDT * 2;
static_assert((size_t)MTOT * 1024 * 2 <= (size_t)1024 * LDT * 2, "RT fits the old PT rows");
constexpr size_t WS_SF = 419 * MiB, WS_SB = 451 * MiB;
constexpr size_t WS_END = 483 * MiB;
static_assert(WS_P + (size_t)MLAT * LDP * 2 <= WS_KT && WS_KT + (size_t)MTOT * 512 * 2 <= WS_PT && (size_t)MTOT * 512 * 2 <= (size_t)512 * LDT * 2 && WS_PT + (size_t)1536 * LDT * 2 <= WS_SF, "ws map");

constexpr int LDS_BYTES = 131072 + 256 + 5120 + 8 * 2304;

struct Params {
    const float *x, *c, *ctx, *c_ctx, *norm_g, *w_ada, *b_ada, *w_in, *na_rpb, *dec_f, *dec_b, *ret_norm_g, *w_out, *final_g;
    float* out; unsigned char* ws;
};

DI unsigned cvt_pk_bf16(float lo, float hi) { unsigned r; asm volatile("v_cvt_pk_bf16_f32 %0, %1, %2" : "=v"(r) : "v"(lo), "v"(hi)); return r; }
DI float bf2f(unsigned short v) { return __uint_as_float(((unsigned)v) << 16); }
DI float bflo(unsigned w) { return __uint_as_float(w << 16); }
DI float bfhi(unsigned w) { return __uint_as_float(w & 0xffff0000u); }
DI f32x4 mfma16(bf16x8 a, bf16x8 b, f32x4 c) { return __builtin_amdgcn_mfma_f32_16x16x32_bf16(a, b, c, 0, 0, 0); }
DI bf16x8 ldg8(const bf16_t* p) { return *(const bf16x8*)p; }
#define GAS __attribute__((address_space(1)))
DI bf16x8 ldg8u(const bf16_t* ub, unsigned off_bytes) {
    const GAS char* gp = (const GAS char*)ub; asm volatile("" : "+s"(gp));
    return *(const GAS bf16x8*)(gp + off_bytes); }
DI float ex2(float x) { return __builtin_amdgcn_exp2f(x); }
DI float wave_sum(float v) {
#pragma unroll
    for (int o = 1; o < 64; o <<= 1) v += __shfl_xor(v, o);
    return v;
}
DI float silu_f(float v) { return v * __builtin_amdgcn_rcpf(1.f + ex2(v * -LOG2E)); }
DI bf16x8 scale_frag(bf16x8 a, float s) {
    u32x4 w = __builtin_bit_cast(u32x4, a), o;
    o.x = cvt_pk_bf16(bflo(w.x) * s, bfhi(w.x) * s); o.y = cvt_pk_bf16(bflo(w.y) * s, bfhi(w.y) * s);
    o.z = cvt_pk_bf16(bflo(w.z) * s, bfhi(w.z) * s); o.w = cvt_pk_bf16(bflo(w.w) * s, bfhi(w.w) * s);
    return __builtin_bit_cast(bf16x8, o);
}

namespace pg8 {
constexpr int BM = 256, BK = 64, HALF = 128, HTB = HALF * BK * 2, STAGE_BYTES = 8 * HTB;
constexpr int GK = 1024;
__host__ __device__ __forceinline__ int lds_byte(int r, int c) { const int st = (r >> 4) * 2 + (c >> 5), rr = r & 15, cc = c & 31, ob = rr * 64 + cc * 2; return st * 1024 + (ob ^ (((ob >> 9) & 1) << 5)); }
__host__ __device__ __forceinline__ void stage_rc(int b, int& R, int& C) { const int st = b / 1024, sb = b % 1024, swz = sb ^ (((sb >> 9) & 1) << 5); R = (st >> 1) * 16 + swz / 64; C = (st & 1) * 32 + (swz % 64) / 2; }
__host__ __device__ __forceinline__ int perm32(int rho) { const int n = rho >> 4, i = rho & 15; return 8 * (i >> 2) + 4 * n + (i & 3); }

struct Unit { int pm, pn; };

template <class Epi, class Sched>
DI void gemm_phase(LAS unsigned char* lds, const Sched& S, const Epi& E) {
    const int tid = threadIdx.x, wid = __builtin_amdgcn_readfirstlane(tid >> 6), lane = tid & 63, wr = wid >> 2, wc = wid & 3, fr = lane & 15, fq = lane >> 4;
    constexpr int K = GK, nt = K / BK;
    unsigned voffA[2], voffB[2];
#pragma unroll
    for (int i = 0; i < 2; ++i) { int R, C; stage_rc(tid * 16 + i * 8192, R, C); const int Rb = Epi::PERM ? ((R & ~31) + perm32(R & 31)) : R;
        voffA[i] = (unsigned)(R * K + C) * 2u; voffB[i] = (unsigned)(Rb * K + C) * 2u; }
    const size_t kstep = (size_t)(BK * 2);
    const size_t hstep = (size_t)HALF * K * 2;
    const unsigned ldsw = (unsigned)wid * 1024u;
    const int aoff = lds_byte(wr * 64 + fr, fq * 8), boff = lds_byte(wc * 32 + fr, fq * 8);
#define PG8_SA(b, h) (((b) * 2 + (h)) * HTB)
#define PG8_SB(b, h) ((4 + (b) * 2 + (h)) * HTB)
#define PG8_STAGE(bufoff, gbase, voff) do { _Pragma("unroll") for (int _i = 0; _i < 2; ++_i) \
        __builtin_amdgcn_global_load_lds((const unsigned*)((const char*)(gbase) + (voff)[_i]), (LAS unsigned*)(lds + (bufoff) + ldsw + _i * 8192), 16, 0, 0); } while (0)
#define PG8_LDA(dst, b, h) do { _Pragma("unroll") for (int m = 0; m < 4; ++m) _Pragma("unroll") for (int k = 0; k < 2; ++k) dst[m][k] = *(const LAS bf16x8*)(lds + PG8_SA(b, h) + aoff + m * 2048 + k * 1024); } while (0)
#define PG8_LDB(dst, b, h) do { _Pragma("unroll") for (int n = 0; n < 2; ++n) _Pragma("unroll") for (int k = 0; k < 2; ++k) dst[n][k] = *(const LAS bf16x8*)(lds + PG8_SB(b, h) + boff + n * 2048 + k * 1024); } while (0)
#define PG8_MMA(ai, bj, At, Bt) do { __builtin_amdgcn_s_setprio(1); _Pragma("unroll") for (int m = 0; m < 4; ++m) _Pragma("unroll") for (int n = 0; n < 2; ++n) _Pragma("unroll") for (int k = 0; k < 2; ++k) \
        acc[ai][bj][m][n] = __builtin_amdgcn_mfma_f32_16x16x32_bf16(Bt[n][k], At[m][k], acc[ai][bj][m][n], 0, 0, 0); __builtin_amdgcn_s_setprio(0); } while (0)
#define PG8_WAIT_V(n) asm volatile("s_waitcnt vmcnt(" #n ")" ::: "memory")
#define PG8_WAIT_L(n) asm volatile("s_waitcnt lgkmcnt(" #n ")" ::: "memory")
#define PG8_BAR __builtin_amdgcn_s_barrier()
#define PG8_SCHED __builtin_amdgcn_sched_barrier(0)
    Unit cur, nxt; int ui = 0;
    if (!S.next(0, cur)) return;
    f32x4 acc[2][2][4][2];
#pragma unroll
    for (int a = 0; a < 2; ++a)
#pragma unroll
        for (int b = 0; b < 2; ++b)
#pragma unroll
            for (int m = 0; m < 4; ++m)
#pragma unroll
                for (int n = 0; n < 2; ++n) acc[a][b][m][n] = (f32x4){0.f, 0.f, 0.f, 0.f};
    bf16x8 At[4][2], B0[2][2], B1[2][2];
    const char* cA = S.aptr(cur); const char* cB = S.bptr(cur);
    PG8_STAGE(PG8_SB(0, 0), cB, voffB); PG8_STAGE(PG8_SB(0, 1), cB + hstep, voffB); PG8_STAGE(PG8_SA(0, 0), cA, voffA); PG8_STAGE(PG8_SA(0, 1), cA + hstep, voffA);
    if (wr == 1) PG8_BAR;
    PG8_WAIT_V(2); PG8_BAR;
    PG8_STAGE(PG8_SB(1, 0), cB + kstep, voffB); PG8_STAGE(PG8_SA(1, 0), cA + kstep, voffA); PG8_STAGE(PG8_SB(1, 1), cB + hstep + kstep, voffB);
    PG8_WAIT_V(6); PG8_BAR;
    for (;;) {
        const bool has_next = S.next(ui + 1, nxt);
        const char* nA = has_next ? S.aptr(nxt) : cA; const char* nB = has_next ? S.bptr(nxt) : cB;
        for (int t = 0; t < nt; t += 2) {
            const bool last = (t == nt - 2);
            const char* a1 = cA + (size_t)(t + 1) * kstep;
            const char* a2 = last ? nA : cA + (size_t)(t + 2) * kstep; const char* b2 = last ? nB : cB + (size_t)(t + 2) * kstep;
            const char* a3 = a2 + kstep; const char* b3 = b2 + kstep;
            PG8_LDB(B0, 0, 0); PG8_LDB(B1, 0, 1); PG8_SCHED; PG8_LDA(At, 0, 0); PG8_STAGE(PG8_SA(1, 1), a1 + hstep, voffA);
            PG8_WAIT_V(8); PG8_WAIT_L(0); PG8_BAR; PG8_MMA(0, 0, At, B0); PG8_MMA(0, 1, At, B1); PG8_BAR; PG8_SCHED;
            PG8_LDA(At, 0, 1); PG8_STAGE(PG8_SB(0, 0), b2, voffB); PG8_STAGE(PG8_SB(0, 1), b2 + hstep, voffB); PG8_STAGE(PG8_SA(0, 0), a2, voffA);
            PG8_WAIT_V(8); PG8_WAIT_L(0); PG8_BAR; PG8_MMA(1, 0, At, B0); PG8_MMA(1, 1, At, B1); PG8_BAR; PG8_SCHED;
            PG8_LDB(B0, 1, 0); PG8_LDB(B1, 1, 1); PG8_SCHED; PG8_LDA(At, 1, 0); PG8_STAGE(PG8_SA(0, 1), a2 + hstep, voffA);
            PG8_WAIT_V(8); PG8_WAIT_L(0); PG8_BAR; PG8_MMA(0, 0, At, B0); PG8_MMA(0, 1, At, B1); PG8_BAR; PG8_SCHED;
            PG8_LDA(At, 1, 1); PG8_STAGE(PG8_SB(1, 0), b3, voffB); PG8_STAGE(PG8_SB(1, 1), b3 + hstep, voffB); PG8_STAGE(PG8_SA(1, 0), a3, voffA);
            PG8_WAIT_V(8); PG8_WAIT_L(0); PG8_BAR; PG8_MMA(1, 0, At, B0); PG8_MMA(1, 1, At, B1); PG8_BAR; PG8_SCHED;
        }
        if (wr == 0) PG8_BAR;
        E(acc, cur, wr, wc, fr, fq);
        if (!has_next) break;
#pragma unroll
        for (int a = 0; a < 2; ++a)
#pragma unroll
            for (int b = 0; b < 2; ++b)
#pragma unroll
                for (int m = 0; m < 4; ++m)
#pragma unroll
                    for (int n = 0; n < 2; ++n) acc[a][b][m][n] = (f32x4){0.f, 0.f, 0.f, 0.f};
        cur = nxt; cA = nA; cB = nB; ++ui;
        if (wr == 1) PG8_BAR;
    }
    PG8_WAIT_V(0);
    PG8_BAR;
#undef PG8_SA
#undef PG8_SB
#undef PG8_STAGE
#undef PG8_LDA
#undef PG8_LDB
#undef PG8_MMA
#undef PG8_WAIT_V
#undef PG8_WAIT_L
#undef PG8_BAR
#undef PG8_SCHED
}
}

struct InSched {
    const char* XN; const char* WT; int c, G;
    DI bool next(int i, pg8::Unit& u) const {
        const long L = (long)i * G + c;
        if (L < 2048) {
            int wgid = (int)L; wgid = (wgid & 7) * 256 + (wgid >> 3);
            const int gid = wgid >> 7, rem = wgid & 127, vs = rem >> 3;
            u.pm = gid * 8 + (rem & 7); u.pn = vs < 14 ? vs : vs + 2; return true;
        }
        if (L < 2176) { const int l2 = (int)L - 2048; u.pm = 128 + (l2 & 15); const int j = l2 >> 4; u.pn = j < 2 ? 2 + j : 10 + j; return true; }
        return false;
    }
    DI const char* aptr(const pg8::Unit& u) const { return u.pn < 12 ? XN + (size_t)u.pm * (256 * 1024 * 2) : WT + (size_t)u.pn * (256 * 1024 * 2); }
    DI const char* bptr(const pg8::Unit& u) const { return u.pn < 12 ? WT + (size_t)u.pn * (256 * 1024 * 2) : XN + (size_t)u.pm * (256 * 1024 * 2); }
};
struct EpiIn {
    static constexpr bool PERM = true;
    bf16_t *P, *KT, *PT; const float *COS, *SIN, *COST, *SINT; LAS unsigned char* scr;
    DI void operator()(const f32x4 (&acc)[2][2][4][2], const pg8::Unit& u, int wr, int wc, int fr_, int fq_) const {
        int fr = fr_, fq = fq_; asm volatile("" : "+v"(fr), "+v"(fq));
        const int vn = u.pn, pm = u.pm;
        if (vn < 12) {
            const int rowb = pm * 256 + wr * 64 + fr;
            if (vn == 2 || vn == 3) {
                const int colk = (vn - 2) * 256 + wc * 32 + 8 * fq;
#pragma unroll
                for (int ai = 0; ai < 2; ++ai)
#pragma unroll
                    for (int m = 0; m < 4; ++m) {
                        const int tok = rowb + ai * 128 + m * 16;
#pragma unroll
                        for (int bj = 0; bj < 2; ++bj) {
                            const int col = colk + bj * 128, hh = col >> 6, ks = (col >> 5) & 1, gg = (col >> 3) & 3;
                            const f32x4 v0 = acc[ai][bj][m][0], v1 = acc[ai][bj][m][1];
                            u32x4 w; w.x = cvt_pk_bf16(v0[0], v0[1]); w.y = cvt_pk_bf16(v0[2], v0[3]); w.z = cvt_pk_bf16(v1[0], v1[1]); w.w = cvt_pk_bf16(v1[2], v1[3]);
                            __builtin_nontemporal_store(w, (u32x4*)((char*)KT + (size_t)((tok >> 3) * 8 + hh) * 1024 + ks * 512 + (gg * 8 + (tok & 7)) * 16));
                        }
                    }
                return;
            }
            bf16_t* base = P; const int ldc = LDP;
            const int col0 = (vn < 2 ? vn : vn - 2) * 256 + wc * 32 + 8 * fq;
            const bool rot = (vn >= 6 && vn < 10);
            const int i0 = 16 * wc + 4 * fq;
#pragma unroll
            for (int ai = 0; ai < 2; ++ai)
#pragma unroll
                for (int m = 0; m < 4; ++m) {
                    const int row = rowb + ai * 128 + m * 16;
                    f32x4 c4 = {1.f, 1.f, 1.f, 1.f}, s4 = {0.f, 0.f, 0.f, 0.f};
                    if (rot) { const int t = row & 2047; c4 = *(const f32x4*)(COS + t * 64 + i0); s4 = *(const f32x4*)(SIN + t * 64 + i0); }
                    bf16_t* rowp = base + (size_t)row * ldc + col0;
#pragma unroll
                    for (int bj = 0; bj < 2; ++bj) {
                        const f32x4 v0 = acc[ai][bj][m][0], v1 = acc[ai][bj][m][1];
                        const f32x4 o0 = v0 * c4 - v1 * s4, o1 = v0 * s4 + v1 * c4;
                        u32x4 w; w.x = cvt_pk_bf16(o0[0], o0[1]); w.y = cvt_pk_bf16(o0[2], o0[3]); w.z = cvt_pk_bf16(o1[0], o1[1]); w.w = cvt_pk_bf16(o1[2], o1[3]);
                        {
                            LAS unsigned char* tbw = scr + 5120 + (wr * 4 + wc) * 2304;
                            const int ln = fr + 16 * fq;
                            *(LAS u32x4*)(tbw + fr * 80 + fq * 16) = w;
                            const u32x4 wt = *(const LAS u32x4*)(tbw + (ln >> 2) * 80 + (ln & 3) * 16);
                            __builtin_nontemporal_store(wt, (u32x4*)(base + (size_t)(row - fr + (ln >> 2)) * ldc + (col0 - 8 * fq) + bj * 128 + (ln & 3) * 8));
                        }
                        if (vn == 8 || vn == 9) {
                            unsigned short* r0 = (unsigned short*)((char*)PT + (size_t)512 * LDT * 2 + ((size_t)(row >> 3) * 1024 + ((vn - 8) * 2 + bj) * 128 + 32 * wc + 4 * fq) * 16 + (row & 7) * 2);
                            r0[0] = (unsigned short)(w.x & 0xffffu); r0[8] = (unsigned short)(w.x >> 16); r0[16] = (unsigned short)(w.y & 0xffffu); r0[24] = (unsigned short)(w.y >> 16);
                            r0[128] = (unsigned short)(w.z & 0xffffu); r0[136] = (unsigned short)(w.z >> 16); r0[144] = (unsigned short)(w.w & 0xffffu); r0[152] = (unsigned short)(w.w >> 16);
                        }
                    }
                }
        } else {
            const int frow0 = (vn - 12) * 256 + wr * 64 + fr;
            const int tok0 = pm * 256 + wc * 32 + 8 * fq;
            const bool rot = (vn == 14 || vn == 15) && pm < 128;
            if (vn < 14) {
#pragma unroll
                for (int ai = 0; ai < 2; ++ai)
#pragma unroll
                    for (int bj = 0; bj < 2; ++bj)
#pragma unroll
                        for (int m = 0; m < 4; ++m) {
                            const int f = frow0 + ai * 128 + m * 16, tok = tok0 + bj * 128;
                            const f32x4 v0 = acc[ai][bj][m][0], v1 = acc[ai][bj][m][1];
                            u32x4 w; w.x = cvt_pk_bf16(v0[0], v0[1]); w.y = cvt_pk_bf16(v0[2], v0[3]); w.z = cvt_pk_bf16(v1[0], v1[1]); w.w = cvt_pk_bf16(v1[2], v1[3]);
                            __builtin_nontemporal_store(w, (u32x4*)((char*)PT + (size_t)((tok >> 3) * 8 + (f >> 6)) * 1024 + (f & 63) * 16));
                        }
                return;
            }
#pragma unroll
            for (int ai = 0; ai < 2; ++ai)
#pragma unroll
                for (int bj = 0; bj < 2; ++bj)
#pragma unroll
                    for (int mp = 0; mp < 2; ++mp) {
                        const int tok = tok0 + bj * 128;
                        f32x4 ca = {1.f, 1.f, 1.f, 1.f}, cb = ca, sa = {0.f, 0.f, 0.f, 0.f}, sb = sa;
                        if (rot) { const int i = 32 * wr + 16 * mp + fr, t = tok & 2047;
                            ca = *(const f32x4*)(COST + i * 2048 + t); cb = *(const f32x4*)(COST + i * 2048 + t + 4);
                            sa = *(const f32x4*)(SINT + i * 2048 + t); sb = *(const f32x4*)(SINT + i * 2048 + t + 4); }
                        const f32x4 x1a = acc[ai][bj][2 * mp][0], x1b = acc[ai][bj][2 * mp][1], x2a = acc[ai][bj][2 * mp + 1][0], x2b = acc[ai][bj][2 * mp + 1][1];
                        const f32x4 o1a = x1a * ca - x2a * sa, o1b = x1b * cb - x2b * sb, o2a = x1a * sa + x2a * ca, o2b = x1b * sb + x2b * cb;
                        char* r1 = (char*)PT + (size_t)512 * LDT * 2 + ((size_t)(tok >> 3) * 1024 + (frow0 - 512 + ai * 128 + (2 * mp) * 16)) * 16;
                        char* r2 = r1 + 16 * 16;
                        u32x4 w; w.x = cvt_pk_bf16(o1a[0], o1a[1]); w.y = cvt_pk_bf16(o1a[2], o1a[3]); w.z = cvt_pk_bf16(o1b[0], o1b[1]); w.w = cvt_pk_bf16(o1b[2], o1b[3]);
                        __builtin_nontemporal_store(w, (u32x4*)r1);
                        w.x = cvt_pk_bf16(o2a[0], o2a[1]); w.y = cvt_pk_bf16(o2a[2], o2a[3]); w.z = cvt_pk_bf16(o2b[0], o2b[1]); w.w = cvt_pk_bf16(o2b[2], o2b[3]);
                        __builtin_nontemporal_store(w, (u32x4*)r2);
                    }
        }
    }
};
struct OutSched {
    const char* Y; const char* WOT; int c, G;
    DI bool next(int i, pg8::Unit& u) const {
        const long L = (long)i * G + c; if (L >= 512) return false;
        u.pm = (int)(L >> 2); u.pn = (int)(L & 3); return true;
    }
    DI const char* aptr(const pg8::Unit& u) const { return Y + (size_t)u.pm * (256 * 1024 * 2); }
    DI const char* bptr(const pg8::Unit& u) const { return WOT + (size_t)u.pn * (256 * 1024 * 2); }
};
struct EpiOutF {
    static constexpr bool PERM = false;
    const float* x; const float* MOD; const float* gfin; float* out; float* xbuf; unsigned* cnt; LAS unsigned char* scr;
    DI void operator()(f32x4 (&acc)[2][2][4][2], const pg8::Unit& u, int wr, int wc, int fr_, int fq_) const {
        int fr = fr_, fq = fq_, tid = threadIdx.x;
        asm volatile("" : "+v"(fr), "+v"(fq), "+v"(tid));
        const int b = u.pm >> 3;
        const int col0 = u.pn * 256 + wc * 32 + 4 * fq;
        LAS float* P4s = (LAS float*)scr;
        LAS float* S = (LAS float*)(scr + 4096);
        f32x4 gt[2][2];
#pragma unroll
        for (int bj = 0; bj < 2; ++bj)
#pragma unroll
            for (int n = 0; n < 2; ++n) gt[bj][n] = *(const f32x4*)(MOD + b * 3072 + 2048 + col0 + bj * 128 + n * 16);
        int lane = fr + 16 * fq; const int rr = lane >> 3, pz = lane & 7;
        LAS unsigned char* tb = scr + 5120 + (wr * 4 + wc) * 2304;
        f32x4 xv[3][2][2];
        const float* xg = x + (size_t)(u.pm * 256 + wr * 64 + rr) * DM + u.pn * 256 + wc * 32 + pz * 4;
#define EPF_LOADX(B, ai_, m_) do { _Pragma("unroll") for (int bj = 0; bj < 2; ++bj) _Pragma("unroll") for (int k = 0; k < 2; ++k) \
            xv[B][bj][k] = *(const f32x4*)(xg + (size_t)((ai_) * 128 + (m_) * 16 + 8 * k) * DM + bj * 128); } while (0)
        EPF_LOADX(0, 0, 0); EPF_LOADX(1, 0, 1);
#pragma unroll
        for (int im = 0; im < 8; ++im) {
            const int ai = im >> 2, m = im & 3;
            if (im + 2 < 8) EPF_LOADX((im + 2) % 3, (im + 2) >> 2, (im + 2) & 3);
            __builtin_amdgcn_sched_barrier(0);
            float q0 = 0.f, q1 = 0.f; f32x4 uu[2];
#pragma unroll
            for (int bj = 0; bj < 2; ++bj) {
#pragma unroll
                for (int n = 0; n < 2; ++n) *(LAS f32x4*)(tb + fr * 144 + (16 * n + 4 * fq) * 4) = gt[bj][n] * acc[ai][bj][m][n];
#pragma unroll
                for (int k = 0; k < 2; ++k) {
                    const f32x4 t = *(const LAS f32x4*)(tb + (rr + 8 * k) * 144 + pz * 16);
                    const f32x4 v = xv[im % 3][bj][k] + t;
                    const float d = (v[0] * v[0] + v[1] * v[1]) + (v[2] * v[2] + v[3] * v[3]);
                    if (k == 0) q0 += d; else q1 += d;
                    uu[k] = v;
                }
                acc[ai][bj][m][0] = uu[0]; acc[ai][bj][m][1] = uu[1];
            }
            q0 += __shfl_xor(q0, 1); q1 += __shfl_xor(q1, 1); q0 += __shfl_xor(q0, 2); q1 += __shfl_xor(q1, 2); q0 += __shfl_xor(q0, 4); q1 += __shfl_xor(q1, 4);
            if (pz == 0) { P4s[(ai * 128 + wr * 64 + m * 16 + rr) * 4 + wc] = q0; P4s[(ai * 128 + wr * 64 + m * 16 + rr + 8) * 4 + wc] = q1; }
            __builtin_amdgcn_sched_barrier(0);
        }
#undef EPF_LOADX
        asm volatile("s_waitcnt lgkmcnt(0)" ::: "memory"); __builtin_amdgcn_s_barrier(); asm volatile("" ::: "memory");
        float* slot = xbuf + ((size_t)u.pm * 256) * 4;
        unsigned* pc = cnt + 64 * u.pm;
        if (tid < 256) {
            const float t = (P4s[tid * 4 + 0] + P4s[tid * 4 + 1]) + (P4s[tid * 4 + 2] + P4s[tid * 4 + 3]);
            __hip_atomic_store(slot + tid * 4 + u.pn, t, __ATOMIC_RELAXED, __HIP_MEMORY_SCOPE_AGENT);
            asm volatile("s_waitcnt vmcnt(0)" ::: "memory");
            if ((tid & 63) == 0) __hip_atomic_fetch_add(pc, 1u, __ATOMIC_RELAXED, __HIP_MEMORY_SCOPE_AGENT);
        }
        if (tid < 64) {
            unsigned sp = 0;
            while ((unsigned)__builtin_amdgcn_readfirstlane(__hip_atomic_load(pc, __ATOMIC_RELAXED, __HIP_MEMORY_SCOPE_AGENT)) < 16u) {
                __builtin_amdgcn_s_sleep(2); if (++sp > (1u << 20)) break; }
            __builtin_amdgcn_fence(__ATOMIC_ACQUIRE, "agent");
        }
        asm volatile("s_waitcnt vmcnt(0) lgkmcnt(0)" ::: "memory"); __builtin_amdgcn_s_barrier(); asm volatile("" ::: "memory");
        if (tid < 256) {
            float tot = 0.f;
#pragma unroll
            for (int t = 0; t < 4; ++t) tot += __hip_atomic_load(slot + tid * 4 + t, __ATOMIC_RELAXED, __HIP_MEMORY_SCOPE_AGENT);
            S[tid] = rsqrtf(tot * (1.f / DM) + EPSN);
        }
        asm volatile("s_waitcnt lgkmcnt(0)" ::: "memory"); __builtin_amdgcn_s_barrier(); asm volatile("" ::: "memory");
        f32x4 gf[2];
#pragma unroll
        for (int bj = 0; bj < 2; ++bj) gf[bj] = *(const f32x4*)(gfin + u.pn * 256 + bj * 128 + wc * 32 + pz * 4);
#pragma unroll
        for (int ai = 0; ai < 2; ++ai)
#pragma unroll
            for (int m = 0; m < 4; ++m)
#pragma unroll
                for (int k = 0; k < 2; ++k) {
                    const int r = ai * 128 + wr * 64 + m * 16 + rr + 8 * k; const float rs = S[r];
                    float* orow = out + (size_t)(u.pm * 256 + r) * DM + u.pn * 256 + wc * 32 + pz * 4;
#pragma unroll
                    for (int bj = 0; bj < 2; ++bj) __builtin_nontemporal_store(acc[ai][bj][m][k] * rs * gf[bj], (f32x4*)(orow + bj * 128));
                }
        asm volatile("s_waitcnt lgkmcnt(0)" ::: "memory"); __builtin_amdgcn_s_barrier(); asm volatile("" ::: "memory");
    }
};

DI void wt_src(int np, int& src, float& sc) {
    const int vn = np >> 8; sc = 1.f;
    if (vn < 2) { src = np; sc = 0.125f * LOG2E; }
    else if (vn < 4) { src = np; }
    else if (vn < 6) { src = 1536 + (np - 1024); }
    else if (vn < 10) { const int hl = (np - 1536) & 511, head = hl >> 7, p = hl & 127, half = (p >> 2) & 1, i = 4 * (p >> 3) + (p & 3);
        src = (vn < 8 ? 2048 : 2560) + head * 128 + 64 * half + i; if (vn >= 8) sc = KSCALE; }
    else if (vn < 12) { src = 3584 + (np - 2560); }
    else if (vn < 14) { src = 1024 + (np - 3072); }
    else if (vn < 16) { const int hl = np - 3584, head = hl >> 7, p = hl & 127, half = (p >> 4) & 1, i = 16 * (p >> 5) + (p & 15);
        src = 2560 + head * 128 + 64 * half + i; sc = KSCALE; }
    else { src = 3072 + (np - 4096); }
}
DI void p0_transpose_item(const float* W, int N, bool is_in, bf16_t* WT, LAS float* scr, int item, int lane) {
    const int nblk = is_in ? (NWT / 32) : 32, kb = item / nblk, nb = item % nblk, k0 = 64 * kb, n0 = 32 * nb;
    int src; float sc;
    if (is_in) wt_src(n0 + (lane & 31), src, sc); else { src = n0 + (lane & 31); sc = 1.f; }
#pragma unroll 8
    for (int i = 0; i < 32; ++i) { const int kk = 2 * i + (lane >> 5); scr[kk * 33 + (lane & 31)] = __builtin_nontemporal_load(W + (size_t)(k0 + kk) * N + src) * sc; }
    asm volatile("s_waitcnt lgkmcnt(0)" ::: "memory");
    const int c = lane & 7;
#pragma unroll
    for (int j = 0; j < 4; ++j) { const int n = (lane >> 3) + 8 * j; const LAS float* s = scr + (8 * c) * 33 + n;
        u32x4 o; o.x = cvt_pk_bf16(s[0 * 33], s[1 * 33]); o.y = cvt_pk_bf16(s[2 * 33], s[3 * 33]); o.z = cvt_pk_bf16(s[4 * 33], s[5 * 33]); o.w = cvt_pk_bf16(s[6 * 33], s[7 * 33]);
        *(u32x4*)(WT + (size_t)(n0 + n) * 1024 + k0 + 8 * c) = o; }
    asm volatile("s_waitcnt lgkmcnt(0)" ::: "memory");
}
DI void p0_gemv_item(const Params& p, float* MODP, LAS float* scr, int item, int lane) {
    const int q = item / 48, cgp = item % 48, col = cgp * 64 + lane;
    float acc[17];
#pragma unroll
    for (int bb = 0; bb < 17; ++bb) acc[bb] = 0.f;
    for (int kc = 0; kc < 4; ++kc) {
        const int kbase = q * 64 + kc * 16;
#pragma unroll
        for (int u = 0; u < 5; ++u) { const int idx = lane + 64 * u;
            if (idx < 272) { const int kk = idx / 17, bb = idx - kk * 17; const float v = bb < 16 ? p.c[bb * 1024 + kbase + kk] : p.c_ctx[kbase + kk]; scr[idx] = silu_f(v); } }
        asm volatile("s_waitcnt lgkmcnt(0)" ::: "memory");
        float wv[16];
#pragma unroll
        for (int kk = 0; kk < 16; ++kk) wv[kk] = p.w_ada[(size_t)(kbase + kk) * 3072 + col];
#pragma unroll
        for (int kk = 0; kk < 16; ++kk) {
#pragma unroll
            for (int bb = 0; bb < 17; ++bb) acc[bb] += scr[kk * 17 + bb] * wv[kk]; }
        asm volatile("s_waitcnt lgkmcnt(0)" ::: "memory");
    }
#pragma unroll
    for (int bb = 0; bb < 17; ++bb) MODP[(q * 17 + bb) * 3072 + col] = acc[bb];
}
DI void phase_p0(const Params& p, LAS unsigned char* lds, int vb, int G) {
    const int tid = threadIdx.x, lane = tid & 63, wave = tid >> 6;
    LAS float* scr = (LAS float*)(lds + wave * 16384);
    const int gw = vb * 8 + wave, NGW = G * 8;
    bf16_t* WT = (bf16_t*)(p.ws + WS_WT); bf16_t* WOT = (bf16_t*)(p.ws + WS_WOT); float* MODP = (float*)(p.ws + WS_MODP);
    constexpr int I_GEMV = 768, I_IN = 16 * (NWT / 32), I_OUT = 16 * 32;
    for (int it = gw; it < I_GEMV + I_IN + I_OUT; it += NGW) {
        if (it < I_GEMV) p0_gemv_item(p, MODP, scr, it, lane);
        else if (it < I_GEMV + I_IN) p0_transpose_item(p.w_in, 4096, true, WT, scr, it - I_GEMV, lane);
        else p0_transpose_item(p.w_out, 1024, false, WOT, scr, it - I_GEMV - I_IN, lane);
    }
    float* COS = (float*)(p.ws + WS_COS); float* SIN = (float*)(p.ws + WS_SIN); float* COST = (float*)(p.ws + WS_COST); float* SINT = (float*)(p.ws + WS_SINT);
    for (int idx = vb * 512 + tid; idx < 2048 * 64; idx += G * 512) {
        const int t = idx >> 6, i = idx & 63, f = i & 31; const float pos = (float)((i < 32) ? (t >> 6) : (t & 63));
        const float inv = exp2f(-(float)f * (13.287712379549449f / 32.f));
        const float ang = pos * inv; const float cs = __cosf(ang), sn = __sinf(ang);
        COS[idx] = cs; SIN[idx] = sn; COST[i * 2048 + t] = cs; SINT[i * 2048 + t] = sn;
    }
}
DI void norm_rows(const Params& p, const float* src, bf16_t* dst, int nrows, int bmod, int lane) {
    const float* MODP = (const float*)(p.ws + WS_MODP);
    f32x4 mul[4], sh[4];
#pragma unroll
    for (int j = 0; j < 4; ++j) { const int col = 4 * lane + 256 * j;
        f32x4 s = *(const f32x4*)(p.b_ada + col), sc = *(const f32x4*)(p.b_ada + 1024 + col);
#pragma unroll 2
        for (int q = 0; q < 16; ++q) { s += *(const f32x4*)(MODP + (q * 17 + bmod) * 3072 + col); sc += *(const f32x4*)(MODP + (q * 17 + bmod) * 3072 + 1024 + col); }
        sh[j] = s; mul[j] = *(const f32x4*)(p.norm_g + col) * (sc + 1.0f); }
    for (int r = 0; r < nrows; r += 2) {
        const f32x4* xr = (const f32x4*)(src + (size_t)r * DM) + lane;
        f32x4 v[2][4]; float sq[2];
#pragma unroll
        for (int q = 0; q < 2; ++q)
#pragma unroll
            for (int j = 0; j < 4; ++j) v[q][j] = __builtin_nontemporal_load(xr + q * 256 + 64 * j);
#pragma unroll
        for (int q = 0; q < 2; ++q) { float s = 0.f;
#pragma unroll
            for (int j = 0; j < 4; ++j) s += (v[q][j].x * v[q][j].x + v[q][j].y * v[q][j].y) + (v[q][j].z * v[q][j].z + v[q][j].w * v[q][j].w);
            sq[q] = s; }
#pragma unroll
        for (int o = 1; o < 64; o <<= 1) { sq[0] += __shfl_xor(sq[0], o); sq[1] += __shfl_xor(sq[1], o); }
#pragma unroll
        for (int q = 0; q < 2; ++q) { const float rstd = rsqrtf(sq[q] * (1.f / DM) + EPSN);
            u32x2* o8 = (u32x2*)(dst + (size_t)(r + q) * DM) + lane;
#pragma unroll
            for (int j = 0; j < 4; ++j) { const f32x4 h = v[q][j] * rstd * mul[j] + sh[j]; u32x2 w; w.x = cvt_pk_bf16(h.x, h.y); w.y = cvt_pk_bf16(h.z, h.w); o8[64 * j] = w; } }
    }
}
DI void phase_p0b(const Params& p, int vb, int G) {
    const int tid = threadIdx.x, lane = tid & 63, wave = tid >> 6;
    const int gw = vb * 8 + wave, NGW = G * 8;
    bf16_t* XN = (bf16_t*)(p.ws + WS_XN);
    for (int wv = gw; wv < 2048; wv += NGW) {
        const int b = wv >> 7, r0 = b * 2048 + (wv & 127) * 16;
        norm_rows(p, p.x + (size_t)r0 * DM, XN + (size_t)r0 * DM, 16, b, lane);
    }
    for (int wv = gw; wv < 2048; wv += NGW)
        norm_rows(p, p.ctx + (size_t)(wv * 2) * DM, XN + (size_t)(MLAT + wv * 2) * DM, 2, 16, lane);
    const float* MODP = (const float*)(p.ws + WS_MODP); float* MOD = (float*)(p.ws + WS_MOD);
    for (int idx = vb * 512 + tid; idx < 17 * 3072; idx += G * 512) {
        const int col = idx % 3072;
        float a = p.b_ada[col];
#pragma unroll
        for (int q = 0; q < 16; ++q) a += MODP[q * 17 * 3072 + idx];
        MOD[idx] = a;
    }
}

DI void ret_state_item(const Params& p, int item) {
    const int lane = threadIdx.x & 63, wave = __builtin_amdgcn_readfirstlane(threadIdx.x >> 6);
    const int dvq = item & 3, h = (item >> 2) & 3, b = item >> 4;
    const int dir = wave & 1, mt = wave >> 1, c = lane & 15, g = lane >> 4;
    const bf16_t* PT = (const bf16_t*)(p.ws + WS_PT);
    bf16_t* SO = (bf16_t*)(p.ws + (dir ? WS_SB : WS_SF)) + (size_t)((b * 4 + h) * 16) * 16384;
    const float lg2 = -__expf(dir ? p.dec_b[h] : p.dec_f[h]) * LOG2E;
    float w8[8];
#pragma unroll
    for (int j = 0; j < 8; ++j) w8[j] = ex2(lg2 * (float)(dir ? (8 * g + j) : (31 - 8 * g - j)));
    const float g32 = ex2(lg2 * 32.f);
    const unsigned loff = (unsigned)((g * 1024 + c) * 16);
    const char* RT = (const char*)(p.ws + WS_RT);
    const char* abase = RT + (size_t)(h * 128 + 32 * mt) * 16;
    const char* bbase = RT + (size_t)(512 + h * 128 + 32 * dvq) * 16;
    const int ctxb = MLAT + b * CTXL, latb = b * SEQ;
    f32x4 acc[2][2];
#pragma unroll
    for (int at = 0; at < 2; ++at)
#pragma unroll
        for (int nt = 0; nt < 2; ++nt) acc[at][nt] = (f32x4){0.f, 0.f, 0.f, 0.f};
    bf16x8 fa[2][2][4], fb[2][2][4];
#define RS_TOK(i) (dir ? ((i) < 2 ? ctxb + 128 * (1 - (i)) : latb + 128 * (17 - (i))) : ((i) < 2 ? ctxb + 128 * (i) : latb + 128 * ((i) - 2)))
#define RS_LOAD(B, i) do { const int tb_ = RS_TOK(i); _Pragma("unroll") for (int ks = 0; ks < 4; ++ks) { \
        const size_t to_ = (size_t)((tb_ >> 3) + 4 * ks) * 16384; \
        fa[B][0][ks] = ldg8u((const bf16_t*)(abase + to_), loff); fa[B][1][ks] = ldg8u((const bf16_t*)(abase + to_ + 256), loff); \
        fb[B][0][ks] = ldg8u((const bf16_t*)(bbase + to_), loff); fb[B][1][ks] = ldg8u((const bf16_t*)(bbase + to_ + 256), loff); } } while (0)
#define RS_STORE(i) do { const int n_ = dir ? 17 - (i) : (i) - 2; bf16_t* so_ = SO + (size_t)n_ * 16384; \
        _Pragma("unroll") for (int at = 0; at < 2; ++at) _Pragma("unroll") for (int nt = 0; nt < 2; ++nt) { \
            u32x2 w_; w_.x = cvt_pk_bf16(acc[at][nt][0], acc[at][nt][1]); w_.y = cvt_pk_bf16(acc[at][nt][2], acc[at][nt][3]); \
            __builtin_nontemporal_store(w_, (u32x2*)(so_ + (32 * dvq + 16 * nt + c) * 128 + 32 * mt + 8 * g + 4 * at)); } } while (0)
#define RS_COMPUTE(B) do { _Pragma("unroll") for (int kk = 0; kk < 4; ++kk) { const int ks = dir ? 3 - kk : kk; \
        _Pragma("unroll") for (int at = 0; at < 2; ++at) _Pragma("unroll") for (int nt = 0; nt < 2; ++nt) acc[at][nt] *= g32; \
        _Pragma("unroll") for (int at = 0; at < 2; ++at) { \
            const u32x4 w_ = __builtin_bit_cast(u32x4, fa[B][at][ks]); u32x4 o_; \
            o_.x = cvt_pk_bf16(bflo(w_.x) * w8[0], bfhi(w_.x) * w8[1]); o_.y = cvt_pk_bf16(bflo(w_.y) * w8[2], bfhi(w_.y) * w8[3]); \
            o_.z = cvt_pk_bf16(bflo(w_.z) * w8[4], bfhi(w_.z) * w8[5]); o_.w = cvt_pk_bf16(bflo(w_.w) * w8[6], bfhi(w_.w) * w8[7]); \
            const bf16x8 aw_ = __builtin_bit_cast(bf16x8, o_); \
            acc[at][0] = mfma16(aw_, fb[B][0][ks], acc[at][0]); acc[at][1] = mfma16(aw_, fb[B][1][ks], acc[at][1]); } } } while (0)
    RS_LOAD(0, 0); __builtin_amdgcn_sched_barrier(0);
    for (int i = 0; i < 18; i += 2) {
        if (i + 1 < 17) RS_LOAD(1, i + 1);
        __builtin_amdgcn_sched_barrier(0);
        if (i >= 2) RS_STORE(i);
        if (i < 17) RS_COMPUTE(0);
        if (i + 2 < 17) RS_LOAD(0, i + 2);
        __builtin_amdgcn_sched_barrier(0);
        if (i + 1 >= 2) RS_STORE(i + 1);
        if (i + 1 < 17) RS_COMPUTE(1);
    }
#undef RS_TOK
#undef RS_LOAD
#undef RS_STORE
#undef RS_COMPUTE
}

template <bool LOCAL>
DI void na_step1(const bf16x8 (&kf)[2][2], const bf16x8 (&vf)[4], const bf16x8 (&qf)[2], f32x4 (&O)[4], float& mrun, float& lrun,
                 const LAS float* bp, const f32x4 (&madd)[2]) {
    f32x4 s[2];
    if (LOCAL) {
#pragma unroll
        for (int tau = 0; tau < 2; ++tau) {
            float b0 = bp[4 * tau], b1 = bp[4 * tau + 1], b2 = bp[4 * tau + 2], b3 = bp[4 * tau + 3];
            asm volatile("" : "+v"(b0), "+v"(b1), "+v"(b2), "+v"(b3));
            s[tau] = (f32x4){b0, b1, b2, b3} + madd[tau];
        }
    } else { s[0] = (f32x4){0.f, 0.f, 0.f, 0.f}; s[1] = s[0]; }
#pragma unroll
    for (int tau = 0; tau < 2; ++tau) { s[tau] = mfma16(kf[tau][0], qf[0], s[tau]); s[tau] = mfma16(kf[tau][1], qf[1], s[tau]); }
    float mx = fmaxf(fmaxf(fmaxf(s[0][0], s[0][1]), fmaxf(s[0][2], s[0][3])), fmaxf(fmaxf(s[1][0], s[1][1]), fmaxf(s[1][2], s[1][3])));
    mx = fmaxf(mx, __shfl_xor(mx, 16)); mx = fmaxf(mx, __shfl_xor(mx, 32));
    const float mnew = fmaxf(mrun, mx), alpha = ex2(mrun - mnew);
    mrun = mnew;
    float ps = 0.f;
#pragma unroll
    for (int tau = 0; tau < 2; ++tau)
#pragma unroll
        for (int e = 0; e < 4; ++e) { s[tau][e] = ex2(s[tau][e] - mnew); ps += s[tau][e]; }
    lrun = lrun * alpha + ps;
    u32x4 pw; pw.x = cvt_pk_bf16(s[0][0], s[0][1]); pw.y = cvt_pk_bf16(s[0][2], s[0][3]); pw.z = cvt_pk_bf16(s[1][0], s[1][1]); pw.w = cvt_pk_bf16(s[1][2], s[1][3]);
    const bf16x8 pf = __builtin_bit_cast(bf16x8, pw);
#pragma unroll
    for (int dt = 0; dt < 4; ++dt) { O[dt] *= alpha; O[dt] = mfma16(vf[dt], pf, O[dt]); }
}
DI void na_step2(const bf16x8 (&kf)[2][2], const bf16x8 (&vf)[4], const bf16x8 (&kc)[2][2], const bf16x8 (&vc)[4], const bf16x8 (&qf)[2], f32x4 (&O)[4], float& mrun, float& lrun,
                 const LAS float* bp, const f32x4 (&madd)[2]) {
    f32x4 s[4];
#pragma unroll
    for (int tau = 0; tau < 2; ++tau) {
        float b0 = bp[4 * tau], b1 = bp[4 * tau + 1], b2 = bp[4 * tau + 2], b3 = bp[4 * tau + 3];
        asm volatile("" : "+v"(b0), "+v"(b1), "+v"(b2), "+v"(b3));
        s[tau] = (f32x4){b0, b1, b2, b3} + madd[tau];
        s[2 + tau] = (f32x4){0.f, 0.f, 0.f, 0.f};
    }
#pragma unroll
    for (int tau = 0; tau < 2; ++tau) { s[tau] = mfma16(kf[tau][0], qf[0], s[tau]); s[2 + tau] = mfma16(kc[tau][0], qf[0], s[2 + tau]); }
#pragma unroll
    for (int tau = 0; tau < 2; ++tau) { s[tau] = mfma16(kf[tau][1], qf[1], s[tau]); s[2 + tau] = mfma16(kc[tau][1], qf[1], s[2 + tau]); }
    float mx = fmaxf(fmaxf(fmaxf(s[0][0], s[0][1]), fmaxf(s[0][2], s[0][3])), fmaxf(fmaxf(s[1][0], s[1][1]), fmaxf(s[1][2], s[1][3])));
    mx = fmaxf(mx, fmaxf(fmaxf(fmaxf(s[2][0], s[2][1]), fmaxf(s[2][2], s[2][3])), fmaxf(fmaxf(s[3][0], s[3][1]), fmaxf(s[3][2], s[3][3]))));
    mx = fmaxf(mx, __shfl_xor(mx, 16)); mx = fmaxf(mx, __shfl_xor(mx, 32));
    const float mnew = fmaxf(mrun, mx), alpha = ex2(mrun - mnew);
    mrun = mnew;
    float ps = 0.f;
#pragma unroll
    for (int t = 0; t < 4; ++t)
#pragma unroll
        for (int e = 0; e < 4; ++e) { s[t][e] = ex2(s[t][e] - mnew); ps += s[t][e]; }
    lrun = lrun * alpha + ps;
    u32x4 pw; pw.x = cvt_pk_bf16(s[0][0], s[0][1]); pw.y = cvt_pk_bf16(s[0][2], s[0][3]); pw.z = cvt_pk_bf16(s[1][0], s[1][1]); pw.w = cvt_pk_bf16(s[1][2], s[1][3]);
    const bf16x8 pfl = __builtin_bit_cast(bf16x8, pw);
    pw.x = cvt_pk_bf16(s[2][0], s[2][1]); pw.y = cvt_pk_bf16(s[2][2], s[2][3]); pw.z = cvt_pk_bf16(s[3][0], s[3][1]); pw.w = cvt_pk_bf16(s[3][2], s[3][3]);
    const bf16x8 pfc = __builtin_bit_cast(bf16x8, pw);
#pragma unroll
    for (int dt = 0; dt < 4; ++dt) { O[dt] *= alpha; O[dt] = mfma16(vf[dt], pfl, O[dt]); O[dt] = mfma16(vc[dt], pfc, O[dt]); }
}
DI void na_item(const Params& p, LAS unsigned char* lds, int item) {
    const int tid = threadIdx.x, lane = tid & 63, wave = __builtin_amdgcn_readfirstlane(tid >> 6);
    const int half = item & 1, h = (item >> 1) & 7, b = item >> 4;
    const int j = wave & 3, rr = wave >> 2, c = lane & 15, g = lane >> 4;
    const bf16_t* P = (const bf16_t*)(p.ws + WS_P); const char* KT = (const char*)(p.ws + WS_KT); const char* VT = (const char*)(p.ws + WS_VT);
    bf16_t* Y = (bf16_t*)(p.ws + WS_Y);
    LAS float* rpb = (LAS float*)lds;
    LAS unsigned char* Kc = lds + 4096;
    LAS unsigned char* Vc = lds + 4096 + 32768;
    __syncthreads();
    for (int idx = tid; idx < 15 * 64; idx += 512) { const int dr = idx >> 6, xx = (idx & 63) - 16;
        rpb[idx] = (xx >= 0 && xx < 31) ? p.na_rpb[(h * 15 + dr) * 31 + xx] * LOG2E : 0.f; }
#pragma unroll
    for (int i = 0; i < 4; ++i) { const int idx = tid + 512 * i, blk = idx >> 6, q = idx & 63;
        const size_t tb = (size_t)(((MLAT + b * CTXL) >> 3) + blk) * 8 + h;
        { const int row = blk * 8 + (q & 7), pc = (q >> 5) * 4 + ((q >> 3) & 3);
          *(LAS bf16x8*)(Kc + row * 128 + ((pc ^ (((row >> 1) & 1) | (((row >> 3) & 3) << 1))) << 4)) = *(const bf16x8*)(KT + tb * 1024 + q * 16); }
        { const int row = q, pc = blk;
          *(LAS bf16x8*)(Vc + row * 512 + ((pc ^ (row & 15)) << 4)) = *(const bf16x8*)(VT + tb * 1024 + q * 16); } }
    __syncthreads();
    const int cw0 = (j == 0) ? 0 : (j == 1) ? 8 : (j == 2) ? 24 : 32;
    const int kap0 = 8 * (c >> 2) + (c & 3);
    const int cq = 16 * j + c; int c0 = cq - 8; c0 = c0 < 0 ? 0 : (c0 > 48 ? 48 : c0);
    const LAS float* rpbl = rpb + 16 + (cw0 + 8 * g - cq + 15);
    f32x4 madd[2];
#pragma unroll
    for (int tau = 0; tau < 2; ++tau)
#pragma unroll
        for (int e = 0; e < 4; ++e) { const int ck = cw0 + 8 * g + 4 * tau + e; madd[tau][e] = (ck >= c0 && ck < c0 + 16) ? 0.f : -INFINITY; }
    const unsigned klo = (unsigned)((c >> 2) * 8192 + (g * 8 + (c & 3)) * 16), vlo = (unsigned)(g * 8192 + c * 16);
    const unsigned kcb = (unsigned)(kap0 * 128), vcb = (unsigned)(c * 512);
    unsigned kx[2]; kx[0] = (unsigned)(((g) ^ (c >> 1)) << 4); kx[1] = (unsigned)(((4 + g) ^ (c >> 1)) << 4);
    for (int ui = 0; ui < 8; ++ui) {
        const int rp = 8 * half + ui, r = 2 * rp + rr;
        int r0 = r - 4; r0 = r0 < 0 ? 0 : (r0 > 24 ? 24 : r0);
        const size_t tok = (size_t)(b * SEQ + r * 64 + 16 * j + c);
        bf16x8 qf[2];
#pragma unroll
        for (int ks = 0; ks < 2; ++ks) qf[ks] = ldg8(P + tok * LDP + PC_NAQ + h * 64 + 32 * ks + 8 * g);
        f32x4 O[4]; float mrun = -1e30f, lrun = 0.f;
#pragma unroll
        for (int dt = 0; dt < 4; ++dt) O[dt] = (f32x4){0.f, 0.f, 0.f, 0.f};
        const size_t tb0 = (size_t)(((b * SEQ + r0 * 64 + cw0) >> 3) * 8 + h) * 1024;
        const char* kb0 = KT + tb0; const char* vb0 = VT + tb0;
        const LAS float* bp0 = rpbl + (r0 - r + 7) * 64;
        bf16x8 kf[2][2][2], vf[2][4], kc[2][2], vc[4];
#define NA_LOADL(B, st) do { _Pragma("unroll") for (int tau = 0; tau < 2; ++tau) _Pragma("unroll") for (int ks = 0; ks < 2; ++ks) \
            kf[B][tau][ks] = ldg8u((const bf16_t*)(kb0 + (size_t)(st) * 65536 + ks * 512 + tau * 64), klo); \
            _Pragma("unroll") for (int dt = 0; dt < 4; ++dt) vf[B][dt] = ldg8u((const bf16_t*)(vb0 + (size_t)(st) * 65536 + dt * 256), vlo); } while (0)
#define NA_LOADC(st) do { _Pragma("unroll") for (int tau = 0; tau < 2; ++tau) _Pragma("unroll") for (int ks = 0; ks < 2; ++ks) \
            kc[tau][ks] = *(const LAS bf16x8*)(Kc + kcb + kx[ks] + (32 * (st) + 4 * tau) * 128); \
            { unsigned va_ = vcb + (unsigned)((((4 * (st) + g) ^ c)) << 4); _Pragma("unroll") for (int dt = 0; dt < 4; ++dt) vc[dt] = *(const LAS bf16x8*)(Vc + va_ + (16 * dt) * 512); } } while (0)
        NA_LOADL(0, 0); __builtin_amdgcn_sched_barrier(0);
#pragma unroll 1
        for (int st = 0; st < 8; st += 2) {
            NA_LOADL(1, st + 1); __builtin_amdgcn_sched_barrier(0);
            NA_LOADC(st);
            na_step2(kf[0], vf[0], kc, vc, qf, O, mrun, lrun, bp0 + st * 64, madd);
            if (st + 2 < 8) NA_LOADL(0, st + 2);
            __builtin_amdgcn_sched_barrier(0);
            NA_LOADC(st + 1);
            na_step2(kf[1], vf[1], kc, vc, qf, O, mrun, lrun, bp0 + (st + 1) * 64, madd);
        }
#undef NA_LOADL
#undef NA_LOADC
        lrun += __shfl_xor(lrun, 16); lrun += __shfl_xor(lrun, 32);
        const float inv = __builtin_amdgcn_rcpf(lrun);
#pragma unroll
        for (int dt = 0; dt < 4; ++dt) {
            const f32x4 o = O[dt] * inv;
            const u32x2 gw = *(const u32x2*)(P + tok * LDP + PC_NAG + h * 64 + 16 * dt + 4 * g);
            u32x2 w; w.x = cvt_pk_bf16(o[0] * silu_f(bflo(gw.x)), o[1] * silu_f(bfhi(gw.x))); w.y = cvt_pk_bf16(o[2] * silu_f(bflo(gw.y)), o[3] * silu_f(bfhi(gw.y)));
            *(u32x2*)(Y + tok * DM + h * 64 + 16 * dt + 4 * g) = w;
        }
    }
}

DI void ret_out_phase(const Params& p, LAS unsigned char* lds, int vb, int G) {
    const int tid = threadIdx.x, lane = tid & 63, wave = __builtin_amdgcn_readfirstlane(tid >> 6), c = lane & 15, g = lane >> 4;
    const bf16_t* P = (const bf16_t*)(p.ws + WS_P); const bf16_t* PT = (const bf16_t*)(p.ws + WS_PT);
    const bf16_t* SFg = (const bf16_t*)(p.ws + WS_SF); const bf16_t* SBg = (const bf16_t*)(p.ws + WS_SB); const char* RTg = (const char*)(p.ws + WS_RT);
    bf16_t* Y = (bf16_t*)(p.ws + WS_Y);
    LAS unsigned char* Ks = lds; LAS unsigned char* Vs = lds + 32768; LAS unsigned char* SFs = lds + 65536; LAS unsigned char* SBs = lds + 98304;
    const int prow = tid >> 4, pc = tid & 15;
    const unsigned wK = (unsigned)(prow * 256 + ((pc ^ ((prow & 3) | (((prow >> 3) & 3) << 2))) << 4));
    const unsigned wV = (unsigned)(prow * 256 + ((pc ^ (prow & 15)) << 4));
    unsigned xo[4];
#pragma unroll
    for (int x = 0; x < 4; ++x) xo[x] = (unsigned)((((4 * x + g) ^ c)) << 4);
    const unsigned rK = (unsigned)((8 * (c >> 2) + (c & 3)) * 256), rV = (unsigned)(c * 256);
    bf16x8 st[8];
#define RO_LOAD_KV(uu) do { const int n_ = (uu) & 15, h_ = ((uu) >> 4) & 3, b_ = (uu) >> 6; \
        const bf16_t* kp_ = P + (size_t)(b_ * SEQ + 128 * n_ + prow) * LDP + PC_RK + h_ * 128 + pc * 8; \
        const char* vp_ = RTg + ((size_t)(((b_ * SEQ + 128 * n_) >> 3) + (tid >> 7)) * 1024 + 512 + h_ * 128 + (tid & 127)) * 16; \
        _Pragma("unroll") for (int i = 0; i < 4; ++i) { st[i] = ldg8(kp_ + (size_t)(32 * i) * LDP); st[4 + i] = *(const bf16x8*)(vp_ + (size_t)(4 * i) * 16384); } } while (0)
#define RO_LOAD_S(uu) do { const int n_ = (uu) & 15, h_ = ((uu) >> 4) & 3, b_ = (uu) >> 6; \
        const size_t so_ = (size_t)((b_ * 4 + h_) * 16 + n_) * 16384 + prow * 128 + pc * 8; \
        _Pragma("unroll") for (int i = 0; i < 4; ++i) { st[i] = ldg8(SFg + so_ + (32 * i) * 128); st[4 + i] = ldg8(SBg + so_ + (32 * i) * 128); } } while (0)
#define RO_STORE_KV() do { _Pragma("unroll") for (int i = 0; i < 4; ++i) { \
        *(LAS bf16x8*)(Ks + wK + i * 8192) = st[i]; \
        *(LAS bf16x8*)(Vs + (tid & 127) * 256 + (((((tid >> 7) + 4 * i)) ^ (tid & 15)) << 4)) = st[4 + i]; } } while (0)
#define RO_STORE(A0, W0, A1, W1) do { _Pragma("unroll") for (int i = 0; i < 4; ++i) { \
        *(LAS bf16x8*)((A0) + (W0) + i * 8192) = st[i]; *(LAS bf16x8*)((A1) + (W1) + i * 8192) = st[4 + i]; } } while (0)
    int u = vb;
    if (u < 1024) RO_LOAD_KV(u);
    for (; u < 1024; u += G) {
        const int n = u & 15, h = (u >> 4) & 3, b = u >> 6;
        const int tl = 16 * wave + c;
        const size_t tok = (size_t)(b * SEQ + 128 * n + tl);
        const float lgf2 = -__expf(p.dec_f[h]) * LOG2E, lgb2 = -__expf(p.dec_b[h]) * LOG2E;
        RO_STORE_KV();
        RO_LOAD_S(u); __builtin_amdgcn_sched_barrier(0);
        bf16x8 qf[4];
#pragma unroll
        for (int ks = 0; ks < 4; ++ks) qf[ks] = ldg8(P + tok * LDP + PC_RQ + h * 128 + 32 * ks + 8 * g);
        u32x2 gwv[8];
#pragma unroll
        for (int dt = 0; dt < 8; ++dt) gwv[dt] = *(const u32x2*)(P + tok * LDP + PC_RG + h * 128 + 16 * dt + 4 * g);
        __syncthreads();
        f32x4 O[8];
#pragma unroll
        for (int dt = 0; dt < 8; ++dt) O[dt] = (f32x4){0.f, 0.f, 0.f, 0.f};
#pragma unroll
        for (int sg = 0; sg < 4; ++sg) {
            int tlv = tl - 8 * g; asm volatile("" : "+v"(tlv));
            f32x4 s_[2];
#pragma unroll
            for (int tau = 0; tau < 2; ++tau) {
                s_[tau] = (f32x4){0.f, 0.f, 0.f, 0.f};
#pragma unroll
                for (int ks = 0; ks < 4; ++ks) { unsigned a_ = rK + xo[ks]; asm volatile("" : "+v"(a_)); s_[tau] = mfma16(*(const LAS bf16x8*)(Ks + a_ + (32 * sg + 4 * tau) * 256), qf[ks], s_[tau]); }
            }
#pragma unroll
            for (int tau = 0; tau < 2; ++tau)
#pragma unroll
                for (int e = 0; e < 4; ++e) {
                    const int dl_ = tlv - (32 * sg + 4 * tau + e);
                    const float lg_ = dl_ > 0 ? lgf2 : lgb2; float d_ = ex2(lg_ * fabsf((float)dl_)); d_ = dl_ == 0 ? 2.0f : d_; s_[tau][e] *= d_; }
            u32x4 pw_; pw_.x = cvt_pk_bf16(s_[0][0], s_[0][1]); pw_.y = cvt_pk_bf16(s_[0][2], s_[0][3]); pw_.z = cvt_pk_bf16(s_[1][0], s_[1][1]); pw_.w = cvt_pk_bf16(s_[1][2], s_[1][3]);
            const bf16x8 pf = __builtin_bit_cast(bf16x8, pw_);
            unsigned av_ = 32768u + rV + xo[sg]; asm volatile("" : "+v"(av_));
#pragma unroll
            for (int dt = 0; dt < 8; ++dt) O[dt] = mfma16(*(const LAS bf16x8*)(lds + av_ + (16 * dt) * 256), pf, O[dt]);
            __builtin_amdgcn_sched_barrier(0);
        }
        RO_STORE(SFs, wV, SBs, wV);
        if (u + G < 1024) RO_LOAD_KV(u + G);
        __builtin_amdgcn_sched_barrier(0);
        __syncthreads();
        const float cF = ex2(lgf2 * (float)(tl + 1)), cB = ex2(lgb2 * (float)(128 - tl));
#pragma unroll
        for (int ks = 0; ks < 4; ++ks) {
            const bf16x8 qF_ = scale_frag(qf[ks], cF), qB_ = scale_frag(qf[ks], cB);
            unsigned af_ = 65536u + rV + xo[ks], ab_ = 98304u + rV + xo[ks]; asm volatile("" : "+v"(af_), "+v"(ab_));
#pragma unroll
            for (int dt = 0; dt < 8; ++dt) {
                O[dt] = mfma16(*(const LAS bf16x8*)(lds + af_ + (16 * dt) * 256), qF_, O[dt]);
                O[dt] = mfma16(*(const LAS bf16x8*)(lds + ab_ + (16 * dt) * 256), qB_, O[dt]);
            }
            __builtin_amdgcn_sched_barrier(0);
        }
        float ss = 0.f;
#pragma unroll
        for (int dt = 0; dt < 8; ++dt) ss += (O[dt][0] * O[dt][0] + O[dt][1] * O[dt][1]) + (O[dt][2] * O[dt][2] + O[dt][3] * O[dt][3]);
        ss += __shfl_xor(ss, 16); ss += __shfl_xor(ss, 32);
        const float rstd = rsqrtf(ss * (1.f / 128.f) + EPSN);
#pragma unroll
        for (int dt = 0; dt < 8; ++dt) {
            const int dv = 16 * dt + 4 * g;
            const f32x4 gn = *(const f32x4*)(p.ret_norm_g + h * 128 + dv);
            const u32x2 gw = gwv[dt];
            const f32x4 o = O[dt] * rstd * gn;
            u32x2 w; w.x = cvt_pk_bf16(o[0] * silu_f(bflo(gw.x)), o[1] * silu_f(bfhi(gw.x))); w.y = cvt_pk_bf16(o[2] * silu_f(bflo(gw.y)), o[3] * silu_f(bfhi(gw.y)));
            *(u32x2*)(Y + tok * DM + 512 + h * 128 + dv) = w;
        }
    }
#undef RO_LOAD_KV
#undef RO_LOAD_S
#undef RO_STORE
#undef RO_STORE_KV
}

DI void phase_p5(const Params& p, int vb, int G) {
    const int tid = threadIdx.x, lane = tid & 63, wave = tid >> 6;
    const int gw = vb * 8 + wave, NGW = G * 8;
    f32x4 gn[4];
#pragma unroll
    for (int j = 0; j < 4; ++j) gn[j] = *(const f32x4*)(p.final_g + 4 * lane + 256 * j);
    for (int grp = gw; grp < MLAT / 4; grp += NGW) {
        f32x4* xr = (f32x4*)(p.out + (size_t)grp * 4 * DM) + lane;
        f32x4 v[4][4]; float sq[4];
#pragma unroll
        for (int r = 0; r < 4; ++r)
#pragma unroll
            for (int j = 0; j < 4; ++j) v[r][j] = xr[r * 256 + 64 * j];
#pragma unroll
        for (int r = 0; r < 4; ++r) { float s = 0.f;
#pragma unroll
            for (int j = 0; j < 4; ++j) s += (v[r][j].x * v[r][j].x + v[r][j].y * v[r][j].y) + (v[r][j].z * v[r][j].z + v[r][j].w * v[r][j].w);
            sq[r] = s; }
#pragma unroll
        for (int o = 1; o < 64; o <<= 1)
#pragma unroll
            for (int r = 0; r < 4; ++r) sq[r] += __shfl_xor(sq[r], o);
#pragma unroll
        for (int r = 0; r < 4; ++r) { const float rstd = rsqrtf(sq[r] * (1.f / DM) + EPSN);
#pragma unroll
            for (int j = 0; j < 4; ++j) xr[r * 256 + 64 * j] = v[r][j] * rstd * gn[j]; }
    }
}

#define XB_TMO      128
#define XB_XCNT(j)  (256  + 64 * (j))
#define XB_XSUB(j)  (1280 + 64 * (j))
#define XB_XGEN(j)  (2304 + 64 * (j))
#define XB_TOP      3328
#define XB_TOPGEN   3392
#define XCD_BAR_WORDS 3456
#define XB_SPIN_CAP (1u << 18)
DI unsigned xb_ld(unsigned* p)              { return __hip_atomic_load(p, __ATOMIC_RELAXED, __HIP_MEMORY_SCOPE_AGENT); }
DI unsigned xb_add(unsigned* p, unsigned v) { return __hip_atomic_fetch_add(p, v, __ATOMIC_RELAXED, __HIP_MEMORY_SCOPE_AGENT); }
DI unsigned xb_xcc_id() { return (unsigned)__builtin_amdgcn_s_getreg((3 << 11) | 20) & 0xFu; }
#define XB_SPIN(cond, bar) do { unsigned _sp = 0; while (cond) { __builtin_amdgcn_s_sleep(1); \
    if ((++_sp & 255u) == 0u) { if (xb_ld(&(bar)[XB_TMO])) break; if (_sp > XB_SPIN_CAP) { atomicAdd(&(bar)[XB_TMO], 1u); break; } } } } while (0)
struct XcdBarrier { unsigned* bar; unsigned x; volatile LAS unsigned* st; };
DI XcdBarrier xcd_barrier_post(unsigned* bar, volatile LAS unsigned* st) {
    XcdBarrier b; b.bar = bar; b.x = xb_xcc_id(); b.st = st;
    if (threadIdx.x == 0) (void)xb_add(&bar[XB_XCNT(b.x)], 1u);
    return b;
}
DI void xcd_barrier_complete(unsigned* bar, unsigned x, unsigned& nloc, unsigned& nx) {
    const unsigned G = gridDim.x * gridDim.y * gridDim.z;
    unsigned sum, cnt, mine, sp = 0u;
    for (;;) {
        sum = 0u; cnt = 0u; mine = 0u;
#pragma unroll
        for (unsigned j = 0; j < 16; ++j) { const unsigned c = xb_ld(&bar[XB_XCNT(j)]); sum += c; cnt += (c > 0u) ? 1u : 0u; mine = (j == x) ? c : mine; }
        if (sum == G) break;
        __builtin_amdgcn_s_sleep(1);
        if ((++sp & 255u) == 0u) { if (xb_ld(&bar[XB_TMO])) break; if (sp > XB_SPIN_CAP) { atomicAdd(&bar[XB_TMO], 1u); break; } }
    }
    nloc = mine > 0u ? mine : 1u; nx = cnt > 0u ? cnt : 1u;
}
DI void xcd_barrier(const XcdBarrier& b) {
    asm volatile("s_waitcnt vmcnt(0)" ::: "memory");
    __syncthreads();
    if (threadIdx.x == 0) {
        unsigned* bar = b.bar;
        __builtin_amdgcn_s_waitcnt(0);
        unsigned nloc = b.st[0], nx = b.st[1];
        if (nloc == 0u) { xcd_barrier_complete(bar, b.x, nloc, nx); b.st[0] = nloc; b.st[1] = nx; }
        const unsigned old = xb_add(&bar[XB_XSUB(b.x)], 1u);
        const unsigned gen = old / nloc;
        if (old + 1u == (gen + 1u) * nloc) {
            __builtin_amdgcn_fence(__ATOMIC_RELEASE, "agent");
            asm volatile("s_waitcnt vmcnt(0)" ::: "memory");
            const unsigned og = xb_add(&bar[XB_TOP], 1u);
            const unsigned tg = og / nx;
            if (og + 1u == (tg + 1u) * nx) xb_add(&bar[XB_TOPGEN], 1u);
            else XB_SPIN(xb_ld(&bar[XB_TOPGEN]) == tg, bar);
            __builtin_amdgcn_fence(__ATOMIC_ACQUIRE, "agent");
            xb_add(&bar[XB_XGEN(b.x)], 1u);
            asm volatile("s_waitcnt vmcnt(0)" ::: "memory");
        } else {
            XB_SPIN(xb_ld(&bar[XB_XGEN(b.x)]) == gen, bar);
            __builtin_amdgcn_fence(__ATOMIC_ACQUIRE, "agent");
            asm volatile("s_waitcnt vmcnt(0)" ::: "memory");
        }
    }
    __syncthreads();
}
__global__ void __launch_bounds__(512, 2) mega_fwd(Params p) {
    extern __shared__ __attribute__((aligned(16))) unsigned char lds_raw[];
    LAS unsigned char* lds = (LAS unsigned char*)lds_raw;
    const int G = gridDim.x, bx = blockIdx.x;
    const int vb = (G % 8 == 0) ? (bx % 8) * (G / 8) + bx / 8 : bx;
    const int tid = threadIdx.x;
    volatile LAS unsigned* MISC = (volatile LAS unsigned*)(lds + 131072);
    if (tid < 16) MISC[tid] = 0u;
    __syncthreads();
    (void)xcd_barrier_post((unsigned*)p.ws, MISC);
#define GRID_BAR() do { XcdBarrier b_; b_.bar = (unsigned*)p.ws; b_.x = xb_xcc_id(); b_.st = (volatile LAS unsigned*)(lds + 131072); xcd_barrier(b_); } while (0)

#ifndef REPMASK
#define REPMASK 0
#endif
#define PH_P0()  phase_p0(p, lds, vb, G)
#define PH_P0B() phase_p0b(p, vb, G)
#define PH_P1()  do { InSched S{(const char*)(p.ws + WS_XN), (const char*)(p.ws + WS_WT), bx, G}; \
        EpiIn E{(bf16_t*)(p.ws + WS_P), (bf16_t*)(p.ws + WS_KT), (bf16_t*)(p.ws + WS_PT), (const float*)(p.ws + WS_COS), (const float*)(p.ws + WS_SIN), (const float*)(p.ws + WS_COST), (const float*)(p.ws + WS_SINT), lds + 131072 + 256}; \
        pg8::gemm_phase<EpiIn, InSched>(lds, S, E); } while (0)
#define PH_R1()  do { for (int it = vb; it < 256; it += G) ret_state_item(p, it); } while (0)
#define PH_NA()  do { for (int it = vb; it < 256; it += G) na_item(p, lds, it); } while (0)
#define PH_R2()  ret_out_phase(p, lds, vb, G)
#define PH_P4()  do { OutSched S{(const char*)(p.ws + WS_Y), (const char*)(p.ws + WS_WOT), vb, G}; \
        EpiOutF E{p.x, (const float*)(p.ws + WS_MOD), p.final_g, p.out, (float*)(p.ws + WS_XBUF), (unsigned*)(p.ws + WS_CNT), lds + 131072 + 256}; \
        pg8::gemm_phase<EpiOutF, OutSched>(lds, S, E); } while (0)
    PH_P0();
#if REPMASK & 1
    PH_P0();
#endif
    GRID_BAR();
    PH_P0B();
#if REPMASK & 2
    PH_P0B();
#endif
    GRID_BAR();
    PH_P1();
#if REPMASK & 4
    PH_P1();
#endif
    GRID_BAR();
    PH_R1();
#if REPMASK & 8
    PH_R1();
#endif
    PH_NA();
#if REPMASK & 16
    PH_NA();
#endif
    GRID_BAR();
    PH_R2();
#if REPMASK & 32
    PH_R2();
#endif
    GRID_BAR();
    PH_P4();
}

extern "C" void kernel_launch(void* const* d_in, const int* in_sizes, int n_in, void* d_out, int out_size, void* d_ws, size_t ws_size, hipStream_t stream) {
    static int grid = 0;
    if (grid == 0) {
        if (n_in != 14 || out_size != MLAT * DM || ws_size < WS_END) { fprintf(stderr, "kernel_launch: unexpected shapes (n_in %d, out %d, ws %zu)\n", n_in, out_size, ws_size); grid = -1; return; }
        int dev = 0, cus = 0, per_cu = 0;
        hipGetDevice(&dev);
        hipDeviceGetAttribute(&cus, hipDeviceAttributeMultiprocessorCount, dev);
        hipFuncSetAttribute((const void*)mega_fwd, hipFuncAttributeMaxDynamicSharedMemorySize, LDS_BYTES);
        hipOccupancyMaxActiveBlocksPerMultiprocessor(&per_cu, (const void*)mega_fwd, 512, LDS_BYTES);
        if (per_cu < 1 || cus < 1) { fprintf(stderr, "kernel_launch: occupancy query says %d blocks per CU (%d CUs)\n", per_cu, cus); grid = -1; return; }
        grid = cus;
    }
    if (grid < 0) return;
    Params p{};
    p.x = (const float*)d_in[0]; p.c = (const float*)d_in[1]; p.ctx = (const float*)d_in[2]; p.c_ctx = (const float*)d_in[3];
    p.norm_g = (const float*)d_in[4]; p.w_ada = (const float*)d_in[5]; p.b_ada = (const float*)d_in[6]; p.w_in = (const float*)d_in[7];
    p.na_rpb = (const float*)d_in[8]; p.dec_f = (const float*)d_in[9]; p.dec_b = (const float*)d_in[10]; p.ret_norm_g = (const float*)d_in[11];
    p.w_out = (const float*)d_in[12]; p.final_g = (const float*)d_in[13];
    p.out = (float*)d_out; p.ws = (unsigned char*)d_ws;
    if (hipMemsetAsync(d_ws, 0, 65536, stream) != hipSuccess) { fprintf(stderr, "kernel_launch: memset of the barrier words failed\n"); return; }
    hipLaunchKernelGGL(mega_fwd, dim3(grid), dim3(512), LDS_BYTES, stream, p);
    const hipError_t e = hipPeekAtLastError();
    if (e != hipSuccess) fprintf(stderr, "launch failed: %s (grid %d)\n", hipGetErrorString(e), grid);
}
```
